# Optimizing an MI355X kernel written in HIP

```python
import math
import jax, jax.numpy as jnp
from jax import lax
import numpy as np

D_MODEL = 1024
BATCH = 8
SEQ = 2048
DEPTH = 1
DEC_BATCH = 128
DEC_SEQ = 8
PAST_LEN = 16384
PAGE_SIZE = 128

D_FF = 2816
POOL_WINDOWS = (2, 4, 8, 16)
N_POOL_GROUPS = 4
POOL_WIDTH = D_MODEL
POOL_GROUP = POOL_WIDTH // N_POOL_GROUPS
POOL_HIST = 16 - 1
SSD_EXPAND = 2
D_INNER = SSD_EXPAND * D_MODEL
SSD_HEAD_DIM = 64
N_SSD_HEADS = D_INNER // SSD_HEAD_DIM
N_SSD_GROUPS = 4
HEADS_PER_GROUP = N_SSD_HEADS // N_SSD_GROUPS
D_STATE = 128
CONV_WIDTH = 4
BC_DIM = N_SSD_GROUPS * D_STATE
CONV_DIM = D_INNER + 2 * BC_DIM
CHUNK = 128
N_BRANCHES = 2
IN_PROJ_DIM = POOL_WIDTH + D_INNER + CONV_DIM + N_SSD_HEADS + N_BRANCHES * D_MODEL
EPS = 1e-6

kernel_name = 'hybrid_pool_ssd_macaron_step'


def rmsnorm(x, g):
    xf = x.astype(jnp.float32)
    y = xf * lax.rsqrt(jnp.mean(xf * xf, axis=-1, keepdims=True) + EPS)
    return (y * g.astype(jnp.float32)).astype(x.dtype)


def swiglu(x, w_in, w_out):
    gu = x @ w_in
    g, u = gu[..., :D_FF], gu[..., D_FF:]
    return (jax.nn.silu(g) * u) @ w_out


def pool_mix(u_ext, T, out_pos0, w_group, scale):
    Bsz = u_ext.shape[0]
    f32 = jnp.float32
    uf = u_ext.astype(f32)
    cs = jnp.concatenate([jnp.zeros((Bsz, 1, POOL_WIDTH), f32), jnp.cumsum(uf, axis=1)], axis=1)
    pos = out_pos0 + jnp.arange(T)
    means = []
    for gi, w in enumerate(POOL_WINDOWS):
        c0, c1 = gi * POOL_GROUP, (gi + 1) * POOL_GROUP
        s = cs[:, POOL_HIST + 1:, c0:c1] - cs[:, POOL_HIST + 1 - w:POOL_HIST + 1 - w + T, c0:c1]
        cnt = jnp.minimum(pos + 1, w).astype(f32)
        means.append(s / cnt[None, :, None])
    d = jnp.concatenate(means, axis=-1) - uf[:, POOL_HIST:]
    d = d.astype(u_ext.dtype).reshape(Bsz, T, N_POOL_GROUPS, POOL_GROUP)
    y = jnp.einsum('btgc,gcd->btgd', d, w_group).reshape(Bsz, T, POOL_WIDTH)
    return y * scale


def causal_conv(xbc, hist, w, b):
    T = xbc.shape[1]
    xp = jnp.concatenate([hist, xbc], axis=1)
    y = b + xp[:, 0:T] * w[0]
    for k in range(1, CONV_WIDTH):
        y = y + xp[:, k:k + T] * w[k]
    return jax.nn.silu(y), xp[:, -(CONV_WIDTH - 1):]


def ssd_scan(x, dt, A, bm, cm, h0):
    f32 = jnp.float32
    Bsz, T = x.shape[0], x.shape[1]
    L = min(CHUNK, T)
    pad = (-T) % L
    if pad:
        padf = lambda a: jnp.pad(a, [(0, 0), (0, pad)] + [(0, 0)] * (a.ndim - 2))
        x, dt, bm, cm = padf(x), padf(dt), padf(bm), padf(cm)
    Tp = T + pad
    nc = Tp // L
    G, R, P, N = N_SSD_GROUPS, HEADS_PER_GROUP, SSD_HEAD_DIM, D_STATE
    xr = x.astype(f32).reshape(Bsz, nc, L, G, R, P)
    dtr = dt.astype(f32).reshape(Bsz, nc, L, G, R)
    br = bm.astype(f32).reshape(Bsz, nc, L, G, N)
    cr = cm.astype(f32).reshape(Bsz, nc, L, G, N)
    a_cs = jnp.cumsum(dtr * A.reshape(G, R), axis=2)
    xdt = xr * dtr[..., None]
    acs_t = jnp.moveaxis(a_cs, 2, -1)
    causal = jnp.tril(jnp.ones((L, L), dtype=bool))
    seg = jnp.where(causal, acs_t[..., :, None] - acs_t[..., None, :], -jnp.inf)
    decay = jnp.exp(seg)
    cb = jnp.einsum('bclgn,bcsgn->bcgls', cr, br)
    y_diag = jnp.einsum('bcgrls,bcsgrp->bclgrp', cb[:, :, :, None] * decay, xdt)
    decay_end = jnp.exp(a_cs[:, :, -1:] - a_cs)
    st = jnp.einsum('bclgn,bclgr,bclgrp->bcgrpn', br, decay_end, xdt)
    chunk_decay = jnp.exp(a_cs[:, :, -1])

    def step(h, inp):
        s_c, d_c = inp
        return h * d_c[..., None, None] + s_c, h

    h_last, h_prev = lax.scan(step, h0.astype(f32).reshape(Bsz, G, R, P, N),
                              (jnp.moveaxis(st, 1, 0), jnp.moveaxis(chunk_decay, 1, 0)))
    h_prev = jnp.moveaxis(h_prev, 0, 1)
    y_off = jnp.einsum('bclgn,bcgrpn,bclgr->bclgrp', cr, h_prev, jnp.exp(a_cs))
    y = (y_diag + y_off).reshape(Bsz, Tp, N_SSD_HEADS, P)[:, :T]
    return y, h_last.reshape(Bsz, N_SSD_HEADS, P, N)


def token_mixing(hn, pool_hist, out_pos0, conv_hist, ssm_h0, w_in, pool_w_group, pool_scale,
                 pool_w_out, conv_w, conv_b, dt_bias, a_log, d_skip, ssd_norm, ssd_w_out, w_o):
    f32 = jnp.float32
    Bsz, T, _ = hn.shape
    proj = hn @ w_in
    s1 = POOL_WIDTH
    s2 = s1 + D_INNER
    s3 = s2 + CONV_DIM
    s4 = s3 + N_SSD_HEADS
    u, z, xbc, dt_raw, gate_logits = (proj[..., :s1], proj[..., s1:s2], proj[..., s2:s3],
                                      proj[..., s3:s4], proj[..., s4:])
    u_ext = jnp.concatenate([pool_hist.astype(u.dtype), u], axis=1)
    branch_pool = pool_mix(u_ext, T, out_pos0, pool_w_group, pool_scale) @ pool_w_out
    new_pool = u_ext[:, -POOL_HIST:]
    xbc_c, new_conv = causal_conv(xbc, conv_hist.astype(xbc.dtype), conv_w, conv_b)
    xs = xbc_c[..., :D_INNER].reshape(Bsz, T, N_SSD_HEADS, SSD_HEAD_DIM)
    bm = xbc_c[..., D_INNER:D_INNER + BC_DIM].reshape(Bsz, T, N_SSD_GROUPS, D_STATE)
    cm = xbc_c[..., D_INNER + BC_DIM:].reshape(Bsz, T, N_SSD_GROUPS, D_STATE)
    dt = jax.nn.softplus(dt_raw.astype(f32) + dt_bias.astype(f32))
    A = -jnp.exp(a_log.astype(f32))
    y, new_ssm = ssd_scan(xs, dt, A, bm, cm, ssm_h0)
    y = y + d_skip.astype(f32)[:, None] * xs.astype(f32)
    yg = (y.reshape(Bsz, T, D_INNER) * jax.nn.silu(z.astype(f32)))
    yg = yg.reshape(Bsz, T, N_SSD_GROUPS, D_INNER // N_SSD_GROUPS)
    yg = yg * lax.rsqrt(jnp.mean(yg * yg, axis=-1, keepdims=True) + EPS)
    y = (yg.reshape(Bsz, T, D_INNER) * ssd_norm.astype(f32)).astype(hn.dtype)
    branch_ssd = y @ ssd_w_out
    gates = jax.nn.sigmoid(gate_logits.astype(f32)).reshape(Bsz, T, N_BRANCHES, D_MODEL)
    merged = (gates[:, :, 0] * branch_pool.astype(f32) + gates[:, :, 1] * branch_ssd.astype(f32)).astype(hn.dtype)
    return merged @ w_o, new_pool, new_conv, new_ssm


def setup_inputs(seed: int = 0) -> dict:
    key = jax.random.key(seed)
    ks = iter(jax.random.split(key, 32))
    nrm = lambda shape, scale: scale * jax.random.normal(next(ks), shape, jnp.float32)
    gain = lambda shape: 1.0 + nrm(shape, 0.05)
    Lr = DEPTH
    x_prompt = nrm((BATCH, SEQ, D_MODEL), 1.0)
    x_sample = nrm((DEC_BATCH, DEC_SEQ, D_MODEL), 1.0)
    state_pool = nrm((Lr, DEC_BATCH, POOL_HIST, POOL_WIDTH), 1.0)
    state_conv = nrm((Lr, DEC_BATCH, CONV_WIDTH - 1, CONV_DIM), 1.0)
    state_ssm = nrm((Lr, DEC_BATCH, N_SSD_HEADS, SSD_HEAD_DIM, D_STATE), 0.5)
    norm_ffn1 = gain((Lr, D_MODEL))
    ffn1_w_in = nrm((Lr, D_MODEL, 2 * D_FF), D_MODEL ** -0.5)
    ffn1_w_out = nrm((Lr, D_FF, D_MODEL), D_FF ** -0.5)
    norm_mix = gain((Lr, D_MODEL))
    w_in = nrm((Lr, D_MODEL, IN_PROJ_DIM), D_MODEL ** -0.5)
    pool_w_group = nrm((Lr, N_POOL_GROUPS, POOL_GROUP, POOL_GROUP), POOL_GROUP ** -0.5)
    pool_scale = gain((Lr, POOL_WIDTH))
    pool_w_out = nrm((Lr, POOL_WIDTH, D_MODEL), POOL_WIDTH ** -0.5)
    conv_w = nrm((Lr, CONV_WIDTH, CONV_DIM), CONV_WIDTH ** -0.5)
    conv_b = nrm((Lr, CONV_DIM), 0.02)
    dt0 = jnp.exp(jax.random.uniform(next(ks), (Lr, N_SSD_HEADS), jnp.float32,
                                     minval=math.log(1e-3), maxval=math.log(1e-1)))
    dt_bias = dt0 + jnp.log(-jnp.expm1(-dt0))
    a_log = jnp.log(jax.random.uniform(next(ks), (Lr, N_SSD_HEADS), jnp.float32, minval=1.0, maxval=16.0))
    d_skip = gain((Lr, N_SSD_HEADS))
    ssd_norm = gain((Lr, D_INNER))
    ssd_w_out = nrm((Lr, D_INNER, D_MODEL), D_INNER ** -0.5)
    w_o = nrm((Lr, D_MODEL, D_MODEL), D_MODEL ** -0.5)
    norm_ffn2 = gain((Lr, D_MODEL))
    ffn2_w_in = nrm((Lr, D_MODEL, 2 * D_FF), D_MODEL ** -0.5)
    ffn2_w_out = nrm((Lr, D_FF, D_MODEL), D_FF ** -0.5)
    norm_final = gain((D_MODEL,))
    return {'x_prompt': x_prompt, 'x_sample': x_sample, 'state_pool': state_pool,
            'state_conv': state_conv, 'state_ssm': state_ssm, 'norm_ffn1': norm_ffn1,
            'ffn1_w_in': ffn1_w_in, 'ffn1_w_out': ffn1_w_out, 'norm_mix': norm_mix, 'w_in': w_in,
            'pool_w_group': pool_w_group, 'pool_scale': pool_scale, 'pool_w_out': pool_w_out,
            'conv_w': conv_w, 'conv_b': conv_b, 'dt_bias': dt_bias, 'a_log': a_log,
            'd_skip': d_skip, 'ssd_norm': ssd_norm, 'ssd_w_out': ssd_w_out, 'w_o': w_o,
            'norm_ffn2': norm_ffn2, 'ffn2_w_in': ffn2_w_in, 'ffn2_w_out': ffn2_w_out,
            'norm_final': norm_final}


def reference(x_prompt, x_sample, state_pool, state_conv, state_ssm, norm_ffn1, ffn1_w_in,
              ffn1_w_out, norm_mix, w_in, pool_w_group, pool_scale, pool_w_out, conv_w, conv_b,
              dt_bias, a_log, d_skip, ssd_norm, ssd_w_out, w_o, norm_ffn2, ffn2_w_in,
              ffn2_w_out, norm_final):
    def layer(x, pool_hist, out_pos0, conv_hist, h0, l):
        x = x + 0.5 * swiglu(rmsnorm(x, norm_ffn1[l]), ffn1_w_in[l], ffn1_w_out[l])
        mix, new_pool, new_conv, new_ssm = token_mixing(
            rmsnorm(x, norm_mix[l]), pool_hist, out_pos0, conv_hist, h0, w_in[l], pool_w_group[l],
            pool_scale[l], pool_w_out[l], conv_w[l], conv_b[l], dt_bias[l], a_log[l], d_skip[l],
            ssd_norm[l], ssd_w_out[l], w_o[l])
        x = x + mix
        x = x + 0.5 * swiglu(rmsnorm(x, norm_ffn2[l]), ffn2_w_in[l], ffn2_w_out[l])
        return x, new_pool, new_conv, new_ssm

    xp, xs = x_prompt, x_sample
    pp, cp, sp, ps, cs, ss = [], [], [], [], [], []
    for l in range(DEPTH):
        xp, a, b, c = layer(xp, jnp.zeros((BATCH, POOL_HIST, POOL_WIDTH), xp.dtype), 0,
                            jnp.zeros((BATCH, CONV_WIDTH - 1, CONV_DIM), xp.dtype),
                            jnp.zeros((BATCH, N_SSD_HEADS, SSD_HEAD_DIM, D_STATE), jnp.float32), l)
        pp.append(a); cp.append(b); sp.append(c)
        xs, d, e, f = layer(xs, state_pool[l], PAST_LEN, state_conv[l], state_ssm[l], l)
        ps.append(d); cs.append(e); ss.append(f)
    y_prompt = rmsnorm(xp, norm_final)
    y_sample = rmsnorm(xs, norm_final)
    return (y_prompt, y_sample, jnp.stack(pp), jnp.stack(cp), jnp.stack(sp),
            jnp.stack(ps), jnp.stack(cs), jnp.stack(ss))
```

```cpp
#include <hip/hip_runtime.h>
#include <cstdio>
#include <cstdint>
namespace pg8 {
#define PG8_LAS __attribute__((address_space(3)))
typedef unsigned short bf16_t;
typedef short bf16x8 __attribute__((ext_vector_type(8)));
typedef float f32x4 __attribute__((ext_vector_type(4)));
typedef unsigned u32x4 __attribute__((ext_vector_type(4)));
constexpr int BM = 256, BK = 64, HALF = 128, HTB = HALF * BK * 2  , STAGE_BYTES = 8 * HTB, NXCD = 8, WGM = 8;

__host__ __device__ __forceinline__ int lds_byte(int r, int c) { const int st = (r >> 4) * 2 + (c >> 5), rr = r & 15, cc = c & 31, ob = rr * 64 + cc * 2; return st * 1024 + (ob ^ (((ob >> 9) & 1) << 5)); }
__host__ __device__ __forceinline__ void stage_rc(int b, int& R, int& C) { const int st = b / 1024, sb = b % 1024, swz = sb ^ (((sb >> 9) & 1) << 5); R = (st >> 1) * 16 + swz / 64; C = (st & 1) * 32 + (swz % 64) / 2; }
__host__ __device__ __forceinline__ int perm32(int rho) { const int n = rho >> 4, i = rho & 15; return 8 * (i >> 2) + 4 * n + (i & 3); }

struct Unit { int pm, pn; };
struct Gemm { const bf16_t* A; const bf16_t* Bt; int M, N, K, lda, ldb, a_pn_off; };

struct StaticOrder {
    int nM, nN, nwg, G, c;
    __host__ __device__ void init(int M, int N, int G_, int c_) { nM = M / BM; nN = N / BM; nwg = nM * nN; G = G_; c = c_; }
    __host__ __device__ bool next(int i, Unit& u) const {
        const long L = (long)i * G + c; if (L >= nwg) return false;
        int wgid = (int)L; { const int q = nwg / NXCD, r = nwg % NXCD, xcd = wgid % NXCD, off = wgid / NXCD; wgid = (xcd < r ? xcd * (q + 1) : r * (q + 1) + (xcd - r) * q) + off; }
        const int nig = WGM * nN, gid = wgid / nig, fm = gid * WGM, gsz = (nM - fm) < WGM ? (nM - fm) : WGM;
        u.pm = fm + ((wgid % nig) % gsz); u.pn = (wgid % nig) / gsz; return true;
    }
    __device__ __forceinline__ void a_ready(const Unit&) const {}
    __device__ __forceinline__ void done(const Unit&) const {}
};

__device__ __forceinline__ unsigned cvt_pk_bf16(float lo, float hi) { unsigned r; asm volatile("v_cvt_pk_bf16_f32 %0, %1, %2" : "=v"(r) : "v"(lo), "v"(hi)); return r; }
typedef float f32x2 __attribute__((ext_vector_type(2)));
__device__ __forceinline__ float bf_lo(unsigned w) { return __uint_as_float(w << 16); }
__device__ __forceinline__ float bf_hi(unsigned w) { return __uint_as_float(w & 0xffff0000u); }
__device__ __forceinline__ float silu_f(float g) { return g * __builtin_amdgcn_rcpf(1.0f + __expf(-g)); }
__device__ __forceinline__ float sigm_f(float g) { return __builtin_amdgcn_rcpf(1.0f + __expf(-g)); }
__device__ __forceinline__ float rstd16(const float* ssq, int row) {
    const f32x4* p = (const f32x4*)(ssq + (size_t)row * 16);
    const f32x4 a = p[0], b = p[1], c = p[2], d = p[3];
    const float s = ((a[0] + a[1]) + (a[2] + a[3])) + ((b[0] + b[1]) + (b[2] + b[3])) + ((c[0] + c[1]) + (c[2] + c[3])) + ((d[0] + d[1]) + (d[2] + d[3]));
    return __builtin_amdgcn_rsqf(s * (1.0f / 1024.0f) + 1e-6f);
}
struct EpiSwiGLU {
    static constexpr bool PERM = true, AFTER_DRAIN = false;
    bf16_t* O; const float* ssq;
    __device__ __forceinline__ void operator()(const f32x4 (&acc)[2][2][4][2], const Unit& u, int wr, int wc, int fr, int fq) const {
#pragma unroll
        for (int ai = 0; ai < 2; ++ai)
#pragma unroll
            for (int m = 0; m < 4; ++m) {
                const int row = u.pm * BM + ai * HALF + wr * 64 + m * 16 + fr;
                float rs = 1.0f; if (ssq) rs = rstd16(ssq, row);
                const f32x4 g0 = acc[ai][0][m][0] * rs, g1 = acc[ai][0][m][1] * rs, u0 = acc[ai][1][m][0] * rs, u1 = acc[ai][1][m][1] * rs;
                u32x4 w;
                w.x = cvt_pk_bf16(silu_f(g0[0]) * u0[0], silu_f(g0[1]) * u0[1]); w.y = cvt_pk_bf16(silu_f(g0[2]) * u0[2], silu_f(g0[3]) * u0[3]);
                w.z = cvt_pk_bf16(silu_f(g1[0]) * u1[0], silu_f(g1[1]) * u1[1]); w.w = cvt_pk_bf16(silu_f(g1[2]) * u1[2], silu_f(g1[3]) * u1[3]);
                *(u32x4*)(O + (size_t)row * 2816 + u.pn * 128 + wc * 32 + fq * 8) = w;
            }
    }
};
struct EpiResid {
    static constexpr bool PERM = true, AFTER_DRAIN = false;
    const float* baseP; const float* baseS;
    float* X; bf16_t* XB; float* ssq; float scale;
    __device__ __forceinline__ void operator()(const f32x4 (&acc)[2][2][4][2], const Unit& u, int wr, int wc, int fr, int fq) const {
        const float* base = (u.pm < 64) ? baseP : baseS;
#pragma unroll
        for (int ai = 0; ai < 2; ++ai)
#pragma unroll
            for (int m = 0; m < 4; ++m) {
                const int row = u.pm * BM + ai * HALF + wr * 64 + m * 16 + fr;
                const size_t off = (size_t)row * 1024 + u.pn * BM + wc * 32 + fq * 8;
                float s = 0.f;
#pragma unroll
                for (int bj = 0; bj < 2; ++bj) {
                    const f32x4 b0 = *(const f32x4*)(base + off + bj * HALF), b1 = *(const f32x4*)(base + off + bj * HALF + 4);
                    const f32x4 v0 = b0 + acc[ai][bj][m][0] * scale, v1 = b1 + acc[ai][bj][m][1] * scale;
                    *(f32x4*)(X + off + bj * HALF) = v0; *(f32x4*)(X + off + bj * HALF + 4) = v1;
                    u32x4 w; w.x = cvt_pk_bf16(v0[0], v0[1]); w.y = cvt_pk_bf16(v0[2], v0[3]); w.z = cvt_pk_bf16(v1[0], v1[1]); w.w = cvt_pk_bf16(v1[2], v1[3]);
                    *(u32x4*)(XB + off + bj * HALF) = w;
                    s += (v0[0] * v0[0] + v0[1] * v0[1]) + (v0[2] * v0[2] + v0[3] * v0[3]) + (v1[0] * v1[0] + v1[1] * v1[1]) + (v1[2] * v1[2] + v1[3] * v1[3]);
                }
                s += __shfl_xor(s, 16); s += __shfl_xor(s, 32);
                if (fq == 0) ssq[(size_t)row * 16 + u.pn * 4 + wc] = s;
            }
    }
};
struct EpiInProj {
    static constexpr bool PERM = true, AFTER_DRAIN = false;
    bf16_t* U; bf16_t* Z; bf16_t* XBC; bf16_t* GL; float* DT; const float* dt_bias; const float* ssq;
    __device__ __forceinline__ void operator()(const f32x4 (&acc)[2][2][4][2], const Unit& u, int wr, int wc, int fr, int fq) const {
        bf16_t* O; int ldc, colt;
        if (u.pn < 4) { O = U; ldc = 1024; colt = u.pn * 256; }
        else if (u.pn < 12) { O = Z; ldc = 2048; colt = (u.pn - 4) * 256; }
        else if (u.pn < 24) { O = XBC; ldc = 3072; colt = (u.pn - 12) * 256; }
        else { O = GL; ldc = 2048; colt = (u.pn - 24) * 256; }
        const bool isdt = (u.pn == 32);
#pragma unroll
        for (int ai = 0; ai < 2; ++ai)
#pragma unroll
            for (int m = 0; m < 4; ++m) {
                const int row = u.pm * BM + ai * HALF + wr * 64 + m * 16 + fr;
                const float rs = rstd16(ssq, row);
                if (!isdt) {
#pragma unroll
                    for (int bj = 0; bj < 2; ++bj) {
                        const f32x4 v0 = acc[ai][bj][m][0] * rs, v1 = acc[ai][bj][m][1] * rs;
                        u32x4 w; w.x = cvt_pk_bf16(v0[0], v0[1]); w.y = cvt_pk_bf16(v0[2], v0[3]); w.z = cvt_pk_bf16(v1[0], v1[1]); w.w = cvt_pk_bf16(v1[2], v1[3]);
                        *(u32x4*)(O + (size_t)row * ldc + colt + bj * HALF + wc * 32 + fq * 8) = w;
                    }
                } else if (wc == 0) {
                    const int c = fq * 8;
                    const f32x4 bb0 = *(const f32x4*)(dt_bias + c), bb1 = *(const f32x4*)(dt_bias + c + 4);
                    f32x4 v0 = acc[ai][0][m][0] * rs + bb0, v1 = acc[ai][0][m][1] * rs + bb1;
#pragma unroll
                    for (int i = 0; i < 4; ++i) { v0[i] = v0[i] > 20.f ? v0[i] : log1pf(__expf(v0[i])); v1[i] = v1[i] > 20.f ? v1[i] : log1pf(__expf(v1[i])); }
                    *(f32x4*)(DT + (size_t)row * 32 + c) = v0; *(f32x4*)(DT + (size_t)row * 32 + c + 4) = v1;
                }
            }
    }
};
struct EpiPlain {
    static constexpr bool PERM = true, AFTER_DRAIN = false;
    bf16_t* O;
    __device__ __forceinline__ void operator()(const f32x4 (&acc)[2][2][4][2], const Unit& u, int wr, int wc, int fr, int fq) const {
#pragma unroll
        for (int ai = 0; ai < 2; ++ai)
#pragma unroll
            for (int m = 0; m < 4; ++m) {
                const int row = u.pm * BM + ai * HALF + wr * 64 + m * 16 + fr;
#pragma unroll
                for (int bj = 0; bj < 2; ++bj) {
                    const f32x4 v0 = acc[ai][bj][m][0], v1 = acc[ai][bj][m][1];
                    u32x4 w; w.x = cvt_pk_bf16(v0[0], v0[1]); w.y = cvt_pk_bf16(v0[2], v0[3]); w.z = cvt_pk_bf16(v1[0], v1[1]); w.w = cvt_pk_bf16(v1[2], v1[3]);
                    *(u32x4*)(O + (size_t)row * 1024 + u.pn * BM + bj * HALF + wc * 32 + fq * 8) = w;
                }
            }
    }
};
struct EpiMerge {
    static constexpr bool PERM = true, AFTER_DRAIN = false;
    const bf16_t* GL; const bf16_t* BP; bf16_t* O;
    __device__ __forceinline__ void operator()(const f32x4 (&acc)[2][2][4][2], const Unit& u, int wr, int wc, int fr, int fq) const {
#pragma unroll
        for (int ai = 0; ai < 2; ++ai)
#pragma unroll
            for (int m = 0; m < 4; ++m) {
                const int row = u.pm * BM + ai * HALF + wr * 64 + m * 16 + fr;
#pragma unroll
                for (int bj = 0; bj < 2; ++bj) {
                    const int col = u.pn * BM + bj * HALF + wc * 32 + fq * 8;
                    const u32x4 g0 = *(const u32x4*)(GL + (size_t)row * 2048 + col), g1 = *(const u32x4*)(GL + (size_t)row * 2048 + 1024 + col), bp = *(const u32x4*)(BP + (size_t)row * 1024 + col);
                    const f32x4 a0 = acc[ai][bj][m][0], a1 = acc[ai][bj][m][1];
                    u32x4 w;
                    w.x = cvt_pk_bf16(sigm_f(bf_lo(g0.x)) * bf_lo(bp.x) + sigm_f(bf_lo(g1.x)) * a0[0], sigm_f(bf_hi(g0.x)) * bf_hi(bp.x) + sigm_f(bf_hi(g1.x)) * a0[1]);
                    w.y = cvt_pk_bf16(sigm_f(bf_lo(g0.y)) * bf_lo(bp.y) + sigm_f(bf_lo(g1.y)) * a0[2], sigm_f(bf_hi(g0.y)) * bf_hi(bp.y) + sigm_f(bf_hi(g1.y)) * a0[3]);
                    w.z = cvt_pk_bf16(sigm_f(bf_lo(g0.z)) * bf_lo(bp.z) + sigm_f(bf_lo(g1.z)) * a1[0], sigm_f(bf_hi(g0.z)) * bf_hi(bp.z) + sigm_f(bf_hi(g1.z)) * a1[1]);
                    w.w = cvt_pk_bf16(sigm_f(bf_lo(g0.w)) * bf_lo(bp.w) + sigm_f(bf_lo(g1.w)) * a1[2], sigm_f(bf_hi(g0.w)) * bf_hi(bp.w) + sigm_f(bf_hi(g1.w)) * a1[3]);
                    *(u32x4*)(O + (size_t)row * 1024 + col) = w;
                }
            }
    }
};

template <class Epi, class Sched, bool ALIGN_EPI = false, bool SP2 = false>
__device__ __forceinline__ void gemm_phase(PG8_LAS unsigned char* lds, const Gemm g, const Sched& S, const Epi& E) {
    const int tid = threadIdx.x, wid = __builtin_amdgcn_readfirstlane(tid >> 6), lane = tid & 63, wr = wid >> 2, wc = wid & 3, fr = lane & 15, fq = lane >> 4;
    const int K = g.K, nt = K / BK;
    unsigned voffA[2], voffB[2];
#pragma unroll
    for (int i = 0; i < 2; ++i) { int R, C; stage_rc(tid * 16 + i * 8192, R, C); const int Rb = Epi::PERM ? ((R & ~31) + perm32(R & 31)) : R;
        voffA[i] = (unsigned)(R * g.lda + C) * 2u; voffB[i] = (unsigned)(Rb * g.ldb + C) * 2u; }
    const size_t kstep = (size_t)(BK * 2);
    const size_t hstepA = (size_t)HALF * g.lda * 2, hstepB = (size_t)HALF * g.ldb * 2;
    const size_t tstepA = 2 * hstepA, tstepB = 2 * hstepB; const size_t pnoffA = (size_t)g.a_pn_off * 2;
    const unsigned ldsw = (unsigned)wid * 1024u;
    const int aoff = lds_byte(wr * 64 + fr, fq * 8), boff = lds_byte(wc * 32 + fr, fq * 8);
#define PG8_SA(b, h) (((b) * 2 + (h)) * HTB)
#define PG8_SB(b, h) ((4 + (b) * 2 + (h)) * HTB)
#define PG8_STAGE(bufoff, gbase, voff) do { _Pragma("unroll") for (int _i = 0; _i < 2; ++_i) \
        __builtin_amdgcn_global_load_lds((const unsigned*)((const char*)(gbase) + (voff)[_i]), (PG8_LAS unsigned*)(lds + (bufoff) + ldsw + _i * 8192), 16, 0, 0); } while (0)
#define PG8_LDA(dst, b, h) do { _Pragma("unroll") for (int m = 0; m < 4; ++m) _Pragma("unroll") for (int k = 0; k < 2; ++k) dst[m][k] = *(const PG8_LAS bf16x8*)(lds + PG8_SA(b, h) + aoff + m * 2048 + k * 1024); } while (0)
#define PG8_LDB(dst, b, h) do { _Pragma("unroll") for (int n = 0; n < 2; ++n) _Pragma("unroll") for (int k = 0; k < 2; ++k) dst[n][k] = *(const PG8_LAS bf16x8*)(lds + PG8_SB(b, h) + boff + n * 2048 + k * 1024); } while (0)
#define PG8_MMA(ai, bj, At, Bt) do { __builtin_amdgcn_s_setprio(1); _Pragma("unroll") for (int m = 0; m < 4; ++m) _Pragma("unroll") for (int n = 0; n < 2; ++n) _Pragma("unroll") for (int k = 0; k < 2; ++k) \
        acc[ai][bj][m][n] = __builtin_amdgcn_mfma_f32_16x16x32_bf16(Bt[n][k], At[m][k], acc[ai][bj][m][n], 0, 0, 0); __builtin_amdgcn_s_setprio(0); } while (0)
#define PG8_WAIT_V(n) asm volatile("s_waitcnt vmcnt(" #n ")" ::: "memory")
#define PG8_WAIT_L(n) asm volatile("s_waitcnt lgkmcnt(" #n ")" ::: "memory")
#define PG8_BAR __builtin_amdgcn_s_barrier()
#define PG8_SCHED __builtin_amdgcn_sched_barrier(0)
    Unit cur, nxt; int ui = 0;
    if (!S.next(0, cur)) return;
    f32x4 acc[2][2][4][2];
#pragma unroll
    for (int a = 0; a < 2; ++a)
#pragma unroll
        for (int b = 0; b < 2; ++b)
#pragma unroll
            for (int m = 0; m < 4; ++m)
#pragma unroll
                for (int n = 0; n < 2; ++n) acc[a][b][m][n] = (f32x4){0.f, 0.f, 0.f, 0.f};
    bf16x8 At[4][2], B0[2][2], B1[2][2];
    const char* cA = (const char*)g.A + (size_t)cur.pm * tstepA + (size_t)cur.pn * pnoffA; const char* cB = (const char*)g.Bt + (size_t)cur.pn * tstepB;
    S.a_ready(cur);
    if constexpr (SP2) {
        PG8_STAGE(PG8_SB(0, 0), cB, voffB); PG8_STAGE(PG8_SB(0, 1), cB + hstepB, voffB); PG8_STAGE(PG8_SA(0, 0), cA, voffA); PG8_STAGE(PG8_SA(0, 1), cA + hstepA, voffA);
        if (wr == 1) PG8_BAR;
        PG8_WAIT_V(2); PG8_BAR;
        PG8_STAGE(PG8_SB(1, 0), cB + kstep, voffB); PG8_STAGE(PG8_SA(1, 0), cA + kstep, voffA); PG8_STAGE(PG8_SB(1, 1), cB + hstepB + kstep, voffB);
        PG8_WAIT_V(6); PG8_BAR;
    } else {
        PG8_STAGE(PG8_SB(0, 0), cB, voffB); PG8_STAGE(PG8_SA(0, 0), cA, voffA); PG8_STAGE(PG8_SB(0, 1), cB + hstepB, voffB); PG8_STAGE(PG8_SA(0, 1), cA + hstepA, voffA);
        if (wr == 1) PG8_BAR;
        PG8_WAIT_V(4); PG8_BAR;
        PG8_STAGE(PG8_SB(1, 0), cB + kstep, voffB); PG8_STAGE(PG8_SA(1, 0), cA + kstep, voffA); PG8_STAGE(PG8_SB(1, 1), cB + hstepB + kstep, voffB);
        PG8_WAIT_V(6); PG8_BAR;
    }
    for (;;) {
        const bool has_next = S.next(ui + 1, nxt);
        const char* nA = has_next ? (const char*)g.A + (size_t)nxt.pm * tstepA + (size_t)nxt.pn * pnoffA : cA; const char* nB = has_next ? (const char*)g.Bt + (size_t)nxt.pn * tstepB : cB;
        for (int t = 0; t < nt; t += 2) {
            const bool last = (t == nt - 2);
            const char* a1 = cA + (size_t)(t + 1) * kstep;
            const char* a2 = last ? nA : cA + (size_t)(t + 2) * kstep; const char* b2 = last ? nB : cB + (size_t)(t + 2) * kstep;
            const char* a3 = a2 + kstep; const char* b3 = b2 + kstep;
            if (last && has_next) S.a_ready(nxt);
            if constexpr (SP2) {
            PG8_LDB(B0, 0, 0); PG8_LDB(B1, 0, 1); PG8_SCHED; PG8_LDA(At, 0, 0); PG8_STAGE(PG8_SA(1, 1), a1 + hstepA, voffA);
            PG8_WAIT_V(8); PG8_WAIT_L(0); PG8_BAR; PG8_MMA(0, 0, At, B0); PG8_MMA(0, 1, At, B1); PG8_BAR; PG8_SCHED;
            PG8_LDA(At, 0, 1); PG8_STAGE(PG8_SB(0, 0), b2, voffB); PG8_STAGE(PG8_SB(0, 1), b2 + hstepB, voffB); PG8_STAGE(PG8_SA(0, 0), a2, voffA);
            PG8_WAIT_V(8); PG8_WAIT_L(0); PG8_BAR; PG8_MMA(1, 0, At, B0); PG8_MMA(1, 1, At, B1); PG8_BAR; PG8_SCHED;
            PG8_LDB(B0, 1, 0); PG8_LDB(B1, 1, 1); PG8_SCHED; PG8_LDA(At, 1, 0); PG8_STAGE(PG8_SA(0, 1), a2 + hstepA, voffA);
            PG8_WAIT_V(8); PG8_WAIT_L(0); PG8_BAR; PG8_MMA(0, 0, At, B0); PG8_MMA(0, 1, At, B1); PG8_BAR; PG8_SCHED;
            PG8_LDA(At, 1, 1); PG8_STAGE(PG8_SB(1, 0), b3, voffB); PG8_STAGE(PG8_SB(1, 1), b3 + hstepB, voffB); PG8_STAGE(PG8_SA(1, 0), a3, voffA);
            PG8_WAIT_V(8); PG8_WAIT_L(0); PG8_BAR; PG8_MMA(1, 0, At, B0); PG8_MMA(1, 1, At, B1); PG8_BAR; PG8_SCHED;
            } else {
            PG8_LDB(B0, 0, 0); PG8_SCHED; PG8_LDA(At, 0, 0); PG8_STAGE(PG8_SA(1, 1), a1 + hstepA, voffA);
            PG8_WAIT_L(8); PG8_BAR; PG8_WAIT_L(0); PG8_MMA(0, 0, At, B0); PG8_BAR; PG8_SCHED;
            PG8_LDB(B1, 0, 1); PG8_STAGE(PG8_SB(0, 0), b2, voffB);
            PG8_BAR; PG8_WAIT_L(0); PG8_MMA(0, 1, At, B1); PG8_BAR;
            PG8_LDA(At, 0, 1); PG8_STAGE(PG8_SA(0, 0), a2, voffA);
            PG8_BAR; PG8_WAIT_L(0); PG8_MMA(1, 0, At, B0); PG8_BAR; PG8_SCHED;
            PG8_STAGE(PG8_SB(0, 1), b2 + hstepB, voffB);
            PG8_WAIT_V(6); PG8_BAR; PG8_MMA(1, 1, At, B1); PG8_BAR;
            PG8_LDB(B0, 1, 0); PG8_SCHED; PG8_LDA(At, 1, 0); PG8_STAGE(PG8_SA(0, 1), a2 + hstepA, voffA);
            PG8_WAIT_L(8); PG8_BAR; PG8_WAIT_L(0); PG8_MMA(0, 0, At, B0); PG8_BAR; PG8_SCHED;
            PG8_LDB(B1, 1, 1); PG8_STAGE(PG8_SB(1, 0), b3, voffB);
            PG8_BAR; PG8_WAIT_L(0); PG8_MMA(0, 1, At, B1); PG8_BAR;
            PG8_LDA(At, 1, 1); PG8_STAGE(PG8_SA(1, 0), a3, voffA);
            PG8_BAR; PG8_WAIT_L(0); PG8_MMA(1, 0, At, B0); PG8_BAR; PG8_SCHED;
            PG8_STAGE(PG8_SB(1, 1), b3 + hstepB, voffB);
            PG8_WAIT_V(6); PG8_BAR; PG8_MMA(1, 1, At, B1); PG8_BAR;
            }
        }
        if constexpr (ALIGN_EPI) { if (wr == 0) PG8_BAR; }
        if constexpr (!Epi::AFTER_DRAIN) { E(acc, cur, wr, wc, fr, fq); S.done(cur); }
        if (!has_next) break;
#pragma unroll
        for (int a = 0; a < 2; ++a)
#pragma unroll
            for (int b = 0; b < 2; ++b)
#pragma unroll
                for (int m = 0; m < 4; ++m)
#pragma unroll
                    for (int n = 0; n < 2; ++n) acc[a][b][m][n] = (f32x4){0.f, 0.f, 0.f, 0.f};
        cur = nxt; cA = nA; cB = nB; ++ui;
        if constexpr (ALIGN_EPI) { if (wr == 1) PG8_BAR; }
    }
    PG8_WAIT_V(0);
    if constexpr (!ALIGN_EPI) { if (wr == 0) PG8_BAR; }
    PG8_BAR;
    if constexpr (Epi::AFTER_DRAIN) { E.fused(acc, cur, wr, wc, fr, fq, lds, wid, lane); S.done(cur); }
#undef PG8_SA
#undef PG8_SB
#undef PG8_STAGE
#undef PG8_LDA
#undef PG8_LDB
#undef PG8_MMA
#undef PG8_WAIT_V
#undef PG8_WAIT_L
#undef PG8_BAR
#undef PG8_SCHED
}
}

#include <hip/hip_cooperative_groups.h>
namespace cg = cooperative_groups;
#ifndef ONE_LAUNCH
#define ONE_LAUNCH 1
#endif
#define LAS __attribute__((address_space(3)))
typedef unsigned short bf16;
typedef unsigned u32x4 __attribute__((ext_vector_type(4)));
typedef unsigned u32x2 __attribute__((ext_vector_type(2)));
typedef float f32x4 __attribute__((ext_vector_type(4)));
typedef short bf16x8 __attribute__((ext_vector_type(8)));
constexpr int NWAVES = 8, NTHR = 512;
constexpr int MP = 16384, MS = 1024, M = MP + MS;
constexpr int D = 1024, FF = 2816, NPROJ = 8224, NPROJ_PAD = 8448;
constexpr float EPS = 1e-6f;
constexpr int N_PHASES = 12;
constexpr size_t O_Y = 0, O_PP = 17825792, O_CP = 17948672, O_SP = 18022400, O_PS = 20119552, O_CS = 22085632, O_SS = 23265280, O_END = 56819712;
constexpr size_t MiB = 1u << 20;
constexpr size_t WS_W1A = 0, WS_W1B = 11 * MiB, WS_WIN = WS_W1B + 5632 * 1024, WS_WPG = WS_WIN + (size_t)NPROJ_PAD * 1024 * 2, WS_WPO = WS_WPG + 512 * 1024, WS_WSO = WS_WPO + 2 * MiB,
                 WS_WO = WS_WSO + 4 * MiB, WS_W2A = WS_WO + 2 * MiB, WS_W2B = WS_W2A + 11 * MiB, WS_WEND = WS_W2B + 5632 * 1024;
constexpr size_t SZ1K = (size_t)M * 1024 * 2, SZ2K = 2 * SZ1K, SZ3K = 3 * SZ1K;
constexpr size_t WS_SMALL = 58 * MiB;
constexpr size_t WS_SSQ = WS_SMALL, WS_DT = WS_SSQ + (size_t)M * 16 * 4, WS_SMALL_END = WS_DT + (size_t)M * 32 * 4;
constexpr size_t WS_XB = 62 * MiB;
constexpr size_t WS_RA = WS_XB + SZ1K;
constexpr size_t WS_RB = WS_RA + SZ3K;
constexpr size_t WS_RC = WS_RB + SZ3K;
constexpr size_t WS_RD = WS_RC + SZ1K;
constexpr size_t WS_RE = WS_RD + SZ2K;
constexpr size_t WS_RF = WS_RE + SZ2K;
constexpr size_t WS_END = WS_RF + SZ1K;
static_assert(WS_WEND <= WS_SMALL && WS_SMALL_END <= WS_XB && WS_END <= 512 * MiB, "d_ws map");
constexpr int LDS_BYTES = 158720;

__device__ __forceinline__ unsigned f2bf(float f) { unsigned u = __float_as_uint(f); return (u + 0x7fffu + ((u >> 16) & 1u)) >> 16; }
__device__ __forceinline__ unsigned pk2(float lo, float hi) { return f2bf(lo) | (f2bf(hi) << 16); }
__device__ __forceinline__ float bflo(unsigned w) { return __uint_as_float(w << 16); }
__device__ __forceinline__ float bfhi(unsigned w) { return __uint_as_float(w & 0xffff0000u); }
__device__ __forceinline__ float bf2f(bf16 v) { return __uint_as_float((unsigned)v << 16); }
__device__ __forceinline__ float wave_sum(float v) {
#pragma unroll
    for (int o = 1; o < 64; o <<= 1) v += __shfl_xor(v, o);
    return v;
}
#define LDS_WAIT() asm volatile("s_waitcnt lgkmcnt(0)" ::: "memory")
struct F8 { float v[8]; };
__device__ __forceinline__ F8 unpack8(u32x4 w) { F8 r; r.v[0] = bflo(w.x); r.v[1] = bfhi(w.x); r.v[2] = bflo(w.y); r.v[3] = bfhi(w.y); r.v[4] = bflo(w.z); r.v[5] = bfhi(w.z); r.v[6] = bflo(w.w); r.v[7] = bfhi(w.w); return r; }
__device__ __forceinline__ u32x4 pack8(const F8& a) { u32x4 w; w.x = pk2(a.v[0], a.v[1]); w.y = pk2(a.v[2], a.v[3]); w.z = pk2(a.v[4], a.v[5]); w.w = pk2(a.v[6], a.v[7]); return w; }
__device__ __forceinline__ F8 loadf8(const float* p) { const f32x4 a = *(const f32x4*)p, b = *(const f32x4*)(p + 4); F8 r; r.v[0] = a[0]; r.v[1] = a[1]; r.v[2] = a[2]; r.v[3] = a[3]; r.v[4] = b[0]; r.v[5] = b[1]; r.v[6] = b[2]; r.v[7] = b[3]; return r; }
__device__ __forceinline__ void storef8(float* p, const F8& a) { *(f32x4*)p = (f32x4){a.v[0], a.v[1], a.v[2], a.v[3]}; *(f32x4*)(p + 4) = (f32x4){a.v[4], a.v[5], a.v[6], a.v[7]}; }
__device__ __forceinline__ F8 zero8() { F8 r;
#pragma unroll
    for (int i = 0; i < 8; ++i) r.v[i] = 0.f;
    return r; }

struct Args { const float* in[25]; float* out; unsigned char* ws; int ph_lo, ph_hi; };
enum { I_XP = 0, I_XS, I_SPOOL, I_SCONV, I_SSSM, I_NF1, I_F1IN, I_F1OUT, I_NMIX, I_WIN, I_PWG, I_PSC, I_PWO, I_CW, I_CB, I_DTB, I_ALOG, I_DSKIP, I_SNORM, I_SWO, I_WO, I_NF2, I_F2IN, I_F2OUT, I_NFIN };

__device__ __forceinline__ void p0_item(const float* W, int K, int N, bf16* WT, int row_off, int mode, const float* gain, LAS float* scr, int item, int lane) {
    const int nblk = N / 32, kb = item / nblk, nb = item % nblk, k0 = 64 * kb, n0 = 32 * nb;
#pragma unroll 8
    for (int i = 0; i < 32; ++i) { const int kk = 2 * i + (lane >> 5); const float gk = gain ? gain[k0 + kk] : 1.0f; scr[kk * 33 + (lane & 31)] = W[(size_t)(k0 + kk) * N + n0 + (lane & 31)] * gk; }
    LDS_WAIT(); asm volatile("" ::: "memory");
    int dr = n0;
    if (mode == 1) { if (n0 < FF) dr = (n0 >> 7) * 256 + (n0 & 127); else { const int j = n0 - FF; dr = (j >> 7) * 256 + 128 + (j & 127); } }
    else if (mode == 2) { if (n0 >= 6176) dr = n0 - 32; else if (n0 >= 6144) dr = 8192 + (n0 - 6144); }
    const int c = lane & 7;
#pragma unroll
    for (int j = 0; j < 4; ++j) { const int n = (lane >> 3) + 8 * j; const LAS float* s = scr + (8 * c) * 33 + n;
        u32x4 o; o.x = pk2(s[0 * 33], s[1 * 33]); o.y = pk2(s[2 * 33], s[3 * 33]); o.z = pk2(s[4 * 33], s[5 * 33]); o.w = pk2(s[6 * 33], s[7 * 33]);
        *(u32x4*)(WT + (size_t)(row_off + dr + n) * K + k0 + 8 * c) = o; }
    LDS_WAIT(); asm volatile("" ::: "memory");
}
__device__ __forceinline__ void phase0(const Args& a, LAS unsigned char* lds, int G, int tid) {
    const int lane = tid & 63, wave = __builtin_amdgcn_readfirstlane(tid >> 6);
    LAS float* scr = (LAS float*)(lds + wave * 16384);
    const int gw = blockIdx.x * NWAVES + wave, NGW = G * NWAVES;
    unsigned char* ws = a.ws;
    constexpr int I1A = 16 * 176, I1B = 44 * 32, IIN = 16 * 257, IPG = 4 * 32, IPO = 16 * 32, ISO = 32 * 32, IWO = 16 * 32;
    constexpr int NITEMS = 2 * I1A + 2 * I1B + IIN + IPG + IPO + ISO + IWO;
    for (int it = gw; it < NITEMS; it += NGW) {
        int r = it;
        if (r < I1A) { p0_item(a.in[I_F1IN], D, 2 * FF, (bf16*)(ws + WS_W1A), 0, 1, a.in[I_NF1], scr, r, lane); continue; } r -= I1A;
        if (r < I1A) { p0_item(a.in[I_F2IN], D, 2 * FF, (bf16*)(ws + WS_W2A), 0, 1, a.in[I_NF2], scr, r, lane); continue; } r -= I1A;
        if (r < IIN) { p0_item(a.in[I_WIN], D, NPROJ, (bf16*)(ws + WS_WIN), 0, 2, a.in[I_NMIX], scr, r, lane); continue; } r -= IIN;
        if (r < I1B) { p0_item(a.in[I_F1OUT], FF, D, (bf16*)(ws + WS_W1B), 0, 0, nullptr, scr, r, lane); continue; } r -= I1B;
        if (r < I1B) { p0_item(a.in[I_F2OUT], FF, D, (bf16*)(ws + WS_W2B), 0, 0, nullptr, scr, r, lane); continue; } r -= I1B;
        if (r < IPG) { const int g = r >> 5; p0_item(a.in[I_PWG] + (size_t)g * 65536, 256, 256, (bf16*)(ws + WS_WPG), g * 256, 0, nullptr, scr, r & 31, lane); continue; } r -= IPG;
        if (r < IPO) { p0_item(a.in[I_PWO], D, D, (bf16*)(ws + WS_WPO), 0, 0, a.in[I_PSC], scr, r, lane); continue; } r -= IPO;
        if (r < ISO) { p0_item(a.in[I_SWO], 2048, D, (bf16*)(ws + WS_WSO), 0, 0, a.in[I_SNORM], scr, r, lane); continue; } r -= ISO;
        p0_item(a.in[I_WO], D, D, (bf16*)(ws + WS_WO), 0, 0, nullptr, scr, r, lane);
    }
    { u32x4* z = (u32x4*)(ws + WS_WIN + (size_t)NPROJ * 1024 * 2); const int n16 = (NPROJ_PAD - NPROJ) * 1024 * 2 / 16;
      for (int i = blockIdx.x * NTHR + tid; i < n16; i += G * NTHR) z[i] = (u32x4){0u, 0u, 0u, 0u}; }
    bf16* XN = (bf16*)(ws + WS_XB);
    for (int m = gw; m < M; m += NGW) {
        const float* xrow = (m < MP) ? a.in[I_XP] + (size_t)m * D : a.in[I_XS] + (size_t)(m - MP) * D;
        const f32x4* xr = (const f32x4*)xrow + lane;
        f32x4 v[4]; float s = 0.f;
#pragma unroll
        for (int j = 0; j < 4; ++j) { v[j] = xr[64 * j]; s += (v[j][0] * v[j][0] + v[j][1] * v[j][1]) + (v[j][2] * v[j][2] + v[j][3] * v[j][3]); }
        const float rstd = __builtin_amdgcn_rsqf(wave_sum(s) * (1.f / D) + EPS);
        u32x2* o8 = (u32x2*)(XN + (size_t)m * D) + lane;
#pragma unroll
        for (int j = 0; j < 4; ++j) { u32x2 w; w.x = pk2(v[j][0] * rstd, v[j][1] * rstd); w.y = pk2(v[j][2] * rstd, v[j][3] * rstd); o8[64 * j] = w; }
    }
}

__device__ __forceinline__ void phase4(const Args& a, int G, int tid) {
    unsigned char* ws = a.ws;
    const bf16* U = (const bf16*)(ws + WS_RC); const bf16* XBC = (const bf16*)(ws + WS_RA);
    bf16* Dp = (bf16*)(ws + WS_RF); bf16* XC = (bf16*)(ws + WS_RB);
    const float* spool = a.in[I_SPOOL]; const float* sconv = a.in[I_SCONV];
    const int gt = blockIdx.x * NTHR + tid, NT = G * NTHR;
    for (int u = gt; u < 65536 + 16384; u += NT) {
        const bool smp = u >= 65536; int b, t0, nrows, slab;
        if (!smp) { slab = u & 127; t0 = ((u >> 7) & 63) * 32; b = u >> 13; nrows = 32; }
        else { const int v = u - 65536; slab = v & 127; b = v >> 7; t0 = 0; nrows = 8; }
        const int c0 = slab * 8, w = 2 << (c0 >> 8);
        const size_t rowbase = smp ? (size_t)MP + b * 8 : (size_t)b * 2048;
        F8 s = zero8();
        for (int j = 1; j < w; ++j) {
            const int i = t0 - j;
            if (i >= 0) { const F8 x = unpack8(*(const u32x4*)(U + (rowbase + i) * 1024 + c0));
#pragma unroll
                for (int e = 0; e < 8; ++e) s.v[e] += x.v[e]; }
            else if (smp) { const F8 x = loadf8(spool + ((size_t)b * 15 + 15 + i) * 1024 + c0);
#pragma unroll
                for (int e = 0; e < 8; ++e) s.v[e] += x.v[e]; }
        }
        for (int t = t0; t < t0 + nrows; ++t) {
            const F8 cur = unpack8(*(const u32x4*)(U + (rowbase + t) * 1024 + c0));
            const float cnt = smp ? (float)w : (float)((t + 1 < w) ? t + 1 : w);
            F8 d;
#pragma unroll
            for (int e = 0; e < 8; ++e) { s.v[e] += cur.v[e]; d.v[e] = s.v[e] / cnt - cur.v[e]; }
            *(u32x4*)(Dp + (rowbase + t) * 1024 + c0) = pack8(d);
            const int i = t - w + 1;
            if (i >= 0) { const F8 x = unpack8(*(const u32x4*)(U + (rowbase + i) * 1024 + c0));
#pragma unroll
                for (int e = 0; e < 8; ++e) s.v[e] -= x.v[e]; }
            else if (smp) { const F8 x = loadf8(spool + ((size_t)b * 15 + 15 + i) * 1024 + c0);
#pragma unroll
                for (int e = 0; e < 8; ++e) s.v[e] -= x.v[e]; }
        }
    }
    const float* cw = a.in[I_CW]; const float* cb = a.in[I_CB];
    for (int u = gt; u < 196608 + 49152; u += NT) {
        const bool smp = u >= 196608; int b, t0, nrows, slab;
        if (!smp) { slab = u % 384; const int q = u / 384; t0 = (q & 63) * 32; b = q >> 6; nrows = 32; }
        else { const int v = u - 196608; slab = v % 384; b = v / 384; t0 = 0; nrows = 8; }
        const int c0 = slab * 8;
        const size_t rowbase = smp ? (size_t)MP + b * 8 : (size_t)b * 2048;
        const F8 w0 = loadf8(cw + c0), w1 = loadf8(cw + 3072 + c0), w2 = loadf8(cw + 6144 + c0), w3 = loadf8(cw + 9216 + c0), bi = loadf8(cb + c0);
        F8 xm3, xm2, xm1;
        if (smp) { xm3 = loadf8(sconv + ((size_t)b * 3 + 0) * 3072 + c0); xm2 = loadf8(sconv + ((size_t)b * 3 + 1) * 3072 + c0); xm1 = loadf8(sconv + ((size_t)b * 3 + 2) * 3072 + c0); }
        else if (t0 == 0) { xm3 = zero8(); xm2 = zero8(); xm1 = zero8(); }
        else { xm3 = unpack8(*(const u32x4*)(XBC + (rowbase + t0 - 3) * 3072 + c0)); xm2 = unpack8(*(const u32x4*)(XBC + (rowbase + t0 - 2) * 3072 + c0)); xm1 = unpack8(*(const u32x4*)(XBC + (rowbase + t0 - 1) * 3072 + c0)); }
        for (int t = t0; t < t0 + nrows; ++t) {
            const F8 cur = unpack8(*(const u32x4*)(XBC + (rowbase + t) * 3072 + c0));
            F8 y;
#pragma unroll
            for (int e = 0; e < 8; ++e) { const float v = bi.v[e] + xm3.v[e] * w0.v[e] + xm2.v[e] * w1.v[e] + xm1.v[e] * w2.v[e] + cur.v[e] * w3.v[e]; y.v[e] = v / (1.0f + __expf(-v)); }
            *(u32x4*)(XC + (rowbase + t) * 3072 + c0) = pack8(y);
            xm3 = xm2; xm2 = xm1; xm1 = cur;
        }
    }
    for (int u = gt; u < (8 + 128) * 15 * 128; u += NT) {
        const int slab = u & 127, rj = u >> 7, c0 = slab * 8;
        if (rj < 120) { const int b = rj / 15, j = rj % 15;
            storef8(a.out + O_PP + ((size_t)b * 15 + j) * 1024 + c0, unpack8(*(const u32x4*)(U + ((size_t)b * 2048 + 2033 + j) * 1024 + c0))); }
        else { const int r2 = rj - 120, b = r2 / 15, j = r2 % 15;
            const F8 v = (j < 7) ? loadf8(spool + ((size_t)b * 15 + 8 + j) * 1024 + c0) : unpack8(*(const u32x4*)(U + ((size_t)MP + b * 8 + (j - 7)) * 1024 + c0));
            storef8(a.out + O_PS + ((size_t)b * 15 + j) * 1024 + c0, v); }
    }
    for (int u = gt; u < (8 + 128) * 3 * 384; u += NT) {
        const int slab = u % 384, rj = u / 384, c0 = slab * 8;
        if (rj < 24) { const int b = rj / 3, j = rj % 3;
            storef8(a.out + O_CP + ((size_t)b * 3 + j) * 3072 + c0, unpack8(*(const u32x4*)(XBC + ((size_t)b * 2048 + 2045 + j) * 3072 + c0))); }
        else { const int r2 = rj - 24, b = r2 / 3, j = r2 % 3;
            storef8(a.out + O_CS + ((size_t)b * 3 + j) * 3072 + c0, unpack8(*(const u32x4*)(XBC + ((size_t)MP + b * 8 + 5 + j) * 3072 + c0))); }
    }
}

#define MFMA16(p, q, c) __builtin_amdgcn_mfma_f32_16x16x32_bf16((p), (q), (c), 0, 0, 0)
constexpr int LDW = 136;
__device__ __forceinline__ void ssd_prompt_unit(LAS unsigned char* lds, int b, int h, const bf16* XC, const float* DT, const bf16* Z, bf16* YG, const float* a_log, const float* d_skip, float* out_ssm, int tid) {
    const int wave = __builtin_amdgcn_readfirstlane(tid >> 6), lane = tid & 63, l16 = lane & 15, quad = lane >> 4, g = h >> 3;
    LAS bf16* Cs = (LAS bf16*)lds;
    LAS bf16* Bs = Cs + 128 * LDW;
    LAS bf16* BT = Bs + 128 * LDW;
    LAS bf16* XT = BT + 128 * LDW;
    LAS bf16* XwT = XT + 64 * LDW;
    LAS bf16* Hb = XwT + 64 * LDW;
    LAS float* acs = (LAS float*)(Hb + 64 * LDW);
    LAS float* dts = acs + 128;
    const float A = -__expf(a_log[h]), Dh = d_skip[h];
    f32x4 hacc[4];
#pragma unroll
    for (int pt = 0; pt < 4; ++pt) hacc[pt] = (f32x4){0.f, 0.f, 0.f, 0.f};
    for (int i = tid; i < 64 * LDW / 2; i += NTHR) ((LAS unsigned*)Hb)[i] = 0u;
    for (int c = 0; c < 16; ++c) {
        const size_t row0 = (size_t)b * 2048 + c * 128;
        u32x4 cgv[4], bgv[4], xgv[2];
#pragma unroll
        for (int i = 0; i < 4; ++i) { const int idx = tid + NTHR * i, l = idx >> 4, seg = idx & 15; const bf16* rp = XC + (row0 + l) * 3072 + g * 128 + seg * 8;
            cgv[i] = *(const u32x4*)(rp + 2560); bgv[i] = *(const u32x4*)(rp + 2048); }
#pragma unroll
        for (int i = 0; i < 2; ++i) { const int idx = tid + NTHR * i, l = idx >> 3, seg = idx & 7; xgv[i] = *(const u32x4*)(XC + (row0 + l) * 3072 + h * 64 + seg * 8); }
        if (wave == 0) {
            const float d0 = DT[(row0 + lane) * 32 + h], d1 = DT[(row0 + 64 + lane) * 32 + h];
            float a0 = d0 * A, a1 = d1 * A;
#pragma unroll
            for (int o = 1; o < 64; o <<= 1) { const float t0 = __shfl_up(a0, o), t1 = __shfl_up(a1, o); if (lane >= o) { a0 += t0; a1 += t1; } }
            a1 += __shfl(a0, 63);
            acs[lane] = a0; acs[64 + lane] = a1; dts[lane] = d0; dts[64 + lane] = d1;
        }
        __syncthreads();
        const float a_end = acs[127];
#pragma unroll
        for (int i = 0; i < 4; ++i) { const int idx = tid + NTHR * i, l = idx >> 4, seg = idx & 15;
            *(LAS u32x4*)(Cs + l * LDW + seg * 8) = cgv[i]; *(LAS u32x4*)(Bs + l * LDW + seg * 8) = bgv[i];
            const u32x4 w = bgv[i]; LAS bf16* bt = BT + (seg * 8) * LDW + l;
            bt[0 * LDW] = (bf16)(w.x & 0xffffu); bt[1 * LDW] = (bf16)(w.x >> 16); bt[2 * LDW] = (bf16)(w.y & 0xffffu); bt[3 * LDW] = (bf16)(w.y >> 16);
            bt[4 * LDW] = (bf16)(w.z & 0xffffu); bt[5 * LDW] = (bf16)(w.z >> 16); bt[6 * LDW] = (bf16)(w.w & 0xffffu); bt[7 * LDW] = (bf16)(w.w >> 16); }
#pragma unroll
        for (int i = 0; i < 2; ++i) { const int idx = tid + NTHR * i, l = idx >> 3, seg = idx & 7;
            const float dtl = dts[l], wl = dtl * __expf(a_end - acs[l]); const F8 x = unpack8(xgv[i]);
            LAS bf16* xt = XT + (seg * 8) * LDW + l; LAS bf16* xw = XwT + (seg * 8) * LDW + l;
#pragma unroll
            for (int e = 0; e < 8; ++e) { xt[e * LDW] = (bf16)f2bf(x.v[e] * dtl); xw[e * LDW] = (bf16)f2bf(x.v[e] * wl); } }
        __syncthreads();
        const int lrow = 16 * wave + l16;
        bf16x8 cf[4];
#pragma unroll
        for (int kk = 0; kk < 4; ++kk) cf[kk] = *(const LAS bf16x8*)(Cs + lrow * LDW + kk * 32 + quad * 8);
        const float acs_l = acs[lrow];
        f32x4 yo[4];
#pragma unroll
        for (int pt = 0; pt < 4; ++pt) { f32x4 t = (f32x4){0.f, 0.f, 0.f, 0.f};
#pragma unroll
            for (int kk = 0; kk < 4; ++kk) t = MFMA16(*(const LAS bf16x8*)(Hb + (16 * pt + l16) * LDW + kk * 32 + quad * 8), cf[kk], t);
            yo[pt] = t; }
        const int nct = (wave | 1) + 1;
        for (int ct = 0; ct < nct; ++ct) {
            f32x4 t = (f32x4){0.f, 0.f, 0.f, 0.f};
            if (ct <= wave) {
#pragma unroll
                for (int kk = 0; kk < 4; ++kk) t = MFMA16(*(const LAS bf16x8*)(Bs + (16 * ct + l16) * LDW + kk * 32 + quad * 8), cf[kk], t);
                const f32x4 as = *(const LAS f32x4*)(acs + 16 * ct + 4 * quad);
#pragma unroll
                for (int r = 0; r < 4; ++r) { const int s = 16 * ct + 4 * quad + r; t[r] = (s <= lrow) ? t[r] * __expf(acs_l - as[r]) : 0.f; }
            }
            u32x2 w; w.x = pk2(t[0], t[1]); w.y = pk2(t[2], t[3]);
            *(LAS u32x2*)(Cs + lrow * LDW + 16 * ct + 4 * quad) = w;
        }
        f32x4 yd[4];
#pragma unroll
        for (int pt = 0; pt < 4; ++pt) yd[pt] = (f32x4){0.f, 0.f, 0.f, 0.f};
        const int nks = (wave >> 1) + 1;
        for (int ks = 0; ks < nks; ++ks) { const bf16x8 gq = *(const LAS bf16x8*)(Cs + lrow * LDW + ks * 32 + quad * 8);
#pragma unroll
            for (int pt = 0; pt < 4; ++pt) yd[pt] = MFMA16(*(const LAS bf16x8*)(XT + (16 * pt + l16) * LDW + ks * 32 + quad * 8), gq, yd[pt]); }
        { const float el = __expf(acs_l); const size_t row = row0 + lrow;
#pragma unroll
          for (int pt = 0; pt < 4; ++pt) { const int p0 = 16 * pt + 4 * quad;
              const u32x2 xr = *(const u32x2*)(XC + row * 3072 + h * 64 + p0), zr = *(const u32x2*)(Z + row * 2048 + h * 64 + p0);
              const float xv[4] = {bflo(xr.x), bfhi(xr.x), bflo(xr.y), bfhi(xr.y)}, zv[4] = {bflo(zr.x), bfhi(zr.x), bflo(zr.y), bfhi(zr.y)};
              float o[4];
#pragma unroll
              for (int r = 0; r < 4; ++r) { const float y = yd[pt][r] + el * yo[pt][r] + Dh * xv[r]; o[r] = y * (zv[r] / (1.0f + __expf(-zv[r]))); }
              u32x2 w; w.x = pk2(o[0], o[1]); w.y = pk2(o[2], o[3]);
              *(u32x2*)(YG + row * 2048 + h * 64 + p0) = w; } }
        __syncthreads();
        { const float cd = __expf(a_end);
#pragma unroll
          for (int pt = 0; pt < 4; ++pt) { f32x4 t = hacc[pt] * cd;
#pragma unroll
              for (int kk = 0; kk < 4; ++kk) t = MFMA16(*(const LAS bf16x8*)(BT + (16 * wave + l16) * LDW + kk * 32 + quad * 8), *(const LAS bf16x8*)(XwT + (16 * pt + l16) * LDW + kk * 32 + quad * 8), t);
              hacc[pt] = t;
              u32x2 w; w.x = pk2(t[0], t[1]); w.y = pk2(t[2], t[3]);
              *(LAS u32x2*)(Hb + (16 * pt + l16) * LDW + 16 * wave + 4 * quad) = w; } }
    }
#pragma unroll
    for (int pt = 0; pt < 4; ++pt) *(f32x4*)(out_ssm + ((size_t)(b * 32 + h) * 64 + 16 * pt + l16) * 128 + 16 * wave + 4 * quad) = hacc[pt];
    __syncthreads();
}
__device__ __forceinline__ void ssd_sample_unit(int b, int h, const bf16* XC, const float* DT, const bf16* Z, bf16* YG, const float* a_log, const float* d_skip, const float* st_in, float* st_out, int tid) {
    const int p = tid >> 3, nq = tid & 7, g = h >> 3;
    const size_t so = ((size_t)(b * 32 + h) * 64 + p) * 128 + nq * 16;
    f32x4 hv[4];
#pragma unroll
    for (int j = 0; j < 4; ++j) hv[j] = *(const f32x4*)(st_in + so + 4 * j);
    const float A = -__expf(a_log[h]), Dh = d_skip[h];
#pragma unroll 2
    for (int t = 0; t < 8; ++t) {
        const size_t row = (size_t)MP + b * 8 + t;
        const float dt = DT[row * 32 + h], dA = __expf(dt * A);
        const float xv = bf2f(XC[row * 3072 + h * 64 + p]);
        const bf16* bp = XC + row * 3072 + 2048 + g * 128 + nq * 16;
        const F8 B0 = unpack8(*(const u32x4*)bp), B1 = unpack8(*(const u32x4*)(bp + 8)), C0 = unpack8(*(const u32x4*)(bp + 512)), C1 = unpack8(*(const u32x4*)(bp + 520));
        const float coef = dt * xv; float y = 0.f;
#pragma unroll
        for (int j = 0; j < 4; ++j) {
#pragma unroll
            for (int e = 0; e < 4; ++e) { const int k = 4 * j + e; const float Bv = k < 8 ? B0.v[k & 7] : B1.v[k & 7], Cv = k < 8 ? C0.v[k & 7] : C1.v[k & 7];
                const float hn = hv[j][e] * dA + coef * Bv; hv[j][e] = hn; y += hn * Cv; } }
        y += __shfl_xor(y, 1); y += __shfl_xor(y, 2); y += __shfl_xor(y, 4);
        y += Dh * xv;
        const float z = bf2f(Z[row * 2048 + h * 64 + p]);
        const float yg = y * (z / (1.0f + __expf(-z)));
        if (nq == 0) YG[row * 2048 + h * 64 + p] = (bf16)f2bf(yg);
    }
#pragma unroll
    for (int j = 0; j < 4; ++j) *(f32x4*)(st_out + so + 4 * j) = hv[j];
}

__global__ void __launch_bounds__(NTHR, 2) fwd_kernel(Args a) {
    extern __shared__ __attribute__((aligned(16))) unsigned char lds_raw[];
    LAS unsigned char* lds = (LAS unsigned char*)lds_raw;
    const int tid = threadIdx.x, G = gridDim.x, lane = tid & 63, wave = __builtin_amdgcn_readfirstlane(tid >> 6);
    unsigned char* ws = a.ws;
    const int lo = a.ph_lo, hi = a.ph_hi;
    using namespace pg8;
    bf16* XB = (bf16*)(ws + WS_XB); bf16* HID = (bf16*)(ws + WS_RA); float* SSQ = (float*)(ws + WS_SSQ); float* DT = (float*)(ws + WS_DT);
    float* X = a.out + O_Y;
#define IN(k) (lo <= (k) && (k) < hi)
#define SEAM(k) do { if ((k) + 1 < hi) cg::this_grid().sync(); } while (0)
    if (IN(0)) { phase0(a, lds, G, tid); SEAM(0); }
    if (IN(1)) {
        Gemm g{XB, (const bf16_t*)(ws + WS_W1A), M, 2 * FF, D, D, D, 0}; StaticOrder S; S.init(M, 2 * FF, G, (int)blockIdx.x);
        EpiSwiGLU E{HID, nullptr};
        gemm_phase<EpiSwiGLU, StaticOrder, true, true>(lds, g, S, E); SEAM(1);
    }
    if (IN(2)) {
        Gemm g{HID, (const bf16_t*)(ws + WS_W1B), M, D, FF, FF, FF, 0}; StaticOrder S; S.init(M, D, G, (int)blockIdx.x);
        EpiResid E{a.in[I_XP], a.in[I_XS] - (size_t)MP * D, X, XB, SSQ, 0.5f};
        gemm_phase<EpiResid, StaticOrder, true, true>(lds, g, S, E); SEAM(2);
    }
    if (IN(3)) {
        Gemm g{XB, (const bf16_t*)(ws + WS_WIN), M, NPROJ_PAD, D, D, D, 0}; StaticOrder S; S.init(M, NPROJ_PAD, G, (int)blockIdx.x);
        EpiInProj E{(bf16*)(ws + WS_RC), (bf16*)(ws + WS_RD), (bf16*)(ws + WS_RA), (bf16*)(ws + WS_RE), DT, a.in[I_DTB], SSQ};
        gemm_phase<EpiInProj, StaticOrder, true, true>(lds, g, S, E); SEAM(3);
    }
    if (IN(4)) { phase4(a, G, tid); SEAM(4); }
    if (IN(5)) {
        const bf16* XC = (const bf16*)(ws + WS_RB); const bf16* Z = (const bf16*)(ws + WS_RD); bf16* YG = (bf16*)(ws + WS_RA);
        for (int u = blockIdx.x; u < 256; u += G) ssd_prompt_unit(lds, u >> 5, u & 31, XC, DT, Z, YG, a.in[I_ALOG], a.in[I_DSKIP], a.out + O_SP, tid);
        for (int u = blockIdx.x; u < 4096; u += G) ssd_sample_unit(u >> 5, u & 31, XC, DT, Z, YG, a.in[I_ALOG], a.in[I_DSKIP], a.in[I_SSSM], a.out + O_SS, tid);
        __syncthreads();
        Gemm g{(const bf16_t*)(ws + WS_RF), (const bf16_t*)(ws + WS_WPG), M, D, 256, D, 256, 256}; StaticOrder S; S.init(M, D, G, (int)blockIdx.x);
        EpiPlain E{(bf16*)(ws + WS_RC)};
        gemm_phase<EpiPlain, StaticOrder, true, true>(lds, g, S, E); SEAM(5);
    }
    if (IN(6)) {
        Gemm g{(const bf16_t*)(ws + WS_RC), (const bf16_t*)(ws + WS_WPO), M, D, D, D, D, 0}; StaticOrder S; S.init(M, D, G, (int)blockIdx.x);
        EpiPlain E{(bf16*)(ws + WS_RB)};
        gemm_phase<EpiPlain, StaticOrder, true, true>(lds, g, S, E);
        bf16* YG = (bf16*)(ws + WS_RA);
        for (int u = blockIdx.x * NWAVES + wave; u < M * 4; u += G * NWAVES) {
            u32x4* p = (u32x4*)(YG + (size_t)u * 512) + lane; F8 v = unpack8(*p); float s = 0.f;
#pragma unroll
            for (int e = 0; e < 8; ++e) s += v.v[e] * v.v[e];
            const float r = __builtin_amdgcn_rsqf(wave_sum(s) * (1.0f / 512.0f) + EPS);
#pragma unroll
            for (int e = 0; e < 8; ++e) v.v[e] *= r;
            *p = pack8(v);
        }
        SEAM(6);
    }
    if (IN(7)) {
        Gemm g{(const bf16_t*)(ws + WS_RA), (const bf16_t*)(ws + WS_WSO), M, D, 2048, 2048, 2048, 0}; StaticOrder S; S.init(M, D, G, (int)blockIdx.x);
        EpiMerge E{(const bf16_t*)(ws + WS_RE), (const bf16_t*)(ws + WS_RB), (bf16*)(ws + WS_RB + SZ1K)};
        gemm_phase<EpiMerge, StaticOrder, true, true>(lds, g, S, E); SEAM(7);
    }
    if (IN(8)) {
        Gemm g{(const bf16_t*)(ws + WS_RB + SZ1K), (const bf16_t*)(ws + WS_WO), M, D, D, D, D, 0}; StaticOrder S; S.init(M, D, G, (int)blockIdx.x);
        EpiResid E{X, X, X, XB, SSQ, 1.0f};
        gemm_phase<EpiResid, StaticOrder, true, true>(lds, g, S, E); SEAM(8);
    }
    if (IN(9)) {
        Gemm g{XB, (const bf16_t*)(ws + WS_W2A), M, 2 * FF, D, D, D, 0}; StaticOrder S; S.init(M, 2 * FF, G, (int)blockIdx.x);
        EpiSwiGLU E{HID, SSQ};
        gemm_phase<EpiSwiGLU, StaticOrder, true, true>(lds, g, S, E); SEAM(9);
    }
    if (IN(10)) {
        Gemm g{HID, (const bf16_t*)(ws + WS_W2B), M, D, FF, FF, FF, 0}; StaticOrder S; S.init(M, D, G, (int)blockIdx.x);
        EpiResid E{X, X, X, XB, SSQ, 0.5f};
        gemm_phase<EpiResid, StaticOrder, true, true>(lds, g, S, E); SEAM(10);
    }
    if (IN(11)) {
        const float* gn = a.in[I_NFIN];
        for (int m = blockIdx.x * NWAVES + wave; m < M; m += G * NWAVES) {
            f32x4* xr = (f32x4*)(X + (size_t)m * D) + lane; f32x4 v[4]; float s = 0.f;
#pragma unroll
            for (int j = 0; j < 4; ++j) { v[j] = xr[64 * j]; s += (v[j][0] * v[j][0] + v[j][1] * v[j][1]) + (v[j][2] * v[j][2] + v[j][3] * v[j][3]); }
            const float rstd = __builtin_amdgcn_rsqf(wave_sum(s) * (1.f / D) + EPS);
#pragma unroll
            for (int j = 0; j < 4; ++j) { const f32x4 gv = ((const f32x4*)gn)[lane + 64 * j]; xr[64 * j] = v[j] * rstd * gv; }
        }
    }
#undef IN
#undef SEAM
}

extern "C" void kernel_launch(void* const* d_in, const int* in_sizes, int n_in, void* d_out, int out_size, void* d_ws, size_t ws_size, hipStream_t stream) {
    static int grid = 0;
    if (grid == 0) {
        if (n_in != 25 || out_size != (int)O_END || ws_size < WS_END) { fprintf(stderr, "kernel_launch: unexpected sizes n_in %d out %d ws %zu (need %zu)\n", n_in, out_size, ws_size, (size_t)WS_END); grid = -1; return; }
        int dev = 0, cus = 0, per_cu = 0;
        hipGetDevice(&dev); hipDeviceGetAttribute(&cus, hipDeviceAttributeMultiprocessorCount, dev);
        if (hipFuncSetAttribute((const void*)fwd_kernel, hipFuncAttributeMaxDynamicSharedMemorySize, LDS_BYTES) != hipSuccess) { fprintf(stderr, "kernel_launch: hipFuncSetAttribute failed\n"); grid = -1; return; }
        hipOccupancyMaxActiveBlocksPerMultiprocessor(&per_cu, (const void*)fwd_kernel, NTHR, LDS_BYTES);
        (void)hipGetLastError();
        if (per_cu < 1) fprintf(stderr, "kernel_launch: occupancy query says %d blocks per CU\n", per_cu);
        grid = cus;
    }
    if (grid < 0) return;
    Args a{};
    for (int i = 0; i < 25; ++i) a.in[i] = (const float*)d_in[i];
    a.out = (float*)d_out; a.ws = (unsigned char*)d_ws;
#if ONE_LAUNCH
    a.ph_lo = 0; a.ph_hi = N_PHASES;
    void* args[] = {&a};
    hipError_t e = hipLaunchCooperativeKernel((const void*)fwd_kernel, dim3(grid), dim3(NTHR), args, LDS_BYTES, stream);
    if (e != hipSuccess) fprintf(stderr, "cooperative launch failed: %s (grid %d)\n", hipGetErrorString(e), grid);
#else
    for (int ph = 0; ph < N_PHASES; ++ph) { a.ph_lo = ph; a.ph_hi = ph + 1; hipLaunchKernelGGL(fwd_kernel, dim3(grid), dim3(NTHR), LDS_BYTES, stream, a); }
#endif
}
```

```cpp
#include <hip/hip_runtime.h>
#include <cstdio>
#include <cstdint>
namespace pg8 {
#define PG8_LAS __attribute__((address_space(3)))
typedef unsigned short bf16_t;
typedef short bf16x8 __attribute__((ext_vector_type(8)));
typedef float f32x4 __attribute__((ext_vector_type(4)));
typedef unsigned u32x4 __attribute__((ext_vector_type(4)));
constexpr int BM = 256, BK = 64, HALF = 128, HTB = HALF * BK * 2  , STAGE_BYTES = 8 * HTB, NXCD = 8, WGM = 8;

__host__ __device__ __forceinline__ int lds_byte(int r, int c) { const int st = (r >> 4) * 2 + (c >> 5), rr = r & 15, cc = c & 31, ob = rr * 64 + cc * 2; return st * 1024 + (ob ^ (((ob >> 9) & 1) << 5)); }
__host__ __device__ __forceinline__ void stage_rc(int b, int& R, int& C) { const int st = b / 1024, sb = b % 1024, swz = sb ^ (((sb >> 9) & 1) << 5); R = (st >> 1) * 16 + swz / 64; C = (st & 1) * 32 + (swz % 64) / 2; }
__host__ __device__ __forceinline__ int perm32(int rho) { const int n = rho >> 4, i = rho & 15; return 8 * (i >> 2) + 4 * n + (i & 3); }

struct Unit { int pm, pn; };
struct Gemm { const bf16_t* A; const bf16_t* Bt; int M, N, K, lda, ldb, a_pn_off; };

struct StaticOrder {
    int nM, nN, nwg, G, c;
    __host__ __device__ void init(int M, int N, int G_, int c_) { nM = M / BM; nN = N / BM; nwg = nM * nN; G = G_; c = c_; }
    __host__ __device__ bool next(int i, Unit& u) const {
        const long L = (long)i * G + c; if (L >= nwg) return false;
        int wgid = (int)L; { const int q = nwg / NXCD, r = nwg % NXCD, xcd = wgid % NXCD, off = wgid / NXCD; wgid = (xcd < r ? xcd * (q + 1) : r * (q + 1) + (xcd - r) * q) + off; }
        const int nig = WGM * nN, gid = wgid / nig, fm = gid * WGM, gsz = (nM - fm) < WGM ? (nM - fm) : WGM;
        u.pm = fm + ((wgid % nig) % gsz); u.pn = (wgid % nig) / gsz; return true;
    }
    __device__ __forceinline__ void a_ready(const Unit&) const {}
    __device__ __forceinline__ void done(const Unit&) const {}
};

__device__ __forceinline__ unsigned cvt_pk_bf16(float lo, float hi) { unsigned r; asm volatile("v_cvt_pk_bf16_f32 %0, %1, %2" : "=v"(r) : "v"(lo), "v"(hi)); return r; }
typedef float f32x2 __attribute__((ext_vector_type(2)));
__device__ __forceinline__ float bf_lo(unsigned w) { return __uint_as_float(w << 16); }
__device__ __forceinline__ float bf_hi(unsigned w) { return __uint_as_float(w & 0xffff0000u); }
__device__ __forceinline__ float silu_f(float g) { return g * __builtin_amdgcn_rcpf(1.0f + __expf(-g)); }
__device__ __forceinline__ float sigm_f(float g) { return __builtin_amdgcn_rcpf(1.0f + __expf(-g)); }
__device__ __forceinline__ float rstd16(const float* ssq, int row) {
    const f32x4* p = (const f32x4*)(ssq + (size_t)row * 16);
    const f32x4 a = p[0], b = p[1], c = p[2], d = p[3];
    const float s = ((a[0] + a[1]) + (a[2] + a[3])) + ((b[0] + b[1]) + (b[2] + b[3])) + ((c[0] + c[1]) + (c[2] + c[3])) + ((d[0] + d[1]) + (d[2] + d[3]));
    return __builtin_amdgcn_rsqf(s * (1.0f / 1024.0f) + 1e-6f);
}
struct EpiSwiGLU {
    static constexpr bool PERM = true, AFTER_DRAIN = false;
    bf16_t* O; const float* ssq;
    __device__ __forceinline__ void operator()(const f32x4 (&acc)[2][2][4][2], const Unit& u, int wr, int wc, int fr, int fq) const {
#pragma unroll
        for (int ai = 0; ai < 2; ++ai)
#pragma unroll
            for (int m = 0; m < 4; ++m) {
                const int row = u.pm * BM + ai * HALF + wr * 64 + m * 16 + fr;
                float rs = 1.0f; if (ssq) rs = rstd16(ssq, row);
                const f32x4 g0 = acc[ai][0][m][0] * rs, g1 = acc[ai][0][m][1] * rs, u0 = acc[ai][1][m][0] * rs, u1 = acc[ai][1][m][1] * rs;
                u32x4 w;
                w.x = cvt_pk_bf16(silu_f(g0[0]) * u0[0], silu_f(g0[1]) * u0[1]); w.y = cvt_pk_bf16(silu_f(g0[2]) * u0[2], silu_f(g0[3]) * u0[3]);
                w.z = cvt_pk_bf16(silu_f(g1[0]) * u1[0], silu_f(g1[1]) * u1[1]); w.w = cvt_pk_bf16(silu_f(g1[2]) * u1[2], silu_f(g1[3]) * u1[3]);
                *(u32x4*)(O + (size_t)row * 2816 + u.pn * 128 + wc * 32 + fq * 8) = w;
            }
    }
};
struct EpiResid {
    static constexpr bool PERM = true, AFTER_DRAIN = false;
    const float* baseP; const float* baseS;
    float* X; bf16_t* XB; float* ssq; float scale;
    __device__ __forceinline__ void operator()(const f32x4 (&acc)[2][2][4][2], const Unit& u, int wr, int wc, int fr, int fq) const {
        const float* base = (u.pm < 64) ? baseP : baseS;
#pragma unroll
        for (int ai = 0; ai < 2; ++ai)
#pragma unroll
            for (int m = 0; m < 4; ++m) {
                const int row = u.pm * BM + ai * HALF + wr * 64 + m * 16 + fr;
                const size_t off = (size_t)row * 1024 + u.pn * BM + wc * 32 + fq * 8;
                float s = 0.f;
#pragma unroll
                for (int bj = 0; bj < 2; ++bj) {
                    const f32x4 b0 = *(const f32x4*)(base + off + bj * HALF), b1 = *(const f32x4*)(base + off + bj * HALF + 4);
                    const f32x4 v0 = b0 + acc[ai][bj][m][0] * scale, v1 = b1 + acc[ai][bj][m][1] * scale;
                    *(f32x4*)(X + off + bj * HALF) = v0; *(f32x4*)(X + off + bj * HALF + 4) = v1;
                    u32x4 w; w.x = cvt_pk_bf16(v0[0], v0[1]); w.y = cvt_pk_bf16(v0[2], v0[3]); w.z = cvt_pk_bf16(v1[0], v1[1]); w.w = cvt_pk_bf16(v1[2], v1[3]);
                    *(u32x4*)(XB + off + bj * HALF) = w;
                    s += (v0[0] * v0[0] + v0[1] * v0[1]) + (v0[2] * v0[2] + v0[3] * v0[3]) + (v1[0] * v1[0] + v1[1] * v1[1]) + (v1[2] * v1[2] + v1[3] * v1[3]);
                }
                s += __shfl_xor(s, 16); s += __shfl_xor(s, 32);
                if (fq == 0) ssq[(size_t)row * 16 + u.pn * 4 + wc] = s;
            }
    }
};
struct EpiInProj {
    static constexpr bool PERM = true, AFTER_DRAIN = false;
    bf16_t* U; bf16_t* Z; bf16_t* XBC; bf16_t* GL; float* DT; const float* dt_bias; const float* ssq;
    __device__ __forceinline__ void operator()(const f32x4 (&acc)[2][2][4][2], const Unit& u, int wr, int wc, int fr, int fq) const {
        bf16_t* O; int ldc, colt;
        if (u.pn < 4) { O = U; ldc = 1024; colt = u.pn * 256; }
        else if (u.pn < 12) { O = Z; ldc = 2048; colt = (u.pn - 4) * 256; }
        else if (u.pn < 24) { O = XBC; ldc = 3072; colt = (u.pn - 12) * 256; }
        else { O = GL; ldc = 2048; colt = (u.pn - 24) * 256; }
        const bool isdt = (u.pn == 32);
#pragma unroll
        for (int ai = 0; ai < 2; ++ai)
#pragma unroll
            for (int m = 0; m < 4; ++m) {
                const int row = u.pm * BM + ai * HALF + wr * 64 + m * 16 + fr;
                const float rs = rstd16(ssq, row);
                if (!isdt) {
#pragma unroll
                    for (int bj = 0; bj < 2; ++bj) {
                        const f32x4 v0 = acc[ai][bj][m][0] * rs, v1 = acc[ai][bj][m][1] * rs;
                        u32x4 w; w.x = cvt_pk_bf16(v0[0], v0[1]); w.y = cvt_pk_bf16(v0[2], v0[3]); w.z = cvt_pk_bf16(v1[0], v1[1]); w.w = cvt_pk_bf16(v1[2], v1[3]);
                        *(u32x4*)(O + (size_t)row * ldc + colt + bj * HALF + wc * 32 + fq * 8) = w;
                    }
                } else if (wc == 0) {
                    const int c = fq * 8;
                    const f32x4 bb0 = *(const f32x4*)(dt_bias + c), bb1 = *(const f32x4*)(dt_bias + c + 4);
                    f32x4 v0 = acc[ai][0][m][0] * rs + bb0, v1 = acc[ai][0][m][1] * rs + bb1;
#pragma unroll
                    for (int i = 0; i < 4; ++i) { v0[i] = v0[i] > 20.f ? v0[i] : log1pf(__expf(v0[i])); v1[i] = v1[i] > 20.f ? v1[i] : log1pf(__expf(v1[i])); }
                    *(f32x4*)(DT + (size_t)row * 32 + c) = v0; *(f32x4*)(DT + (size_t)row * 32 + c + 4) = v1;
                }
            }
    }
};
struct EpiPlain {
    static constexpr bool PERM = true, AFTER_DRAIN = false;
    bf16_t* O;
    __device__ __forceinline__ void operator()(const f32x4 (&acc)[2][2][4][2], const Unit& u, int wr, int wc, int fr, int fq) const {
#pragma unroll
        for (int ai = 0; ai < 2; ++ai)
#pragma unroll
            for (int m = 0; m < 4; ++m) {
                const int row = u.pm * BM + ai * HALF + wr * 64 + m * 16 + fr;
#pragma unroll
                for (int bj = 0; bj < 2; ++bj) {
                    const f32x4 v0 = acc[ai][bj][m][0], v1 = acc[ai][bj][m][1];
                    u32x4 w; w.x = cvt_pk_bf16(v0[0], v0[1]); w.y = cvt_pk_bf16(v0[2], v0[3]); w.z = cvt_pk_bf16(v1[0], v1[1]); w.w = cvt_pk_bf16(v1[2], v1[3]);
                    *(u32x4*)(O + (size_t)row * 1024 + u.pn * BM + bj * HALF + wc * 32 + fq * 8) = w;
                }
            }
    }
};
struct EpiMerge {
    static constexpr bool PERM = true, AFTER_DRAIN = false;
    const bf16_t* GL; const bf16_t* BP; bf16_t* O;
    __device__ __forceinline__ void operator()(const f32x4 (&acc)[2][2][4][2], const Unit& u, int wr, int wc, int fr, int fq) const {
#pragma unroll
        for (int ai = 0; ai < 2; ++ai)
#pragma unroll
            for (int m = 0; m < 4; ++m) {
                const int row = u.pm * BM + ai * HALF + wr * 64 + m * 16 + fr;
#pragma unroll
                for (int bj = 0; bj < 2; ++bj) {
                    const int col = u.pn * BM + bj * HALF + wc * 32 + fq * 8;
                    const u32x4 g0 = *(const u32x4*)(GL + (size_t)row * 2048 + col), g1 = *(const u32x4*)(GL + (size_t)row * 2048 + 1024 + col), bp = *(const u32x4*)(BP + (size_t)row * 1024 + col);
                    const f32x4 a0 = acc[ai][bj][m][0], a1 = acc[ai][bj][m][1];
                    u32x4 w;
                    w.x = cvt_pk_bf16(sigm_f(bf_lo(g0.x)) * bf_lo(bp.x) + sigm_f(bf_lo(g1.x)) * a0[0], sigm_f(bf_hi(g0.x)) * bf_hi(bp.x) + sigm_f(bf_hi(g1.x)) * a0[1]);
                    w.y = cvt_pk_bf16(sigm_f(bf_lo(g0.y)) * bf_lo(bp.y) + sigm_f(bf_lo(g1.y)) * a0[2], sigm_f(bf_hi(g0.y)) * bf_hi(bp.y) + sigm_f(bf_hi(g1.y)) * a0[3]);
                    w.z = cvt_pk_bf16(sigm_f(bf_lo(g0.z)) * bf_lo(bp.z) + sigm_f(bf_lo(g1.z)) * a1[0], sigm_f(bf_hi(g0.z)) * bf_hi(bp.z) + sigm_f(bf_hi(g1.z)) * a1[1]);
                    w.w = cvt_pk_bf16(sigm_f(bf_lo(g0.w)) * bf_lo(bp.w) + sigm_f(bf_lo(g1.w)) * a1[2], sigm_f(bf_hi(g0.w)) * bf_hi(bp.w) + sigm_f(bf_hi(g1.w)) * a1[3]);
                    *(u32x4*)(O + (size_t)row * 1024 + col) = w;
                }
            }
    }
};

template <class Epi, class Sched, bool ALIGN_EPI = false, bool SP2 = false>
__device__ __forceinline__ void gemm_phase(PG8_LAS unsigned char* lds, const Gemm g, const Sched& S, const Epi& E) {
    const int tid = threadIdx.x, wid = __builtin_amdgcn_readfirstlane(tid >> 6), lane = tid & 63, wr = wid >> 2, wc = wid & 3, fr = lane & 15, fq = lane >> 4;
    const int K = g.K, nt = K / BK;
    unsigned voffA[2], voffB[2];
#pragma unroll
    for (int i = 0; i < 2; ++i) { int R, C; stage_rc(tid * 16 + i * 8192, R, C); const int Rb = Epi::PERM ? ((R & ~31) + perm32(R & 31)) : R;
        voffA[i] = (unsigned)(R * g.lda + C) * 2u; voffB[i] = (unsigned)(Rb * g.ldb + C) * 2u; }
    const size_t kstep = (size_t)(BK * 2);
    const size_t hstepA = (size_t)HALF * g.lda * 2, hstepB = (size_t)HALF * g.ldb * 2;
    const size_t tstepA = 2 * hstepA, tstepB = 2 * hstepB; const size_t pnoffA = (size_t)g.a_pn_off * 2;
    const unsigned ldsw = (unsigned)wid * 1024u;
    const int aoff = lds_byte(wr * 64 + fr, fq * 8), boff = lds_byte(wc * 32 + fr, fq * 8);
#define PG8_SA(b, h) (((b) * 2 + (h)) * HTB)
#define PG8_SB(b, h) ((4 + (b) * 2 + (h)) * HTB)
#define PG8_STAGE(bufoff, gbase, voff) do { _Pragma("unroll") for (int _i = 0; _i < 2; ++_i) \
        __builtin_amdgcn_global_load_lds((const unsigned*)((const char*)(gbase) + (voff)[_i]), (PG8_LAS unsigned*)(lds + (bufoff) + ldsw + _i * 8192), 16, 0, 0); } while (0)
#define PG8_LDA(dst, b, h) do { _Pragma("unroll") for (int m = 0; m < 4; ++m) _Pragma("unroll") for (int k = 0; k < 2; ++k) dst[m][k] = *(const PG8_LAS bf16x8*)(lds + PG8_SA(b, h) + aoff + m * 2048 + k * 1024); } while (0)
#define PG8_LDB(dst, b, h) do { _Pragma("unroll") for (int n = 0; n < 2; ++n) _Pragma("unroll") for (int k = 0; k < 2; ++k) dst[n][k] = *(const PG8_LAS bf16x8*)(lds + PG8_SB(b, h) + boff + n * 2048 + k * 1024); } while (0)
#define PG8_MMA(ai, bj, At, Bt) do { __builtin_amdgcn_s_setprio(1); _Pragma("unroll") for (int m = 0; m < 4; ++m) _Pragma("unroll") for (int n = 0; n < 2; ++n) _Pragma("unroll") for (int k = 0; k < 2; ++k) \
        acc[ai][bj][m][n] = __builtin_amdgcn_mfma_f32_16x16x32_bf16(Bt[n][k], At[m][k], acc[ai][bj][m][n], 0, 0, 0); __builtin_amdgcn_s_setprio(0); } while (0)
#define PG8_WAIT_V(n) asm volatile("s_waitcnt vmcnt(" #n ")" ::: "memory")
#define PG8_WAIT_L(n) asm volatile("s_waitcnt lgkmcnt(" #n ")" ::: "memory")
#define PG8_BAR __builtin_amdgcn_s_barrier()
#define PG8_SCHED __builtin_amdgcn_sched_barrier(0)
    Unit cur, nxt; int ui = 0;
    if (!S.next(0, cur)) return;
    f32x4 acc[2][2][4][2];
#pragma unroll
    for (int a = 0; a < 2; ++a)
#pragma unroll
        for (int b = 0; b < 2; ++b)
#pragma unroll
            for (int m = 0; m < 4; ++m)
#pragma unroll
                for (int n = 0; n < 2; ++n) acc[a][b][m][n] = (f32x4){0.f, 0.f, 0.f, 0.f};
    bf16x8 At[4][2], B0[2][2], B1[2][2];
    const char* cA = (const char*)g.A + (size_t)cur.pm * tstepA + (size_t)cur.pn * pnoffA; const char* cB = (const char*)g.Bt + (size_t)cur.pn * tstepB;
    S.a_ready(cur);
    if constexpr (SP2) {
        PG8_STAGE(PG8_SB(0, 0), cB, voffB); PG8_STAGE(PG8_SB(0, 1), cB + hstepB, voffB); PG8_STAGE(PG8_SA(0, 0), cA, voffA); PG8_STAGE(PG8_SA(0, 1), cA + hstepA, voffA);
        if (wr == 1) PG8_BAR;
        PG8_WAIT_V(2); PG8_BAR;
        PG8_STAGE(PG8_SB(1, 0), cB + kstep, voffB); PG8_STAGE(PG8_SA(1, 0), cA + kstep, voffA); PG8_STAGE(PG8_SB(1, 1), cB + hstepB + kstep, voffB);
        PG8_WAIT_V(6); PG8_BAR;
    } else {
        PG8_STAGE(PG8_SB(0, 0), cB, voffB); PG8_STAGE(PG8_SA(0, 0), cA, voffA); PG8_STAGE(PG8_SB(0, 1), cB + hstepB, voffB); PG8_STAGE(PG8_SA(0, 1), cA + hstepA, voffA);
        if (wr == 1) PG8_BAR;
        PG8_WAIT_V(4); PG8_BAR;
        PG8_STAGE(PG8_SB(1, 0), cB + kstep, voffB); PG8_STAGE(PG8_SA(1, 0), cA + kstep, voffA); PG8_STAGE(PG8_SB(1, 1), cB + hstepB + kstep, voffB);
        PG8_WAIT_V(6); PG8_BAR;
    }
    for (;;) {
        const bool has_next = S.next(ui + 1, nxt);
        const char* nA = has_next ? (const char*)g.A + (size_t)nxt.pm * tstepA + (size_t)nxt.pn * pnoffA : cA; const char* nB = has_next ? (const char*)g.Bt + (size_t)nxt.pn * tstepB : cB;
        for (int t = 0; t < nt; t += 2) {
            const bool last = (t == nt - 2);
            const char* a1 = cA + (size_t)(t + 1) * kstep;
            const char* a2 = last ? nA : cA + (size_t)(t + 2) * kstep; const char* b2 = last ? nB : cB + (size_t)(t + 2) * kstep;
            const char* a3 = a2 + kstep; const char* b3 = b2 + kstep;
            if (last && has_next) S.a_ready(nxt);
            if constexpr (SP2) {
            PG8_LDB(B0, 0, 0); PG8_LDB(B1, 0, 1); PG8_SCHED; PG8_LDA(At, 0, 0); PG8_STAGE(PG8_SA(1, 1), a1 + hstepA, voffA);
            PG8_WAIT_V(8); PG8_WAIT_L(0); PG8_BAR; PG8_MMA(0, 0, At, B0); PG8_MMA(0, 1, At, B1); PG8_BAR; PG8_SCHED;
            PG8_LDA(At, 0, 1); PG8_STAGE(PG8_SB(0, 0), b2, voffB); PG8_STAGE(PG8_SB(0, 1), b2 + hstepB, voffB); PG8_STAGE(PG8_SA(0, 0), a2, voffA);
            PG8_WAIT_V(8); PG8_WAIT_L(0); PG8_BAR; PG8_MMA(1, 0, At, B0); PG8_MMA(1, 1, At, B1); PG8_BAR; PG8_SCHED;
            PG8_LDB(B0, 1, 0); PG8_LDB(B1, 1, 1); PG8_SCHED; PG8_LDA(At, 1, 0); PG8_STAGE(PG8_SA(0, 1), a2 + hstepA, voffA);
            PG8_WAIT_V(8); PG8_WAIT_L(0); PG8_BAR; PG8_MMA(0, 0, At, B0); PG8_MMA(0, 1, At, B1); PG8_BAR; PG8_SCHED;
            PG8_LDA(At, 1, 1); PG8_STAGE(PG8_SB(1, 0), b3, voffB); PG8_STAGE(PG8_SB(1, 1), b3 + hstepB, voffB); PG8_STAGE(PG8_SA(1, 0), a3, voffA);
            PG8_WAIT_V(8); PG8_WAIT_L(0); PG8_BAR; PG8_MMA(1, 0, At, B0); PG8_MMA(1, 1, At, B1); PG8_BAR; PG8_SCHED;
            } else {
            PG8_LDB(B0, 0, 0); PG8_SCHED; PG8_LDA(At, 0, 0); PG8_STAGE(PG8_SA(1, 1), a1 + hstepA, voffA);
            PG8_WAIT_L(8); PG8_BAR; PG8_WAIT_L(0); PG8_MMA(0, 0, At, B0); PG8_BAR; PG8_SCHED;
            PG8_LDB(B1, 0, 1); PG8_STAGE(PG8_SB(0, 0), b2, voffB);
            PG8_BAR; PG8_WAIT_L(0); PG8_MMA(0, 1, At, B1); PG8_BAR;
            PG8_LDA(At, 0, 1); PG8_STAGE(PG8_SA(0, 0), a2, voffA);
            PG8_BAR; PG8_WAIT_L(0); PG8_MMA(1, 0, At, B0); PG8_BAR; PG8_SCHED;
            PG8_STAGE(PG8_SB(0, 1), b2 + hstepB, voffB);
            PG8_WAIT_V(6); PG8_BAR; PG8_MMA(1, 1, At, B1); PG8_BAR;
            PG8_LDB(B0, 1, 0); PG8_SCHED; PG8_LDA(At, 1, 0); PG8_STAGE(PG8_SA(0, 1), a2 + hstepA, voffA);
            PG8_WAIT_L(8); PG8_BAR; PG8_WAIT_L(0); PG8_MMA(0, 0, At, B0); PG8_BAR; PG8_SCHED;
            PG8_LDB(B1, 1, 1); PG8_STAGE(PG8_SB(1, 0), b3, voffB);
            PG8_BAR; PG8_WAIT_L(0); PG8_MMA(0, 1, At, B1); PG8_BAR;
            PG8_LDA(At, 1, 1); PG8_STAGE(PG8_SA(1, 0), a3, voffA);
            PG8_BAR; PG8_WAIT_L(0); PG8_MMA(1, 0, At, B0); PG8_BAR; PG8_SCHED;
            PG8_STAGE(PG8_SB(1, 1), b3 + hstepB, voffB);
            PG8_WAIT_V(6); PG8_BAR; PG8_MMA(1, 1, At, B1); PG8_BAR;
            }
        }
        if constexpr (ALIGN_EPI) { if (wr == 0) PG8_BAR; }
        if constexpr (!Epi::AFTER_DRAIN) { E(acc, cur, wr, wc, fr, fq); S.done(cur); }
        if (!has_next) break;
#pragma unroll
        for (int a = 0; a < 2; ++a)
#pragma unroll
            for (int b = 0; b < 2; ++b)
#pragma unroll
                for (int m = 0; m < 4; ++m)
#pragma unroll
                    for (int n = 0; n < 2; ++n) acc[a][b][m][n] = (f32x4){0.f, 0.f, 0.f, 0.f};
        cur = nxt; cA = nA; cB = nB; ++ui;
        if constexpr (ALIGN_EPI) { if (wr == 1) PG8_BAR; }
    }
    PG8_WAIT_V(0);
    if constexpr (!ALIGN_EPI) { if (wr == 0) PG8_BAR; }
    PG8_BAR;
    if constexpr (Epi::AFTER_DRAIN) { E.fused(acc, cur, wr, wc, fr, fq, lds, wid, lane); S.done(cur); }
#undef PG8_SA
#undef PG8_SB
#undef PG8_STAGE
#undef PG8_LDA
#undef PG8_LDB
#undef PG8_MMA
#undef PG8_WAIT_V
#undef PG8_WAIT_L
#undef PG8_BAR
#undef PG8_SCHED
}
}

#include <hip/hip_cooperative_groups.h>
namespace cg = cooperative_groups;
#ifndef ONE_LAUNCH
#define ONE_LAUNCH 1
#endif
#define LAS __attribute__((address_space(3)))
typedef unsigned short bf16;
typedef unsigned u32x4 __attribute__((ext_vector_type(4)));
typedef unsigned u32x2 __attribute__((ext_vector_type(2)));
typedef float f32x4 __attribute__((ext_vector_type(4)));
typedef short bf16x8 __attribute__((ext_vector_type(8)));
constexpr int NWAVES = 8, NTHR = 512;
constexpr int MP = 16384, MS = 1024, M = MP + MS;
constexpr int D = 1024, FF = 2816, NPROJ = 8224, NPROJ_PAD = 8448;
constexpr float EPS = 1e-6f;
constexpr int N_PHASES = 12;
constexpr size_t O_Y = 0, O_PP = 17825792, O_CP = 17948672, O_SP = 18022400, O_PS = 20119552, O_CS = 22085632, O_SS = 23265280, O_END = 56819712;
constexpr size_t MiB = 1u << 20;
constexpr size_t WS_W1A = 0, WS_W1B = 11 * MiB, WS_WIN = WS_W1B + 5632 * 1024, WS_WPG = WS_WIN + (size_t)NPROJ_PAD * 1024 * 2, WS_WPO = WS_WPG + 512 * 1024, WS_WSO = WS_WPO + 2 * MiB,
                 WS_WO = WS_WSO + 4 * MiB, WS_W2A = WS_WO + 2 * MiB, WS_W2B = WS_W2A + 11 * MiB, WS_WEND = WS_W2B + 5632 * 1024;
constexpr size_t SZ1K = (size_t)M * 1024 * 2, SZ2K = 2 * SZ1K, SZ3K = 3 * SZ1K;
constexpr size_t WS_SMALL = 58 * MiB;
constexpr size_t WS_SSQ = WS_SMALL, WS_DT = WS_SSQ + (size_t)M * 16 * 4, WS_SMALL_END = WS_DT + (size_t)M * 32 * 4;
constexpr size_t WS_XB = 62 * MiB;
constexpr size_t WS_RA = WS_XB + SZ1K;
constexpr size_t WS_RB = WS_RA + SZ3K;
constexpr size_t WS_RC = WS_RB + SZ3K;
constexpr size_t WS_RD = WS_RC + SZ1K;
constexpr size_t WS_RE = WS_RD + SZ2K;
constexpr size_t WS_RF = WS_RE + SZ2K;
constexpr size_t WS_END = WS_RF + SZ1K;
static_assert(WS_WEND <= WS_SMALL && WS_SMALL_END <= WS_XB && WS_END <= 512 * MiB, "d_ws map");
constexpr int LDS_BYTES = 158720;

__device__ __forceinline__ unsigned f2bf(float f) { unsigned u = __float_as_uint(f); return (u + 0x7fffu + ((u >> 16) & 1u)) >> 16; }
__device__ __forceinline__ unsigned pk2(float lo, float hi) { return f2bf(lo) | (f2bf(hi) << 16); }
__device__ __forceinline__ float bflo(unsigned w) { return __uint_as_float(w << 16); }
__device__ __forceinline__ float bfhi(unsigned w) { return __uint_as_float(w & 0xffff0000u); }
__device__ __forceinline__ float bf2f(bf16 v) { return __uint_as_float((unsigned)v << 16); }
__device__ __forceinline__ float wave_sum(float v) {
#pragma unroll
    for (int o = 1; o < 64; o <<= 1) v += __shfl_xor(v, o);
    return v;
}
#define LDS_WAIT() asm volatile("s_waitcnt lgkmcnt(0)" ::: "memory")
struct F8 { float v[8]; };
__device__ __forceinline__ F8 unpack8(u32x4 w) { F8 r; r.v[0] = bflo(w.x); r.v[1] = bfhi(w.x); r.v[2] = bflo(w.y); r.v[3] = bfhi(w.y); r.v[4] = bflo(w.z); r.v[5] = bfhi(w.z); r.v[6] = bflo(w.w); r.v[7] = bfhi(w.w); return r; }
__device__ __forceinline__ u32x4 pack8(const F8& a) { u32x4 w; w.x = pk2(a.v[0], a.v[1]); w.y = pk2(a.v[2], a.v[3]); w.z = pk2(a.v[4], a.v[5]); w.w = pk2(a.v[6], a.v[7]); return w; }
__device__ __forceinline__ F8 loadf8(const float* p) { const f32x4 a = *(const f32x4*)p, b = *(const f32x4*)(p + 4); F8 r; r.v[0] = a[0]; r.v[1] = a[1]; r.v[2] = a[2]; r.v[3] = a[3]; r.v[4] = b[0]; r.v[5] = b[1]; r.v[6] = b[2]; r.v[7] = b[3]; return r; }
__device__ __forceinline__ void storef8(float* p, const F8& a) { *(f32x4*)p = (f32x4){a.v[0], a.v[1], a.v[2], a.v[3]}; *(f32x4*)(p + 4) = (f32x4){a.v[4], a.v[5], a.v[6], a.v[7]}; }
__device__ __forceinline__ F8 zero8() { F8 r;
#pragma unroll
    for (int i = 0; i < 8; ++i) r.v[i] = 0.f;
    return r; }

struct Args { const float* in[25]; float* out; unsigned char* ws; int ph_lo, ph_hi; };
enum { I_XP = 0, I_XS, I_SPOOL, I_SCONV, I_SSSM, I_NF1, I_F1IN, I_F1OUT, I_NMIX, I_WIN, I_PWG, I_PSC, I_PWO, I_CW, I_CB, I_DTB, I_ALOG, I_DSKIP, I_SNORM, I_SWO, I_WO, I_NF2, I_F2IN, I_F2OUT, I_NFIN };

__device__ __forceinline__ void p0_item(const float* W, int K, int N, bf16* WT, int row_off, int mode, const float* gain, LAS float* scr, int item, int lane) {
    const int nblk = N / 32, kb = item / nblk, nb = item % nblk, k0 = 64 * kb, n0 = 32 * nb;
    const float gv = gain ? gain[k0 + lane] : 1.0f;
    float wv[32];
#pragma unroll
    for (int i = 0; i < 32; ++i) { const int kk = 2 * i + (lane >> 5); wv[i] = W[(size_t)(k0 + kk) * N + n0 + (lane & 31)]; }
#pragma unroll
    for (int i = 0; i < 32; ++i) { const int kk = 2 * i + (lane >> 5); scr[kk * 33 + (lane & 31)] = wv[i] * __shfl(gv, kk); }
    LDS_WAIT(); asm volatile("" ::: "memory");
    int dr = n0;
    if (mode == 1) { if (n0 < FF) dr = (n0 >> 7) * 256 + (n0 & 127); else { const int j = n0 - FF; dr = (j >> 7) * 256 + 128 + (j & 127); } }
    else if (mode == 2) { if (n0 >= 6176) dr = n0 - 32; else if (n0 >= 6144) dr = 8192 + (n0 - 6144); }
    const int c = lane & 7;
#pragma unroll
    for (int j = 0; j < 4; ++j) { const int n = (lane >> 3) + 8 * j; const LAS float* s = scr + (8 * c) * 33 + n;
        u32x4 o; o.x = pk2(s[0 * 33], s[1 * 33]); o.y = pk2(s[2 * 33], s[3 * 33]); o.z = pk2(s[4 * 33], s[5 * 33]); o.w = pk2(s[6 * 33], s[7 * 33]);
        *(u32x4*)(WT + (size_t)(row_off + dr + n) * K + k0 + 8 * c) = o; }
    LDS_WAIT(); asm volatile("" ::: "memory");
}
__device__ __forceinline__ void phase0(const Args& a, LAS unsigned char* lds, int G, int tid) {
    const int lane = tid & 63, wave = __builtin_amdgcn_readfirstlane(tid >> 6);
    LAS float* scr = (LAS float*)(lds + wave * 16384);
    const int gw = blockIdx.x * NWAVES + wave, NGW = G * NWAVES;
    unsigned char* ws = a.ws;
    constexpr int I1A = 16 * 176, I1B = 44 * 32, IIN = 16 * 257, IPG = 4 * 32, IPO = 16 * 32, ISO = 32 * 32, IWO = 16 * 32;
    constexpr int NITEMS = 2 * I1A + 2 * I1B + IIN + IPG + IPO + ISO + IWO;
    for (int it = gw; it < NITEMS; it += NGW) {
        int r = it;
        if (r < I1A) { p0_item(a.in[I_F1IN], D, 2 * FF, (bf16*)(ws + WS_W1A), 0, 1, a.in[I_NF1], scr, r, lane); continue; } r -= I1A;
        if (r < I1A) { p0_item(a.in[I_F2IN], D, 2 * FF, (bf16*)(ws + WS_W2A), 0, 1, a.in[I_NF2], scr, r, lane); continue; } r -= I1A;
        if (r < IIN) { p0_item(a.in[I_WIN], D, NPROJ, (bf16*)(ws + WS_WIN), 0, 2, a.in[I_NMIX], scr, r, lane); continue; } r -= IIN;
        if (r < I1B) { p0_item(a.in[I_F1OUT], FF, D, (bf16*)(ws + WS_W1B), 0, 0, nullptr, scr, r, lane); continue; } r -= I1B;
        if (r < I1B) { p0_item(a.in[I_F2OUT], FF, D, (bf16*)(ws + WS_W2B), 0, 0, nullptr, scr, r, lane); continue; } r -= I1B;
        if (r < IPG) { const int g = r >> 5; p0_item(a.in[I_PWG] + (size_t)g * 65536, 256, 256, (bf16*)(ws + WS_WPG), g * 256, 0, nullptr, scr, r & 31, lane); continue; } r -= IPG;
        if (r < IPO) { p0_item(a.in[I_PWO], D, D, (bf16*)(ws + WS_WPO), 0, 0, a.in[I_PSC], scr, r, lane); continue; } r -= IPO;
        if (r < ISO) { p0_item(a.in[I_SWO], 2048, D, (bf16*)(ws + WS_WSO), 0, 0, a.in[I_SNORM], scr, r, lane); continue; } r -= ISO;
        p0_item(a.in[I_WO], D, D, (bf16*)(ws + WS_WO), 0, 0, nullptr, scr, r, lane);
    }
    { u32x4* z = (u32x4*)(ws + WS_WIN + (size_t)NPROJ * 1024 * 2); const int n16 = (NPROJ_PAD - NPROJ) * 1024 * 2 / 16;
      for (int i = blockIdx.x * NTHR + tid; i < n16; i += G * NTHR) z[i] = (u32x4){0u, 0u, 0u, 0u}; }
    bf16* XN = (bf16*)(ws + WS_XB);
    for (int m0 = gw * 2; m0 < M; m0 += NGW * 2) {
        const float* xrow = (m0 < MP) ? a.in[I_XP] + (size_t)m0 * D : a.in[I_XS] + (size_t)(m0 - MP) * D;
        const f32x4* xr = (const f32x4*)xrow + lane;
        f32x4 v[2][4]; float s[2] = {0.f, 0.f};
#pragma unroll
        for (int q = 0; q < 2; ++q)
#pragma unroll
            for (int j = 0; j < 4; ++j) v[q][j] = xr[256 * q + 64 * j];
#pragma unroll
        for (int q = 0; q < 2; ++q)
#pragma unroll
            for (int j = 0; j < 4; ++j) s[q] += (v[q][j][0] * v[q][j][0] + v[q][j][1] * v[q][j][1]) + (v[q][j][2] * v[q][j][2] + v[q][j][3] * v[q][j][3]);
#pragma unroll
        for (int q = 0; q < 2; ++q) { const float rstd = __builtin_amdgcn_rsqf(wave_sum(s[q]) * (1.f / D) + EPS);
            u32x2* o8 = (u32x2*)(XN + (size_t)(m0 + q) * D) + lane;
#pragma unroll
            for (int j = 0; j < 4; ++j) { u32x2 w; w.x = pk2(v[q][j][0] * rstd, v[q][j][1] * rstd); w.y = pk2(v[q][j][2] * rstd, v[q][j][3] * rstd); o8[64 * j] = w; } }
    }
}

__device__ __forceinline__ void phase4(const Args& a, int G, int tid) {
    unsigned char* ws = a.ws;
    const bf16* U = (const bf16*)(ws + WS_RC); const bf16* XBC = (const bf16*)(ws + WS_RA);
    bf16* Dp = (bf16*)(ws + WS_RF); bf16* XC = (bf16*)(ws + WS_RB);
    const float* spool = a.in[I_SPOOL]; const float* sconv = a.in[I_SCONV];
    const int gt = blockIdx.x * NTHR + tid, NT = G * NTHR;
    for (int u = gt; u < 65536 + 16384; u += NT) {
        const bool smp = u >= 65536; int b, t0, nrows, slab;
        if (!smp) { slab = u & 127; t0 = ((u >> 7) & 63) * 32; b = u >> 13; nrows = 32; }
        else { const int v = u - 65536; slab = v & 127; b = v >> 7; t0 = 0; nrows = 8; }
        const int c0 = slab * 8, w = 2 << (c0 >> 8);
        const size_t rowbase = smp ? (size_t)MP + b * 8 : (size_t)b * 2048;
        const bf16* Ub = U + rowbase * 1024 + c0; const float* hb = spool + ((size_t)b * 15 + 15) * 1024 + c0;
        F8 s = zero8();
        for (int j = 1; j < w; ++j) {
            const int i = t0 - j;
            if (i >= 0) { const F8 x = unpack8(*(const u32x4*)(Ub + (ptrdiff_t)i * 1024));
#pragma unroll
                for (int e = 0; e < 8; ++e) s.v[e] += x.v[e]; }
            else if (smp) { const F8 x = loadf8(hb + (ptrdiff_t)i * 1024);
#pragma unroll
                for (int e = 0; e < 8; ++e) s.v[e] += x.v[e]; }
        }
        for (int tb = t0; tb < t0 + nrows; tb += 8) {
            u32x4 curw[8]; F8 oldv[8];
#pragma unroll
            for (int k = 0; k < 8; ++k) curw[k] = *(const u32x4*)(Ub + (size_t)(tb + k) * 1024);
#pragma unroll
            for (int k = 0; k < 8; ++k) { const int i = tb + k - w + 1;
                if (i >= 0) oldv[k] = unpack8(*(const u32x4*)(Ub + (ptrdiff_t)i * 1024));
                else if (smp) oldv[k] = loadf8(hb + (ptrdiff_t)i * 1024);
                else oldv[k] = zero8(); }
#pragma unroll
            for (int k = 0; k < 8; ++k) {
                const int t = tb + k; const F8 cur = unpack8(curw[k]);
                const float cnt = smp ? (float)w : (float)((t + 1 < w) ? t + 1 : w);
                F8 d;
#pragma unroll
                for (int e = 0; e < 8; ++e) { s.v[e] += cur.v[e]; d.v[e] = s.v[e] / cnt - cur.v[e]; s.v[e] -= oldv[k].v[e]; }
                *(u32x4*)(Dp + (rowbase + t) * 1024 + c0) = pack8(d);
            }
        }
    }
    const float* cw = a.in[I_CW]; const float* cb = a.in[I_CB];
    for (int u = gt; u < 196608 + 49152; u += NT) {
        const bool smp = u >= 196608; int b, t0, nrows, slab;
        if (!smp) { slab = u % 384; const int q = u / 384; t0 = (q & 63) * 32; b = q >> 6; nrows = 32; }
        else { const int v = u - 196608; slab = v % 384; b = v / 384; t0 = 0; nrows = 8; }
        const int c0 = slab * 8;
        const size_t rowbase = smp ? (size_t)MP + b * 8 : (size_t)b * 2048;
        const F8 w0 = loadf8(cw + c0), w1 = loadf8(cw + 3072 + c0), w2 = loadf8(cw + 6144 + c0), w3 = loadf8(cw + 9216 + c0), bi = loadf8(cb + c0);
        F8 xm3, xm2, xm1;
        if (smp) { xm3 = loadf8(sconv + ((size_t)b * 3 + 0) * 3072 + c0); xm2 = loadf8(sconv + ((size_t)b * 3 + 1) * 3072 + c0); xm1 = loadf8(sconv + ((size_t)b * 3 + 2) * 3072 + c0); }
        else if (t0 == 0) { xm3 = zero8(); xm2 = zero8(); xm1 = zero8(); }
        else { xm3 = unpack8(*(const u32x4*)(XBC + (rowbase + t0 - 3) * 3072 + c0)); xm2 = unpack8(*(const u32x4*)(XBC + (rowbase + t0 - 2) * 3072 + c0)); xm1 = unpack8(*(const u32x4*)(XBC + (rowbase + t0 - 1) * 3072 + c0)); }
        for (int tb = t0; tb < t0 + nrows; tb += 8) {
            u32x4 curw[8];
#pragma unroll
            for (int k = 0; k < 8; ++k) curw[k] = *(const u32x4*)(XBC + (rowbase + tb + k) * 3072 + c0);
#pragma unroll
            for (int k = 0; k < 8; ++k) {
                const F8 cur = unpack8(curw[k]);
                F8 y;
#pragma unroll
                for (int e = 0; e < 8; ++e) { const float v = bi.v[e] + xm3.v[e] * w0.v[e] + xm2.v[e] * w1.v[e] + xm1.v[e] * w2.v[e] + cur.v[e] * w3.v[e]; y.v[e] = v / (1.0f + __expf(-v)); }
                *(u32x4*)(XC + (rowbase + tb + k) * 3072 + c0) = pack8(y);
                xm3 = xm2; xm2 = xm1; xm1 = cur;
            }
        }
    }
    for (int u = gt; u < (8 + 128) * 15 * 128; u += NT) {
        const int slab = u & 127, rj = u >> 7, c0 = slab * 8;
        if (rj < 120) { const int b = rj / 15, j = rj % 15;
            storef8(a.out + O_PP + ((size_t)b * 15 + j) * 1024 + c0, unpack8(*(const u32x4*)(U + ((size_t)b * 2048 + 2033 + j) * 1024 + c0))); }
        else { const int r2 = rj - 120, b = r2 / 15, j = r2 % 15;
            const F8 v = (j < 7) ? loadf8(spool + ((size_t)b * 15 + 8 + j) * 1024 + c0) : unpack8(*(const u32x4*)(U + ((size_t)MP + b * 8 + (j - 7)) * 1024 + c0));
            storef8(a.out + O_PS + ((size_t)b * 15 + j) * 1024 + c0, v); }
    }
    for (int u = gt; u < (8 + 128) * 3 * 384; u += NT) {
        const int slab = u % 384, rj = u / 384, c0 = slab * 8;
        if (rj < 24) { const int b = rj / 3, j = rj % 3;
            storef8(a.out + O_CP + ((size_t)b * 3 + j) * 3072 + c0, unpack8(*(const u32x4*)(XBC + ((size_t)b * 2048 + 2045 + j) * 3072 + c0))); }
        else { const int r2 = rj - 24, b = r2 / 3, j = r2 % 3;
            storef8(a.out + O_CS + ((size_t)b * 3 + j) * 3072 + c0, unpack8(*(const u32x4*)(XBC + ((size_t)MP + b * 8 + 5 + j) * 3072 + c0))); }
    }
}

#define MFMA16(p, q, c) __builtin_amdgcn_mfma_f32_16x16x32_bf16((p), (q), (c), 0, 0, 0)
constexpr int LDW = 136;
__device__ __forceinline__ void ssd_prompt_unit(LAS unsigned char* lds, int b, int h, const bf16* XC, const float* DT, const bf16* Z, bf16* YG, const float* a_log, const float* d_skip, float* out_ssm, int tid) {
    const int wave = __builtin_amdgcn_readfirstlane(tid >> 6), lane = tid & 63, l16 = lane & 15, quad = lane >> 4, g = h >> 3;
    LAS bf16* Cs = (LAS bf16*)lds;
    LAS bf16* Bs = Cs + 128 * LDW;
    LAS bf16* BT = Bs + 128 * LDW;
    LAS bf16* XT = BT + 128 * LDW;
    LAS bf16* XwT = XT + 64 * LDW;
    LAS bf16* Hb = XwT + 64 * LDW;
    LAS float* acs = (LAS float*)(Hb + 64 * LDW);
    LAS float* dts = acs + 128;
    const float A = -__expf(a_log[h]), Dh = d_skip[h];
    f32x4 hacc[4];
#pragma unroll
    for (int pt = 0; pt < 4; ++pt) hacc[pt] = (f32x4){0.f, 0.f, 0.f, 0.f};
    for (int i = tid; i < 64 * LDW / 2; i += NTHR) ((LAS unsigned*)Hb)[i] = 0u;
    for (int c = 0; c < 16; ++c) {
        const size_t row0 = (size_t)b * 2048 + c * 128;
        u32x4 cgv[4], bgv[4], xgv[2];
#pragma unroll
        for (int i = 0; i < 4; ++i) { const int idx = tid + NTHR * i, l = idx >> 4, seg = idx & 15; const bf16* rp = XC + (row0 + l) * 3072 + g * 128 + seg * 8;
            cgv[i] = *(const u32x4*)(rp + 2560); bgv[i] = *(const u32x4*)(rp + 2048); }
#pragma unroll
        for (int i = 0; i < 2; ++i) { const int idx = tid + NTHR * i, l = idx >> 3, seg = idx & 7; xgv[i] = *(const u32x4*)(XC + (row0 + l) * 3072 + h * 64 + seg * 8); }
        if (wave == 0) {
            const float d0 = DT[(row0 + lane) * 32 + h], d1 = DT[(row0 + 64 + lane) * 32 + h];
            float a0 = d0 * A, a1 = d1 * A;
#pragma unroll
            for (int o = 1; o < 64; o <<= 1) { const float t0 = __shfl_up(a0, o), t1 = __shfl_up(a1, o); if (lane >= o) { a0 += t0; a1 += t1; } }
            a1 += __shfl(a0, 63);
            acs[lane] = a0; acs[64 + lane] = a1; dts[lane] = d0; dts[64 + lane] = d1;
        }
        __syncthreads();
        const float a_end = acs[127];
#pragma unroll
        for (int i = 0; i < 4; ++i) { const int idx = tid + NTHR * i, l = idx >> 4, seg = idx & 15;
            *(LAS u32x4*)(Cs + l * LDW + seg * 8) = cgv[i]; *(LAS u32x4*)(Bs + l * LDW + seg * 8) = bgv[i];
            const u32x4 w = bgv[i]; LAS bf16* bt = BT + (seg * 8) * LDW + l;
            bt[0 * LDW] = (bf16)(w.x & 0xffffu); bt[1 * LDW] = (bf16)(w.x >> 16); bt[2 * LDW] = (bf16)(w.y & 0xffffu); bt[3 * LDW] = (bf16)(w.y >> 16);
            bt[4 * LDW] = (bf16)(w.z & 0xffffu); bt[5 * LDW] = (bf16)(w.z >> 16); bt[6 * LDW] = (bf16)(w.w & 0xffffu); bt[7 * LDW] = (bf16)(w.w >> 16); }
#pragma unroll
        for (int i = 0; i < 2; ++i) { const int idx = tid + NTHR * i, l = idx >> 3, seg = idx & 7;
            const float dtl = dts[l], wl = dtl * __expf(a_end - acs[l]); const F8 x = unpack8(xgv[i]);
            LAS bf16* xt = XT + (seg * 8) * LDW + l; LAS bf16* xw = XwT + (seg * 8) * LDW + l;
#pragma unroll
            for (int e = 0; e < 8; ++e) { xt[e * LDW] = (bf16)f2bf(x.v[e] * dtl); xw[e * LDW] = (bf16)f2bf(x.v[e] * wl); } }
        __syncthreads();
        const int lrow = 16 * wave + l16;
        bf16x8 cf[4];
#pragma unroll
        for (int kk = 0; kk < 4; ++kk) cf[kk] = *(const LAS bf16x8*)(Cs + lrow * LDW + kk * 32 + quad * 8);
        const float acs_l = acs[lrow];
        f32x4 yo[4];
#pragma unroll
        for (int pt = 0; pt < 4; ++pt) { f32x4 t = (f32x4){0.f, 0.f, 0.f, 0.f};
#pragma unroll
            for (int kk = 0; kk < 4; ++kk) t = MFMA16(*(const LAS bf16x8*)(Hb + (16 * pt + l16) * LDW + kk * 32 + quad * 8), cf[kk], t);
            yo[pt] = t; }
        const int nct = (wave | 1) + 1;
        for (int ct = 0; ct < nct; ++ct) {
            f32x4 t = (f32x4){0.f, 0.f, 0.f, 0.f};
            if (ct <= wave) {
#pragma unroll
                for (int kk = 0; kk < 4; ++kk) t = MFMA16(*(const LAS bf16x8*)(Bs + (16 * ct + l16) * LDW + kk * 32 + quad * 8), cf[kk], t);
                const f32x4 as = *(const LAS f32x4*)(acs + 16 * ct + 4 * quad);
#pragma unroll
                for (int r = 0; r < 4; ++r) { const int s = 16 * ct + 4 * quad + r; t[r] = (s <= lrow) ? t[r] * __expf(acs_l - as[r]) : 0.f; }
            }
            u32x2 w; w.x = pk2(t[0], t[1]); w.y = pk2(t[2], t[3]);
            *(LAS u32x2*)(Cs + lrow * LDW + 16 * ct + 4 * quad) = w;
        }
        f32x4 yd[4];
#pragma unroll
        for (int pt = 0; pt < 4; ++pt) yd[pt] = (f32x4){0.f, 0.f, 0.f, 0.f};
        const int nks = (wave >> 1) + 1;
        for (int ks = 0; ks < nks; ++ks) { const bf16x8 gq = *(const LAS bf16x8*)(Cs + lrow * LDW + ks * 32 + quad * 8);
#pragma unroll
            for (int pt = 0; pt < 4; ++pt) yd[pt] = MFMA16(*(const LAS bf16x8*)(XT + (16 * pt + l16) * LDW + ks * 32 + quad * 8), gq, yd[pt]); }
        { const float el = __expf(acs_l); const size_t row = row0 + lrow;
#pragma unroll
          for (int pt = 0; pt < 4; ++pt) { const int p0 = 16 * pt + 4 * quad;
              const u32x2 xr = *(const u32x2*)(XC + row * 3072 + h * 64 + p0), zr = *(const u32x2*)(Z + row * 2048 + h * 64 + p0);
              const float xv[4] = {bflo(xr.x), bfhi(xr.x), bflo(xr.y), bfhi(xr.y)}, zv[4] = {bflo(zr.x), bfhi(zr.x), bflo(zr.y), bfhi(zr.y)};
              float o[4];
#pragma unroll
              for (int r = 0; r < 4; ++r) { const float y = yd[pt][r] + el * yo[pt][r] + Dh * xv[r]; o[r] = y * (zv[r] / (1.0f + __expf(-zv[r]))); }
              u32x2 w; w.x = pk2(o[0], o[1]); w.y = pk2(o[2], o[3]);
              *(u32x2*)(YG + row * 2048 + h * 64 + p0) = w; } }
        __syncthreads();
        { const float cd = __expf(a_end);
#pragma unroll
          for (int pt = 0; pt < 4; ++pt) { f32x4 t = hacc[pt] * cd;
#pragma unroll
              for (int kk = 0; kk < 4; ++kk) t = MFMA16(*(const LAS bf16x8*)(BT + (16 * wave + l16) * LDW + kk * 32 + quad * 8), *(const LAS bf16x8*)(XwT + (16 * pt + l16) * LDW + kk * 32 + quad * 8), t);
              hacc[pt] = t;
              u32x2 w; w.x = pk2(t[0], t[1]); w.y = pk2(t[2], t[3]);
              *(LAS u32x2*)(Hb + (16 * pt + l16) * LDW + 16 * wave + 4 * quad) = w; } }
    }
#pragma unroll
    for (int pt = 0; pt < 4; ++pt) *(f32x4*)(out_ssm + ((size_t)(b * 32 + h) * 64 + 16 * pt + l16) * 128 + 16 * wave + 4 * quad) = hacc[pt];
    __syncthreads();
}
__device__ __forceinline__ void ssd_sample_unit(int b, int h, const bf16* __restrict__ XC, const float* __restrict__ DT, const bf16* __restrict__ Z, bf16* __restrict__ YG, const float* a_log, const float* d_skip, const float* __restrict__ st_in, float* __restrict__ st_out, int tid) {
    const int p = tid >> 3, nq = tid & 7, g = h >> 3;
    const size_t so = ((size_t)(b * 32 + h) * 64 + p) * 128 + nq * 16;
    f32x4 hv[4];
#pragma unroll
    for (int j = 0; j < 4; ++j) hv[j] = *(const f32x4*)(st_in + so + 4 * j);
    const float A = -__expf(a_log[h]), Dh = d_skip[h];
    const size_t rowb = (size_t)MP + b * 8;
    float dtv[8]; bf16 xr[8], zr[8]; u32x4 Bq[8][2], Cq[8][2];
#pragma unroll
    for (int t = 0; t < 8; ++t) {
        const size_t row = rowb + t;
        dtv[t] = DT[row * 32 + h]; xr[t] = XC[row * 3072 + h * 64 + p]; zr[t] = Z[row * 2048 + h * 64 + p];
        const bf16* bp = XC + row * 3072 + 2048 + g * 128 + nq * 16;
        Bq[t][0] = *(const u32x4*)bp; Bq[t][1] = *(const u32x4*)(bp + 8); Cq[t][0] = *(const u32x4*)(bp + 512); Cq[t][1] = *(const u32x4*)(bp + 520);
    }
    float ygv[8];
#pragma unroll
    for (int t = 0; t < 8; ++t) {
        const float dt = dtv[t], dA = __expf(dt * A), xv = bf2f(xr[t]);
        const F8 B0 = unpack8(Bq[t][0]), B1 = unpack8(Bq[t][1]), C0 = unpack8(Cq[t][0]), C1 = unpack8(Cq[t][1]);
        const float coef = dt * xv; float y = 0.f;
#pragma unroll
        for (int j = 0; j < 4; ++j) {
#pragma unroll
            for (int e = 0; e < 4; ++e) { const int k = 4 * j + e; const float Bv = k < 8 ? B0.v[k & 7] : B1.v[k & 7], Cv = k < 8 ? C0.v[k & 7] : C1.v[k & 7];
                const float hn = hv[j][e] * dA + coef * Bv; hv[j][e] = hn; y += hn * Cv; } }
        y += __shfl_xor(y, 1); y += __shfl_xor(y, 2); y += __shfl_xor(y, 4);
        y += Dh * xv;
        const float z = bf2f(zr[t]);
        ygv[t] = y * (z / (1.0f + __expf(-z)));
    }
    if (nq == 0) {
#pragma unroll
        for (int t = 0; t < 8; ++t) YG[(rowb + t) * 2048 + h * 64 + p] = (bf16)f2bf(ygv[t]);
    }
#pragma unroll
    for (int j = 0; j < 4; ++j) *(f32x4*)(st_out + so + 4 * j) = hv[j];
}

__global__ void __launch_bounds__(NTHR, 2) fwd_kernel(Args a) {
    extern __shared__ __attribute__((aligned(16))) unsigned char lds_raw[];
    LAS unsigned char* lds = (LAS unsigned char*)lds_raw;
    const int tid = threadIdx.x, G = gridDim.x, lane = tid & 63, wave = __builtin_amdgcn_readfirstlane(tid >> 6);
    unsigned char* ws = a.ws;
    const int lo = a.ph_lo, hi = a.ph_hi;
    using namespace pg8;
    bf16* XB = (bf16*)(ws + WS_XB); bf16* HID = (bf16*)(ws + WS_RA); float* SSQ = (float*)(ws + WS_SSQ); float* DT = (float*)(ws + WS_DT);
    float* X = a.out + O_Y;
#define IN(k) (lo <= (k) && (k) < hi)
#define SEAM(k) do { if ((k) + 1 < hi) cg::this_grid().sync(); } while (0)
    if (IN(0)) { phase0(a, lds, G, tid); SEAM(0); }
    if (IN(1)) {
        Gemm g{XB, (const bf16_t*)(ws + WS_W1A), M, 2 * FF, D, D, D, 0}; StaticOrder S; S.init(M, 2 * FF, G, (int)blockIdx.x);
        EpiSwiGLU E{HID, nullptr};
        gemm_phase<EpiSwiGLU, StaticOrder, true, true>(lds, g, S, E); SEAM(1);
    }
    if (IN(2)) {
        Gemm g{HID, (const bf16_t*)(ws + WS_W1B), M, D, FF, FF, FF, 0}; StaticOrder S; S.init(M, D, G, (int)blockIdx.x);
        EpiResid E{a.in[I_XP], a.in[I_XS] - (size_t)MP * D, X, XB, SSQ, 0.5f};
        gemm_phase<EpiResid, StaticOrder, true, true>(lds, g, S, E); SEAM(2);
    }
    if (IN(3)) {
        Gemm g{XB, (const bf16_t*)(ws + WS_WIN), M, NPROJ_PAD, D, D, D, 0}; StaticOrder S; S.init(M, NPROJ_PAD, G, (int)blockIdx.x);
        EpiInProj E{(bf16*)(ws + WS_RC), (bf16*)(ws + WS_RD), (bf16*)(ws + WS_RA), (bf16*)(ws + WS_RE), DT, a.in[I_DTB], SSQ};
        gemm_phase<EpiInProj, StaticOrder, true, true>(lds, g, S, E); SEAM(3);
    }
    if (IN(4)) { phase4(a, G, tid); SEAM(4); }
    if (IN(5)) {
        const bf16* XC = (const bf16*)(ws + WS_RB); const bf16* Z = (const bf16*)(ws + WS_RD); bf16* YG = (bf16*)(ws + WS_RA);
        for (int u = blockIdx.x; u < 256; u += G) ssd_prompt_unit(lds, u >> 5, u & 31, XC, DT, Z, YG, a.in[I_ALOG], a.in[I_DSKIP], a.out + O_SP, tid);
        for (int u = blockIdx.x; u < 4096; u += G) ssd_sample_unit(u >> 5, u & 31, XC, DT, Z, YG, a.in[I_ALOG], a.in[I_DSKIP], a.in[I_SSSM], a.out + O_SS, tid);
        __syncthreads();
        Gemm g{(const bf16_t*)(ws + WS_RF), (const bf16_t*)(ws + WS_WPG), M, D, 256, D, 256, 256}; StaticOrder S; S.init(M, D, G, (int)blockIdx.x);
        EpiPlain E{(bf16*)(ws + WS_RC)};
        gemm_phase<EpiPlain, StaticOrder, true, true>(lds, g, S, E); SEAM(5);
    }
    if (IN(6)) {
        Gemm g{(const bf16_t*)(ws + WS_RC), (const bf16_t*)(ws + WS_WPO), M, D, D, D, D, 0}; StaticOrder S; S.init(M, D, G, (int)blockIdx.x);
        EpiPlain E{(bf16*)(ws + WS_RB)};
        gemm_phase<EpiPlain, StaticOrder, true, true>(lds, g, S, E);
        bf16* YG = (bf16*)(ws + WS_RA);
        for (int u0 = (blockIdx.x * NWAVES + wave) * 4; u0 < M * 4; u0 += G * NWAVES * 4) {
            u32x4* p = (u32x4*)(YG + (size_t)u0 * 512) + lane; u32x4 raw[4];
#pragma unroll
            for (int q = 0; q < 4; ++q) raw[q] = p[64 * q];
#pragma unroll
            for (int q = 0; q < 4; ++q) { F8 v = unpack8(raw[q]); float s = 0.f;
#pragma unroll
                for (int e = 0; e < 8; ++e) s += v.v[e] * v.v[e];
                const float r = __builtin_amdgcn_rsqf(wave_sum(s) * (1.0f / 512.0f) + EPS);
#pragma unroll
                for (int e = 0; e < 8; ++e) v.v[e] *= r;
                p[64 * q] = pack8(v); }
        }
        SEAM(6);
    }
    if (IN(7)) {
        Gemm g{(const bf16_t*)(ws + WS_RA), (const bf16_t*)(ws + WS_WSO), M, D, 2048, 2048, 2048, 0}; StaticOrder S; S.init(M, D, G, (int)blockIdx.x);
        EpiMerge E{(const bf16_t*)(ws + WS_RE), (const bf16_t*)(ws + WS_RB), (bf16*)(ws + WS_RB + SZ1K)};
        gemm_phase<EpiMerge, StaticOrder, true, true>(lds, g, S, E); SEAM(7);
    }
    if (IN(8)) {
        Gemm g{(const bf16_t*)(ws + WS_RB + SZ1K), (const bf16_t*)(ws + WS_WO), M, D, D, D, D, 0}; StaticOrder S; S.init(M, D, G, (int)blockIdx.x);
        EpiResid E{X, X, X, XB, SSQ, 1.0f};
        gemm_phase<EpiResid, StaticOrder, true, true>(lds, g, S, E); SEAM(8);
    }
    if (IN(9)) {
        Gemm g{XB, (const bf16_t*)(ws + WS_W2A), M, 2 * FF, D, D, D, 0}; StaticOrder S; S.init(M, 2 * FF, G, (int)blockIdx.x);
        EpiSwiGLU E{HID, SSQ};
        gemm_phase<EpiSwiGLU, StaticOrder, true, true>(lds, g, S, E); SEAM(9);
    }
    if (IN(10)) {
        Gemm g{HID, (const bf16_t*)(ws + WS_W2B), M, D, FF, FF, FF, 0}; StaticOrder S; S.init(M, D, G, (int)blockIdx.x);
        EpiResid E{X, X, X, XB, SSQ, 0.5f};
        gemm_phase<EpiResid, StaticOrder, true, true>(lds, g, S, E); SEAM(10);
    }
    if (IN(11)) {
        const float* gn = a.in[I_NFIN];
        for (int m0 = (blockIdx.x * NWAVES + wave) * 2; m0 < M; m0 += G * NWAVES * 2) {
            f32x4* xr = (f32x4*)(X + (size_t)m0 * D) + lane; f32x4 v[2][4]; float s[2] = {0.f, 0.f};
#pragma unroll
            for (int q = 0; q < 2; ++q)
#pragma unroll
                for (int j = 0; j < 4; ++j) v[q][j] = xr[256 * q + 64 * j];
#pragma unroll
            for (int q = 0; q < 2; ++q)
#pragma unroll
                for (int j = 0; j < 4; ++j) s[q] += (v[q][j][0] * v[q][j][0] + v[q][j][1] * v[q][j][1]) + (v[q][j][2] * v[q][j][2] + v[q][j][3] * v[q][j][3]);
#pragma unroll
            for (int q = 0; q < 2; ++q) { const float rstd = __builtin_amdgcn_rsqf(wave_sum(s[q]) * (1.f / D) + EPS);
#pragma unroll
                for (int j = 0; j < 4; ++j) { const f32x4 gv = ((const f32x4*)gn)[lane + 64 * j]; xr[256 * q + 64 * j] = v[q][j] * rstd * gv; } }
        }
    }
#undef IN
#undef SEAM
}

extern "C" void kernel_launch(void* const* d_in, const int* in_sizes, int n_in, void* d_out, int out_size, void* d_ws, size_t ws_size, hipStream_t stream) {
    static int grid = 0;
    if (grid == 0) {
        if (n_in != 25 || out_size != (int)O_END || ws_size < WS_END) { fprintf(stderr, "kernel_launch: unexpected sizes n_in %d out %d ws %zu (need %zu)\n", n_in, out_size, ws_size, (size_t)WS_END); grid = -1; return; }
        int dev = 0, cus = 0, per_cu = 0;
        hipGetDevice(&dev); hipDeviceGetAttribute(&cus, hipDeviceAttributeMultiprocessorCount, dev);
        if (hipFuncSetAttribute((const void*)fwd_kernel, hipFuncAttributeMaxDynamicSharedMemorySize, LDS_BYTES) != hipSuccess) { fprintf(stderr, "kernel_launch: hipFuncSetAttribute failed\n"); grid = -1; return; }
        hipOccupancyMaxActiveBlocksPerMultiprocessor(&per_cu, (const void*)fwd_kernel, NTHR, LDS_BYTES);
        (void)hipGetLastError();
        if (per_cu < 1) fprintf(stderr, "kernel_launch: occupancy query says %d blocks per CU\n", per_cu);
        grid = cus;
    }
    if (grid < 0) return;
    Args a{};
    for (int i = 0; i < 25; ++i) a.in[i] = (const float*)d_in[i];
    a.out = (float*)d_out; a.ws = (unsigned char*)d_ws;
#if ONE_LAUNCH
    a.ph_lo = 0; a.ph_hi = N_PHASES;
    void* args[] = {&a};
    hipError_t e = hipLaunchCooperativeKernel((const void*)fwd_kernel, dim3(grid), dim3(NTHR), args, LDS_BYTES, stream);
    if (e != hipSuccess) fprintf(stderr, "cooperative launch failed: %s (grid %d)\n", hipGetErrorString(e), grid);
#else
    for (int ph = 0; ph < N_PHASES; ++ph) { a.ph_lo = ph; a.ph_hi = ph + 1; hipLaunchKernelGGL(fwd_kernel, dim3(grid), dim3(NTHR), LDS_BYTES, stream, a); }
#endif
}
```

```cpp
#include <hip/hip_runtime.h>
#include <cstdio>
#include <cstdint>
namespace pg8 {
#define PG8_LAS __attribute__((address_space(3)))
typedef unsigned short bf16_t;
typedef short bf16x8 __attribute__((ext_vector_type(8)));
typedef float f32x4 __attribute__((ext_vector_type(4)));
typedef unsigned u32x4 __attribute__((ext_vector_type(4)));
constexpr int BM = 256, BK = 64, HALF = 128, HTB = HALF * BK * 2  , STAGE_BYTES = 8 * HTB, NXCD = 8, WGM = 8;

__host__ __device__ __forceinline__ int lds_byte(int r, int c) { const int st = (r >> 4) * 2 + (c >> 5), rr = r & 15, cc = c & 31, ob = rr * 64 + cc * 2; return st * 1024 + (ob ^ (((ob >> 9) & 1) << 5)); }
__host__ __device__ __forceinline__ void stage_rc(int b, int& R, int& C) { const int st = b / 1024, sb = b % 1024, swz = sb ^ (((sb >> 9) & 1) << 5); R = (st >> 1) * 16 + swz / 64; C = (st & 1) * 32 + (swz % 64) / 2; }
__host__ __device__ __forceinline__ int perm32(int rho) { const int n = rho >> 4, i = rho & 15; return 8 * (i >> 2) + 4 * n + (i & 3); }

struct Unit { int pm, pn, kofs, nt, part; };
struct Gemm { const bf16_t* A; const bf16_t* Bt; int M, N, K, lda, ldb, a_pn_off; float* part; };

struct StaticOrder {
    int nM, nN, nwg, G, c, ntf;
    __host__ __device__ void init(int M, int N, int K, int G_, int c_) { nM = M / BM; nN = N / BM; nwg = nM * nN; G = G_; c = c_; ntf = K / BK; }
    __host__ __device__ bool next(int i, Unit& u) const {
        const long L = (long)i * G + c; if (L >= nwg) return false;
        int wgid = (int)L; { const int q = nwg / NXCD, r = nwg % NXCD, xcd = wgid % NXCD, off = wgid / NXCD; wgid = (xcd < r ? xcd * (q + 1) : r * (q + 1) + (xcd - r) * q) + off; }
        const int nig = WGM * nN, gid = wgid / nig, fm = gid * WGM, gsz = (nM - fm) < WGM ? (nM - fm) : WGM;
        u.pm = fm + ((wgid % nig) % gsz); u.pn = (wgid % nig) / gsz; u.kofs = 0; u.nt = ntf; u.part = -1; return true;
    }
    __device__ __forceinline__ void a_ready(const Unit&) const {}
    __device__ __forceinline__ void done(const Unit&) const {}
};


struct SplitOrder {
    StaticOrder so; int S, G, c;
    __host__ __device__ void init(int K, int G_, int c_) { so.init(16384, 1024, K, G_, c_); S = K / 256; G = G_; c = c_; }
    __host__ __device__ bool next(int i, Unit& u) const {
        const int np = (c < 16 * S) ? 1 : 0;
        if (i < np) { const int tile = c / S, sp = c % S; u.pm = 64 + (tile >> 2); u.pn = tile & 3; u.kofs = sp * 512; u.nt = 4; u.part = sp; return true; }
        const long L = (long)(i - np) * G + c;
        if (L < 256) { StaticOrder t = so; t.c = (int)L; t.G = 0; return t.next(0, u); }
        const int j = (int)(L - 256) + ((G < 16 * S) ? G : 16 * S);
        if (j >= 16 * S || G >= 16 * S) return false;
        const int tile = j / S, sp = j % S;
        u.pm = 64 + (tile >> 2); u.pn = tile & 3; u.kofs = sp * 512; u.nt = 4; u.part = sp; return true;
    }
    __device__ __forceinline__ void a_ready(const Unit&) const {}
    __device__ __forceinline__ void done(const Unit&) const {}
};

__device__ __forceinline__ unsigned cvt_pk_bf16(float lo, float hi) { unsigned r; asm volatile("v_cvt_pk_bf16_f32 %0, %1, %2" : "=v"(r) : "v"(lo), "v"(hi)); return r; }
typedef float f32x2 __attribute__((ext_vector_type(2)));
__device__ __forceinline__ float bf_lo(unsigned w) { return __uint_as_float(w << 16); }
__device__ __forceinline__ float bf_hi(unsigned w) { return __uint_as_float(w & 0xffff0000u); }
__device__ __forceinline__ float silu_f(float g) { return g * __builtin_amdgcn_rcpf(1.0f + __expf(-g)); }
__device__ __forceinline__ float sigm_f(float g) { return __builtin_amdgcn_rcpf(1.0f + __expf(-g)); }
__device__ __forceinline__ float rstd16(const float* ssq, int row) {
    const f32x4* p = (const f32x4*)(ssq + (size_t)row * 16);
    const f32x4 a = p[0], b = p[1], c = p[2], d = p[3];
    const float s = ((a[0] + a[1]) + (a[2] + a[3])) + ((b[0] + b[1]) + (b[2] + b[3])) + ((c[0] + c[1]) + (c[2] + c[3])) + ((d[0] + d[1]) + (d[2] + d[3]));
    return __builtin_amdgcn_rsqf(s * (1.0f / 1024.0f) + 1e-6f);
}
struct EpiSwiGLU {
    static constexpr bool PERM = true, AFTER_DRAIN = false, KSEG = false, PREF = true;
    bf16_t* O; const float* rstd;
    __device__ __forceinline__ void operator()(const f32x4 (&acc)[2][2][4][2], const Unit& u, int wr, int wc, int fr, int fq, const PG8_LAS float* epl) const {
        float rsv[2][4];
#pragma unroll
        for (int ai = 0; ai < 2; ++ai)
#pragma unroll
            for (int m = 0; m < 4; ++m) rsv[ai][m] = epl[ai * HALF + wr * 64 + m * 16 + fr];
#pragma unroll
        for (int ai = 0; ai < 2; ++ai)
#pragma unroll
            for (int m = 0; m < 4; ++m) {
                const int row = u.pm * BM + ai * HALF + wr * 64 + m * 16 + fr;
                const float rs = rsv[ai][m];
                const f32x4 g0 = acc[ai][0][m][0] * rs, g1 = acc[ai][0][m][1] * rs, u0 = acc[ai][1][m][0] * rs, u1 = acc[ai][1][m][1] * rs;
                u32x4 w;
                w.x = cvt_pk_bf16(silu_f(g0[0]) * u0[0], silu_f(g0[1]) * u0[1]); w.y = cvt_pk_bf16(silu_f(g0[2]) * u0[2], silu_f(g0[3]) * u0[3]);
                w.z = cvt_pk_bf16(silu_f(g1[0]) * u1[0], silu_f(g1[1]) * u1[1]); w.w = cvt_pk_bf16(silu_f(g1[2]) * u1[2], silu_f(g1[3]) * u1[3]);
                *(u32x4*)(O + (size_t)row * 2816 + u.pn * 128 + wc * 32 + fq * 8) = w;
            }
    }
};
template <bool BASE_BF16, bool WRITE_X, bool WRITE_XB, bool SCALED = false> struct EpiResid {
    static constexpr bool PERM = true, AFTER_DRAIN = false, KSEG = false, PREF = false;
    const float* baseP; const float* baseS;
    float* X; bf16_t* XB; float* ssq; float scale;
    __device__ __forceinline__ void operator()(const f32x4 (&acc)[2][2][4][2], const Unit& u, int wr, int wc, int fr, int fq) const {
        const float* base = (u.pm < 64) ? baseP : baseS;
#pragma unroll
        for (int ai = 0; ai < 2; ++ai) {
            f32x4 bv[4][2][2];
            float rinv[4];
#pragma unroll
            for (int m = 0; m < 4; ++m) rinv[m] = SCALED ? baseP[u.pm * BM + ai * HALF + wr * 64 + m * 16 + fr] : 1.0f;
#pragma unroll
            for (int m = 0; m < 4; ++m) { const size_t off = (size_t)(u.pm * BM + ai * HALF + wr * 64 + m * 16 + fr) * 1024 + u.pn * BM + wc * 32 + fq * 8;
#pragma unroll
                for (int bj = 0; bj < 2; ++bj) {
                    if constexpr (BASE_BF16) { const u32x4 w = *(const u32x4*)(XB + off + bj * HALF);
                        bv[m][bj][0] = (f32x4){bf_lo(w.x), bf_hi(w.x), bf_lo(w.y), bf_hi(w.y)}; bv[m][bj][1] = (f32x4){bf_lo(w.z), bf_hi(w.z), bf_lo(w.w), bf_hi(w.w)};
                        if constexpr (SCALED) { bv[m][bj][0] *= rinv[m]; bv[m][bj][1] *= rinv[m]; } }
                    else { bv[m][bj][0] = *(const f32x4*)(base + off + bj * HALF); bv[m][bj][1] = *(const f32x4*)(base + off + bj * HALF + 4); } } }
#pragma unroll
            for (int m = 0; m < 4; ++m) {
                const int row = u.pm * BM + ai * HALF + wr * 64 + m * 16 + fr;
                const size_t off = (size_t)row * 1024 + u.pn * BM + wc * 32 + fq * 8;
                float s = 0.f;
#pragma unroll
                for (int bj = 0; bj < 2; ++bj) {
                    const f32x4 v0 = bv[m][bj][0] + acc[ai][bj][m][0] * scale, v1 = bv[m][bj][1] + acc[ai][bj][m][1] * scale;
                    if constexpr (WRITE_X) { *(f32x4*)(X + off + bj * HALF) = v0; *(f32x4*)(X + off + bj * HALF + 4) = v1; }
                    if constexpr (WRITE_XB) { u32x4 w; w.x = cvt_pk_bf16(v0[0], v0[1]); w.y = cvt_pk_bf16(v0[2], v0[3]); w.z = cvt_pk_bf16(v1[0], v1[1]); w.w = cvt_pk_bf16(v1[2], v1[3]);
                        *(u32x4*)(XB + off + bj * HALF) = w;
                        s += (v0[0] * v0[0] + v0[1] * v0[1]) + (v0[2] * v0[2] + v0[3] * v0[3]) + (v1[0] * v1[0] + v1[1] * v1[1]) + (v1[2] * v1[2] + v1[3] * v1[3]); }
                }
                if constexpr (WRITE_XB) { s += __shfl_xor(s, 16); s += __shfl_xor(s, 32); if (fq == 0) ssq[(size_t)row * 16 + u.pn * 4 + wc] = s; }
            }
        }
    }
};
struct EpiInProj {
    static constexpr bool PERM = true, AFTER_DRAIN = false, KSEG = false, PREF = true;
    bf16_t* U; bf16_t* Z; bf16_t* XBC; bf16_t* GL; float* DT; const float* dt_bias; const float* rstd;
    __device__ __forceinline__ void operator()(const f32x4 (&acc)[2][2][4][2], const Unit& u, int wr, int wc, int fr, int fq, const PG8_LAS float* epl) const {
        bf16_t* O; int ldc, colt;
        if (u.pn < 4) { O = U; ldc = 1024; colt = u.pn * 256; }
        else if (u.pn < 12) { O = Z; ldc = 2048; colt = (u.pn - 4) * 256; }
        else if (u.pn < 24) { O = XBC; ldc = 3072; colt = (u.pn - 12) * 256; }
        else { O = GL; ldc = 2048; colt = (u.pn - 24) * 256; }
        const bool isdt = (u.pn == 32);
        float rsv[2][4];
#pragma unroll
        for (int ai = 0; ai < 2; ++ai)
#pragma unroll
            for (int m = 0; m < 4; ++m) rsv[ai][m] = epl[ai * HALF + wr * 64 + m * 16 + fr];
#pragma unroll
        for (int ai = 0; ai < 2; ++ai)
#pragma unroll
            for (int m = 0; m < 4; ++m) {
                const int row = u.pm * BM + ai * HALF + wr * 64 + m * 16 + fr;
                const float rs = rsv[ai][m];
                if (!isdt) {
#pragma unroll
                    for (int bj = 0; bj < 2; ++bj) {
                        const f32x4 v0 = acc[ai][bj][m][0] * rs, v1 = acc[ai][bj][m][1] * rs;
                        u32x4 w; w.x = cvt_pk_bf16(v0[0], v0[1]); w.y = cvt_pk_bf16(v0[2], v0[3]); w.z = cvt_pk_bf16(v1[0], v1[1]); w.w = cvt_pk_bf16(v1[2], v1[3]);
                        *(u32x4*)(O + (size_t)row * ldc + colt + bj * HALF + wc * 32 + fq * 8) = w;
                    }
                } else if (wc == 0) {
                    const int c = fq * 8;
                    const f32x4 bb0 = *(const f32x4*)(dt_bias + c), bb1 = *(const f32x4*)(dt_bias + c + 4);
                    f32x4 v0 = acc[ai][0][m][0] * rs + bb0, v1 = acc[ai][0][m][1] * rs + bb1;
#pragma unroll
                    for (int i = 0; i < 4; ++i) { v0[i] = v0[i] > 20.f ? v0[i] : log1pf(__expf(v0[i])); v1[i] = v1[i] > 20.f ? v1[i] : log1pf(__expf(v1[i])); }
                    *(f32x4*)(DT + (size_t)row * 32 + c) = v0; *(f32x4*)(DT + (size_t)row * 32 + c + 4) = v1;
                }
            }
    }
};
struct EpiPlain {
    static constexpr bool PERM = true, AFTER_DRAIN = false, KSEG = false, PREF = false;
    bf16_t* O;
    __device__ __forceinline__ void operator()(const f32x4 (&acc)[2][2][4][2], const Unit& u, int wr, int wc, int fr, int fq) const {
#pragma unroll
        for (int ai = 0; ai < 2; ++ai)
#pragma unroll
            for (int m = 0; m < 4; ++m) {
                const int row = u.pm * BM + ai * HALF + wr * 64 + m * 16 + fr;
#pragma unroll
                for (int bj = 0; bj < 2; ++bj) {
                    const f32x4 v0 = acc[ai][bj][m][0], v1 = acc[ai][bj][m][1];
                    u32x4 w; w.x = cvt_pk_bf16(v0[0], v0[1]); w.y = cvt_pk_bf16(v0[2], v0[3]); w.z = cvt_pk_bf16(v1[0], v1[1]); w.w = cvt_pk_bf16(v1[2], v1[3]);
                    *(u32x4*)(O + (size_t)row * 1024 + u.pn * BM + bj * HALF + wc * 32 + fq * 8) = w;
                }
            }
    }
};
struct EpiMerge {
    static constexpr bool PERM = true, AFTER_DRAIN = false, KSEG = true, PREF = false;
    const bf16_t* GL; const bf16_t* BP; bf16_t* O; const float* RAT;
    __device__ __forceinline__ void kseg(f32x4 (&acc)[2][2][4][2], const Unit& u, int g, int wr, int fr) const {
        if (u.pm >= 64) return;
        const float* rp = RAT + (size_t)(u.pm * BM + wr * 64 + fr) * 4 + g;
#pragma unroll
        for (int ai = 0; ai < 2; ++ai) {
            float f[4];
#pragma unroll
            for (int m = 0; m < 4; ++m) f[m] = rp[(ai * HALF + m * 16) * 4];
#pragma unroll
            for (int m = 0; m < 4; ++m)
#pragma unroll
                for (int bj = 0; bj < 2; ++bj) { acc[ai][bj][m][0] *= f[m]; acc[ai][bj][m][1] *= f[m]; }
        }
    }
    __device__ __forceinline__ void operator()(const f32x4 (&acc)[2][2][4][2], const Unit& u, int wr, int wc, int fr, int fq) const {
#pragma unroll
        for (int ai = 0; ai < 2; ++ai)
#pragma unroll
            for (int mp = 0; mp < 2; ++mp) {
                u32x4 g0v[2][2], g1v[2][2], bpv[2][2];
                float r3v[2];
#pragma unroll
                for (int mm = 0; mm < 2; ++mm) r3v[mm] = (u.pm < 64) ? RAT[(size_t)(u.pm * BM + ai * HALF + wr * 64 + (2 * mp + mm) * 16 + fr) * 4 + 3] : 1.0f;
#pragma unroll
                for (int mm = 0; mm < 2; ++mm) { const int row = u.pm * BM + ai * HALF + wr * 64 + (2 * mp + mm) * 16 + fr;
#pragma unroll
                    for (int bj = 0; bj < 2; ++bj) { const int col = u.pn * BM + bj * HALF + wc * 32 + fq * 8;
                        g0v[mm][bj] = *(const u32x4*)(GL + (size_t)row * 2048 + col); g1v[mm][bj] = *(const u32x4*)(GL + (size_t)row * 2048 + 1024 + col); bpv[mm][bj] = *(const u32x4*)(BP + (size_t)row * 1024 + col); } }
#pragma unroll
                for (int mm = 0; mm < 2; ++mm) { const int m = 2 * mp + mm; const int row = u.pm * BM + ai * HALF + wr * 64 + m * 16 + fr;
#pragma unroll
                    for (int bj = 0; bj < 2; ++bj) {
                        const int col = u.pn * BM + bj * HALF + wc * 32 + fq * 8;
                        const u32x4 g0 = g0v[mm][bj], g1 = g1v[mm][bj], bp = bpv[mm][bj];
                        const f32x4 a0 = acc[ai][bj][m][0] * r3v[mm], a1 = acc[ai][bj][m][1] * r3v[mm];
                        u32x4 w;
                        w.x = cvt_pk_bf16(sigm_f(bf_lo(g0.x)) * bf_lo(bp.x) + sigm_f(bf_lo(g1.x)) * a0[0], sigm_f(bf_hi(g0.x)) * bf_hi(bp.x) + sigm_f(bf_hi(g1.x)) * a0[1]);
                        w.y = cvt_pk_bf16(sigm_f(bf_lo(g0.y)) * bf_lo(bp.y) + sigm_f(bf_lo(g1.y)) * a0[2], sigm_f(bf_hi(g0.y)) * bf_hi(bp.y) + sigm_f(bf_hi(g1.y)) * a0[3]);
                        w.z = cvt_pk_bf16(sigm_f(bf_lo(g0.z)) * bf_lo(bp.z) + sigm_f(bf_lo(g1.z)) * a1[0], sigm_f(bf_hi(g0.z)) * bf_hi(bp.z) + sigm_f(bf_hi(g1.z)) * a1[1]);
                        w.w = cvt_pk_bf16(sigm_f(bf_lo(g0.w)) * bf_lo(bp.w) + sigm_f(bf_lo(g1.w)) * a1[2], sigm_f(bf_hi(g0.w)) * bf_hi(bp.w) + sigm_f(bf_hi(g1.w)) * a1[3]);
                        *(u32x4*)(O + (size_t)row * 1024 + col) = w;
                    } }
            }
    }
};

template <class Epi, class Sched, bool ALIGN_EPI = false, bool SP2 = false>
__device__ __forceinline__ void gemm_phase(PG8_LAS unsigned char* lds, const Gemm g, const Sched& S, const Epi& E) {
    const int tid = threadIdx.x, wid = __builtin_amdgcn_readfirstlane(tid >> 6), lane = tid & 63, wr = wid >> 2, wc = wid & 3, fr = lane & 15, fq = lane >> 4;
    const int K = g.K; (void)K;
    unsigned voffA[2], voffB[2];
#pragma unroll
    for (int i = 0; i < 2; ++i) { int R, C; stage_rc(tid * 16 + i * 8192, R, C); const int Rb = Epi::PERM ? ((R & ~31) + perm32(R & 31)) : R;
        voffA[i] = (unsigned)(R * g.lda + C) * 2u; voffB[i] = (unsigned)(Rb * g.ldb + C) * 2u; }
    const size_t kstep = (size_t)(BK * 2);
    const size_t hstepA = (size_t)HALF * g.lda * 2, hstepB = (size_t)HALF * g.ldb * 2;
    const size_t tstepA = 2 * hstepA, tstepB = 2 * hstepB; const size_t pnoffA = (size_t)g.a_pn_off * 2;
    const unsigned ldsw = (unsigned)wid * 1024u;
    const int aoff = lds_byte(wr * 64 + fr, fq * 8), boff = lds_byte(wc * 32 + fr, fq * 8);
#define PG8_SA(b, h) (((b) * 2 + (h)) * HTB)
#define PG8_SB(b, h) ((4 + (b) * 2 + (h)) * HTB)
#define PG8_STAGE(bufoff, gbase, voff) do { _Pragma("unroll") for (int _i = 0; _i < 2; ++_i) \
        __builtin_amdgcn_global_load_lds((const unsigned*)((const char*)(gbase) + (voff)[_i]), (PG8_LAS unsigned*)(lds + (bufoff) + ldsw + _i * 8192), 16, 0, 0); } while (0)
#define PG8_LDA(dst, b, h) do { _Pragma("unroll") for (int m = 0; m < 4; ++m) _Pragma("unroll") for (int k = 0; k < 2; ++k) dst[m][k] = *(const PG8_LAS bf16x8*)(lds + PG8_SA(b, h) + aoff + m * 2048 + k * 1024); } while (0)
#define PG8_LDB(dst, b, h) do { _Pragma("unroll") for (int n = 0; n < 2; ++n) _Pragma("unroll") for (int k = 0; k < 2; ++k) dst[n][k] = *(const PG8_LAS bf16x8*)(lds + PG8_SB(b, h) + boff + n * 2048 + k * 1024); } while (0)
#define PG8_MMA(ai, bj, At, Bt) do { __builtin_amdgcn_s_setprio(1); _Pragma("unroll") for (int m = 0; m < 4; ++m) _Pragma("unroll") for (int n = 0; n < 2; ++n) _Pragma("unroll") for (int k = 0; k < 2; ++k) \
        acc[ai][bj][m][n] = __builtin_amdgcn_mfma_f32_16x16x32_bf16(Bt[n][k], At[m][k], acc[ai][bj][m][n], 0, 0, 0); __builtin_amdgcn_s_setprio(0); } while (0)
#define PG8_WAIT_V(n) asm volatile("s_waitcnt vmcnt(" #n ")" ::: "memory")
#define PG8_WAIT_L(n) asm volatile("s_waitcnt lgkmcnt(" #n ")" ::: "memory")
#define PG8_BAR __builtin_amdgcn_s_barrier()
#define PG8_SCHED __builtin_amdgcn_sched_barrier(0)
    Unit cur, nxt; int ui = 0;
    if (!S.next(0, cur)) return;
    f32x4 acc[2][2][4][2];
#pragma unroll
    for (int a = 0; a < 2; ++a)
#pragma unroll
        for (int b = 0; b < 2; ++b)
#pragma unroll
            for (int m = 0; m < 4; ++m)
#pragma unroll
                for (int n = 0; n < 2; ++n) acc[a][b][m][n] = (f32x4){0.f, 0.f, 0.f, 0.f};
    bf16x8 At[4][2], B0[2][2], B1[2][2];
    const char* cA = (const char*)g.A + (size_t)cur.pm * tstepA + (size_t)cur.pn * pnoffA + cur.kofs; const char* cB = (const char*)g.Bt + (size_t)cur.pn * tstepB + cur.kofs;
    S.a_ready(cur);
    if constexpr (SP2) {
        PG8_STAGE(PG8_SB(0, 0), cB, voffB); PG8_STAGE(PG8_SB(0, 1), cB + hstepB, voffB); PG8_STAGE(PG8_SA(0, 0), cA, voffA); PG8_STAGE(PG8_SA(0, 1), cA + hstepA, voffA);
        if (wr == 1) PG8_BAR;
        PG8_WAIT_V(2); PG8_BAR;
        PG8_STAGE(PG8_SB(1, 0), cB + kstep, voffB); PG8_STAGE(PG8_SA(1, 0), cA + kstep, voffA); PG8_STAGE(PG8_SB(1, 1), cB + hstepB + kstep, voffB);
        PG8_WAIT_V(6); PG8_BAR;
    } else {
        PG8_STAGE(PG8_SB(0, 0), cB, voffB); PG8_STAGE(PG8_SA(0, 0), cA, voffA); PG8_STAGE(PG8_SB(0, 1), cB + hstepB, voffB); PG8_STAGE(PG8_SA(0, 1), cA + hstepA, voffA);
        if (wr == 1) PG8_BAR;
        PG8_WAIT_V(4); PG8_BAR;
        PG8_STAGE(PG8_SB(1, 0), cB + kstep, voffB); PG8_STAGE(PG8_SA(1, 0), cA + kstep, voffA); PG8_STAGE(PG8_SB(1, 1), cB + hstepB + kstep, voffB);
        PG8_WAIT_V(6); PG8_BAR;
    }
    for (;;) {
        const bool has_next = S.next(ui + 1, nxt);
        const char* nA = has_next ? (const char*)g.A + (size_t)nxt.pm * tstepA + (size_t)nxt.pn * pnoffA + nxt.kofs : cA; const char* nB = has_next ? (const char*)g.Bt + (size_t)nxt.pn * tstepB + nxt.kofs : cB;
        const int nt = cur.nt;
        PG8_LAS float* epl = (PG8_LAS float*)(lds + 131072 + 2048) + (ui & 1) * 256;
        float epv = 1.0f;
        if constexpr (Epi::PREF) { if (cur.part < 0 && wid < 4 && E.rstd) epv = E.rstd[cur.pm * BM + tid]; }
        for (int t = 0; t < nt; t += 2) {
            const bool last = (t == nt - 2);
            const char* a1 = cA + (size_t)(t + 1) * kstep;
            const char* a2 = last ? nA : cA + (size_t)(t + 2) * kstep; const char* b2 = last ? nB : cB + (size_t)(t + 2) * kstep;
            const char* a3 = a2 + kstep; const char* b3 = b2 + kstep;
            if (last && has_next) S.a_ready(nxt);
            if constexpr (Epi::PREF) { if (last && cur.part < 0 && wid < 4) epl[tid] = epv; }
            if constexpr (SP2) {
            PG8_LDB(B0, 0, 0); PG8_LDB(B1, 0, 1); PG8_SCHED; PG8_LDA(At, 0, 0); PG8_STAGE(PG8_SA(1, 1), a1 + hstepA, voffA);
            PG8_WAIT_V(8); PG8_WAIT_L(0); PG8_BAR; PG8_MMA(0, 0, At, B0); PG8_MMA(0, 1, At, B1); PG8_BAR; PG8_SCHED;
            PG8_LDA(At, 0, 1); PG8_STAGE(PG8_SB(0, 0), b2, voffB); PG8_STAGE(PG8_SB(0, 1), b2 + hstepB, voffB); PG8_STAGE(PG8_SA(0, 0), a2, voffA);
            PG8_WAIT_V(8); PG8_WAIT_L(0); PG8_BAR; PG8_MMA(1, 0, At, B0); PG8_MMA(1, 1, At, B1); PG8_BAR; PG8_SCHED;
            PG8_LDB(B0, 1, 0); PG8_LDB(B1, 1, 1); PG8_SCHED; PG8_LDA(At, 1, 0); PG8_STAGE(PG8_SA(0, 1), a2 + hstepA, voffA);
            PG8_WAIT_V(8); PG8_WAIT_L(0); PG8_BAR; PG8_MMA(0, 0, At, B0); PG8_MMA(0, 1, At, B1); PG8_BAR; PG8_SCHED;
            PG8_LDA(At, 1, 1); PG8_STAGE(PG8_SB(1, 0), b3, voffB); PG8_STAGE(PG8_SB(1, 1), b3 + hstepB, voffB); PG8_STAGE(PG8_SA(1, 0), a3, voffA);
            PG8_WAIT_V(8); PG8_WAIT_L(0); PG8_BAR; PG8_MMA(1, 0, At, B0); PG8_MMA(1, 1, At, B1); PG8_BAR; PG8_SCHED;
            } else {
            PG8_LDB(B0, 0, 0); PG8_SCHED; PG8_LDA(At, 0, 0); PG8_STAGE(PG8_SA(1, 1), a1 + hstepA, voffA);
            PG8_WAIT_L(8); PG8_BAR; PG8_WAIT_L(0); PG8_MMA(0, 0, At, B0); PG8_BAR; PG8_SCHED;
            PG8_LDB(B1, 0, 1); PG8_STAGE(PG8_SB(0, 0), b2, voffB);
            PG8_BAR; PG8_WAIT_L(0); PG8_MMA(0, 1, At, B1); PG8_BAR;
            PG8_LDA(At, 0, 1); PG8_STAGE(PG8_SA(0, 0), a2, voffA);
            PG8_BAR; PG8_WAIT_L(0); PG8_MMA(1, 0, At, B0); PG8_BAR; PG8_SCHED;
            PG8_STAGE(PG8_SB(0, 1), b2 + hstepB, voffB);
            PG8_WAIT_V(6); PG8_BAR; PG8_MMA(1, 1, At, B1); PG8_BAR;
            PG8_LDB(B0, 1, 0); PG8_SCHED; PG8_LDA(At, 1, 0); PG8_STAGE(PG8_SA(0, 1), a2 + hstepA, voffA);
            PG8_WAIT_L(8); PG8_BAR; PG8_WAIT_L(0); PG8_MMA(0, 0, At, B0); PG8_BAR; PG8_SCHED;
            PG8_LDB(B1, 1, 1); PG8_STAGE(PG8_SB(1, 0), b3, voffB);
            PG8_BAR; PG8_WAIT_L(0); PG8_MMA(0, 1, At, B1); PG8_BAR;
            PG8_LDA(At, 1, 1); PG8_STAGE(PG8_SA(1, 0), a3, voffA);
            PG8_BAR; PG8_WAIT_L(0); PG8_MMA(1, 0, At, B0); PG8_BAR; PG8_SCHED;
            PG8_STAGE(PG8_SB(1, 1), b3 + hstepB, voffB);
            PG8_WAIT_V(6); PG8_BAR; PG8_MMA(1, 1, At, B1); PG8_BAR;
            }
            if constexpr (Epi::KSEG) { if (cur.part < 0 && ((t + 2) & 7) == 0 && (t + 2) < nt) E.kseg(acc, cur, ((t + 2) >> 3) - 1, wr, fr); }
        }
        if constexpr (ALIGN_EPI) { if (wr == 0) PG8_BAR; }
        if constexpr (!Epi::AFTER_DRAIN) {
            if (cur.part >= 0) {
                static_assert(Epi::PERM, "partial store assumes the PERM column layout");
#pragma unroll
                for (int ai = 0; ai < 2; ++ai)
#pragma unroll
                    for (int m = 0; m < 4; ++m) { float* pp = g.part + ((size_t)cur.part * 1024 + (cur.pm - 64) * BM + ai * HALF + wr * 64 + m * 16 + fr) * 1024 + cur.pn * BM + wc * 32 + fq * 8;
#pragma unroll
                        for (int bj = 0; bj < 2; ++bj) { *(f32x4*)(pp + bj * HALF) = acc[ai][bj][m][0]; *(f32x4*)(pp + bj * HALF + 4) = acc[ai][bj][m][1]; } }
            } else { if constexpr (Epi::PREF) E(acc, cur, wr, wc, fr, fq, epl); else E(acc, cur, wr, wc, fr, fq); }
            S.done(cur); }
        if (!has_next) break;
#pragma unroll
        for (int a = 0; a < 2; ++a)
#pragma unroll
            for (int b = 0; b < 2; ++b)
#pragma unroll
                for (int m = 0; m < 4; ++m)
#pragma unroll
                    for (int n = 0; n < 2; ++n) acc[a][b][m][n] = (f32x4){0.f, 0.f, 0.f, 0.f};
        cur = nxt; cA = nA; cB = nB; ++ui;
        if constexpr (ALIGN_EPI) { if (wr == 1) PG8_BAR; }
    }
    PG8_WAIT_V(0);
    if constexpr (!ALIGN_EPI) { if (wr == 0) PG8_BAR; }
    PG8_BAR;
    if constexpr (Epi::AFTER_DRAIN) { E.fused(acc, cur, wr, wc, fr, fq, lds, wid, lane); S.done(cur); }
#undef PG8_SA
#undef PG8_SB
#undef PG8_STAGE
#undef PG8_LDA
#undef PG8_LDB
#undef PG8_MMA
#undef PG8_WAIT_V
#undef PG8_WAIT_L
#undef PG8_BAR
#undef PG8_SCHED
}
}

#include <hip/hip_cooperative_groups.h>
namespace cg = cooperative_groups;
#ifndef ONE_LAUNCH
#define ONE_LAUNCH 1
#endif
#define LAS __attribute__((address_space(3)))
typedef unsigned short bf16;
typedef unsigned u32x4 __attribute__((ext_vector_type(4)));
typedef unsigned u32x2 __attribute__((ext_vector_type(2)));
typedef float f32x4 __attribute__((ext_vector_type(4)));
typedef short bf16x8 __attribute__((ext_vector_type(8)));
constexpr int NWAVES = 8, NTHR = 512;
constexpr int MP = 16384, MS = 1024, M = MP + MS;
constexpr int D = 1024, FF = 2816, NPROJ = 8224, NPROJ_PAD = 8448;
constexpr float EPS = 1e-6f;
constexpr int N_PHASES = 11;
constexpr size_t O_Y = 0, O_PP = 17825792, O_CP = 17948672, O_SP = 18022400, O_PS = 20119552, O_CS = 22085632, O_SS = 23265280, O_END = 56819712;
constexpr size_t MiB = 1u << 20;
constexpr size_t WS_W1A = 0, WS_W1B = 11 * MiB, WS_WIN = WS_W1B + 5632 * 1024, WS_WPG = WS_WIN + (size_t)NPROJ_PAD * 1024 * 2, WS_WPO = WS_WPG + 512 * 1024, WS_WSO = WS_WPO + 2 * MiB,
                 WS_WO = WS_WSO + 4 * MiB, WS_W2A = WS_WO + 2 * MiB, WS_W2B = WS_W2A + 11 * MiB, WS_WEND = WS_W2B + 5632 * 1024;
constexpr size_t SZ1K = (size_t)M * 1024 * 2, SZ2K = 2 * SZ1K, SZ3K = 3 * SZ1K;
constexpr size_t WS_SMALL = 58 * MiB;
constexpr size_t WS_SSQ = WS_SMALL, WS_DT = WS_SSQ + (size_t)M * 16 * 4, WS_RSTD = WS_DT + (size_t)M * 32 * 4, WS_RAT = WS_RSTD + (size_t)M * 4, WS_SMALL_END = WS_RAT + (size_t)MP * 16;
constexpr size_t WS_XB = 62 * MiB;
constexpr size_t WS_RA = WS_XB + SZ1K;
constexpr size_t WS_RB = WS_RA + SZ3K;
constexpr size_t WS_RC = WS_RB + SZ3K;
constexpr size_t WS_RD = WS_RC + SZ1K;
constexpr size_t WS_RE = WS_RD + SZ2K;
constexpr size_t WS_RF = WS_RE + SZ2K;
constexpr size_t WS_CTL = WS_RF + SZ1K, CTL_BYTES = 16384;
constexpr size_t WS_WEFF = WS_CTL + CTL_BYTES;
constexpr size_t WS_END = WS_WEFF + 2 * MiB;
static_assert(WS_WEND <= WS_SMALL && WS_SMALL_END <= WS_XB && WS_END <= 512 * MiB, "d_ws map");
constexpr int LDS_BYTES = 145408;
constexpr int LDS_MISC_OFF = 144384;

__device__ __forceinline__ unsigned f2bf(float f) { unsigned u = __float_as_uint(f); return (u + 0x7fffu + ((u >> 16) & 1u)) >> 16; }
typedef float f32x2_t __attribute__((ext_vector_type(2))); typedef __bf16 bf16x2_t __attribute__((ext_vector_type(2)));
__device__ __forceinline__ unsigned pk2(float lo, float hi) { f32x2_t v = {lo, hi}; bf16x2_t b = __builtin_convertvector(v, bf16x2_t); return __builtin_bit_cast(unsigned, b); }
__device__ __forceinline__ float bflo(unsigned w) { return __uint_as_float(w << 16); }
__device__ __forceinline__ float bfhi(unsigned w) { return __uint_as_float(w & 0xffff0000u); }
__device__ __forceinline__ float bf2f(bf16 v) { return __uint_as_float((unsigned)v << 16); }
__device__ __forceinline__ float wave_sum(float v) {
#pragma unroll
    for (int o = 1; o < 64; o <<= 1) v += __shfl_xor(v, o);
    return v;
}
#define LDS_WAIT() asm volatile("s_waitcnt lgkmcnt(0)" ::: "memory")
#define LDS_BARRIER() do { asm volatile("s_waitcnt lgkmcnt(0)" ::: "memory"); __builtin_amdgcn_s_barrier(); asm volatile("" ::: "memory"); } while (0)
struct F8 { float v[8]; };
__device__ __forceinline__ F8 unpack8(u32x4 w) { F8 r; r.v[0] = bflo(w.x); r.v[1] = bfhi(w.x); r.v[2] = bflo(w.y); r.v[3] = bfhi(w.y); r.v[4] = bflo(w.z); r.v[5] = bfhi(w.z); r.v[6] = bflo(w.w); r.v[7] = bfhi(w.w); return r; }
__device__ __forceinline__ u32x4 pack8(const F8& a) { u32x4 w; w.x = pk2(a.v[0], a.v[1]); w.y = pk2(a.v[2], a.v[3]); w.z = pk2(a.v[4], a.v[5]); w.w = pk2(a.v[6], a.v[7]); return w; }
__device__ __forceinline__ F8 loadf8(const float* p) { const f32x4 a = *(const f32x4*)p, b = *(const f32x4*)(p + 4); F8 r; r.v[0] = a[0]; r.v[1] = a[1]; r.v[2] = a[2]; r.v[3] = a[3]; r.v[4] = b[0]; r.v[5] = b[1]; r.v[6] = b[2]; r.v[7] = b[3]; return r; }
__device__ __forceinline__ void storef8(float* p, const F8& a) { *(f32x4*)p = (f32x4){a.v[0], a.v[1], a.v[2], a.v[3]}; *(f32x4*)(p + 4) = (f32x4){a.v[4], a.v[5], a.v[6], a.v[7]}; }
__device__ __forceinline__ F8 zero8() { F8 r;
#pragma unroll
    for (int i = 0; i < 8; ++i) r.v[i] = 0.f;
    return r; }

struct Args { const float* in[25]; float* out; unsigned char* ws; int ph_lo, ph_hi; };
enum { I_XP = 0, I_XS, I_SPOOL, I_SCONV, I_SSSM, I_NF1, I_F1IN, I_F1OUT, I_NMIX, I_WIN, I_PWG, I_PSC, I_PWO, I_CW, I_CB, I_DTB, I_ALOG, I_DSKIP, I_SNORM, I_SWO, I_WO, I_NF2, I_F2IN, I_F2OUT, I_NFIN };

__device__ __forceinline__ void p0_item(const float* W, int K, int N, bf16* WT, int row_off, int mode, const float* gain, LAS float* scr, int item, int lane) {
    const int nblk = N / 32, kb = item / nblk, nb = item % nblk, k0 = 64 * kb, n0 = 32 * nb;
    const float gv = gain ? gain[k0 + lane] : 1.0f;
    float wv[32];
#pragma unroll
    for (int i = 0; i < 32; ++i) { const int kk = 2 * i + (lane >> 5); wv[i] = __builtin_nontemporal_load(W + (size_t)(k0 + kk) * N + n0 + (lane & 31)); }
#pragma unroll
    for (int i = 0; i < 32; ++i) { const int kk = 2 * i + (lane >> 5); scr[kk * 33 + (lane & 31)] = wv[i] * __shfl(gv, kk); }
    LDS_WAIT(); asm volatile("" ::: "memory");
    int dr = n0;
    if (mode == 1) { if (n0 < FF) dr = (n0 >> 7) * 256 + (n0 & 127); else { const int j = n0 - FF; dr = (j >> 7) * 256 + 128 + (j & 127); } }
    else if (mode == 2) { if (n0 >= 6176) dr = n0 - 32; else if (n0 >= 6144) dr = 8192 + (n0 - 6144); }
    const int c = lane & 7;
#pragma unroll
    for (int j = 0; j < 4; ++j) { const int n = (lane >> 3) + 8 * j; const LAS float* s = scr + (8 * c) * 33 + n;
        u32x4 o; o.x = pk2(s[0 * 33], s[1 * 33]); o.y = pk2(s[2 * 33], s[3 * 33]); o.z = pk2(s[4 * 33], s[5 * 33]); o.w = pk2(s[6 * 33], s[7 * 33]);
        *(u32x4*)(WT + (size_t)(row_off + dr + n) * K + k0 + 8 * c) = o; }
    LDS_WAIT(); asm volatile("" ::: "memory");
}
__device__ __forceinline__ void phase0(const Args& a, LAS unsigned char* lds, int G, int tid) {
    const int lane = tid & 63, wave = __builtin_amdgcn_readfirstlane(tid >> 6);
    LAS float* scr = (LAS float*)(lds + wave * 16384);
    const int gw = blockIdx.x * NWAVES + wave, NGW = G * NWAVES;
    unsigned char* ws = a.ws;
    constexpr int I1A = 16 * 176, I1B = 44 * 32, IIN = 16 * 257, IPG = 4 * 32, IPO = 16 * 32, ISO = 32 * 32, IWO = 16 * 32;
    constexpr int NITEMS = 2 * I1A + 2 * I1B + IIN + IPO + ISO + IWO; (void)IPG;
    for (int it = gw; it < NITEMS; it += NGW) {
        int r = it;
        if (r < I1A) { p0_item(a.in[I_F1IN], D, 2 * FF, (bf16*)(ws + WS_W1A), 0, 1, a.in[I_NF1], scr, r, lane); continue; } r -= I1A;
        if (r < I1A) { p0_item(a.in[I_F2IN], D, 2 * FF, (bf16*)(ws + WS_W2A), 0, 1, a.in[I_NF2], scr, r, lane); continue; } r -= I1A;
        if (r < IIN) { p0_item(a.in[I_WIN], D, NPROJ, (bf16*)(ws + WS_WIN), 0, 2, a.in[I_NMIX], scr, r, lane); continue; } r -= IIN;
        if (r < I1B) { p0_item(a.in[I_F1OUT], FF, D, (bf16*)(ws + WS_W1B), 0, 0, nullptr, scr, r, lane); continue; } r -= I1B;
        if (r < I1B) { p0_item(a.in[I_F2OUT], FF, D, (bf16*)(ws + WS_W2B), 0, 0, nullptr, scr, r, lane); continue; } r -= I1B;
        if (r < IPO) { p0_item(a.in[I_PWO], D, D, (bf16*)(ws + WS_WPO), 0, 0, a.in[I_PSC], scr, r, lane); continue; } r -= IPO;
        if (r < ISO) { p0_item(a.in[I_SWO], 2048, D, (bf16*)(ws + WS_WSO), 0, 0, a.in[I_SNORM], scr, r, lane); continue; } r -= ISO;
        p0_item(a.in[I_WO], D, D, (bf16*)(ws + WS_WO), 0, 0, nullptr, scr, r, lane);
    }
    { const float* wg = a.in[I_PWG]; u32x4* o = (u32x4*)(ws + WS_WPG);
      for (int i = blockIdx.x * NTHR + tid; i < 262144 / 8; i += G * NTHR) o[i] = pack8(loadf8(wg + (size_t)i * 8)); }
    { u32x4* z = (u32x4*)(ws + WS_WIN + (size_t)NPROJ * 1024 * 2); const int n16 = (NPROJ_PAD - NPROJ) * 1024 * 2 / 16;
      for (int i = blockIdx.x * NTHR + tid; i < n16; i += G * NTHR) z[i] = (u32x4){0u, 0u, 0u, 0u}; }
    bf16* XN = (bf16*)(ws + WS_XB);
    for (int m0 = gw * 2; m0 < M; m0 += NGW * 2) {
        const float* xrow = (m0 < MP) ? a.in[I_XP] + (size_t)m0 * D : a.in[I_XS] + (size_t)(m0 - MP) * D;
        const f32x4* xr = (const f32x4*)xrow + lane;
        f32x4 v[2][4]; float s[2] = {0.f, 0.f};
#pragma unroll
        for (int q = 0; q < 2; ++q)
#pragma unroll
            for (int j = 0; j < 4; ++j) v[q][j] = __builtin_nontemporal_load(xr + 256 * q + 64 * j);
#pragma unroll
        for (int q = 0; q < 2; ++q)
#pragma unroll
            for (int j = 0; j < 4; ++j) s[q] += (v[q][j][0] * v[q][j][0] + v[q][j][1] * v[q][j][1]) + (v[q][j][2] * v[q][j][2] + v[q][j][3] * v[q][j][3]);
#pragma unroll
        for (int q = 0; q < 2; ++q) { const float ms = wave_sum(s[q]) * (1.f / D) + EPS, rstd = __builtin_amdgcn_rsqf(ms);
            if (lane == 0) ((float*)(ws + WS_RSTD))[m0 + q] = ms * rstd;
            u32x2* o8 = (u32x2*)(XN + (size_t)(m0 + q) * D) + lane;
#pragma unroll
            for (int j = 0; j < 4; ++j) { u32x2 w; w.x = pk2(v[q][j][0] * rstd, v[q][j][1] * rstd); w.y = pk2(v[q][j][2] * rstd, v[q][j][3] * rstd); o8[64 * j] = w; } }
    }
}

__device__ __forceinline__ void phase4(const Args& a, int G, int tid) {
    unsigned char* ws = a.ws;
    const bf16* U = (const bf16*)(ws + WS_RC); const bf16* XBC = (const bf16*)(ws + WS_RA);
    bf16* Dp = (bf16*)(ws + WS_RF); bf16* XC = (bf16*)(ws + WS_RB);
    const float* spool = a.in[I_SPOOL]; const float* sconv = a.in[I_SCONV];
    const int gt = blockIdx.x * NTHR + tid, NT = G * NTHR;
    for (int u = gt; u < 65536 + 16384; u += NT) {
        const bool smp = u >= 65536; int b, t0, nrows, slab;
        if (!smp) { slab = u & 127; t0 = ((u >> 7) & 63) * 32; b = u >> 13; nrows = 32; }
        else { const int v = u - 65536; slab = v & 127; b = v >> 7; t0 = 0; nrows = 8; }
        const int c0 = slab * 8, w = 2 << (c0 >> 8);
        const size_t rowbase = smp ? (size_t)MP + b * 8 : (size_t)b * 2048;
        const bf16* Ub = U + rowbase * 1024 + c0; const float* hb = spool + ((size_t)b * 15 + 15) * 1024 + c0;
        F8 s = zero8();
        for (int j = 1; j < w; ++j) {
            const int i = t0 - j;
            if (i >= 0) { const F8 x = unpack8(*(const u32x4*)(Ub + (ptrdiff_t)i * 1024));
#pragma unroll
                for (int e = 0; e < 8; ++e) s.v[e] += x.v[e]; }
            else if (smp) { const F8 x = loadf8(hb + (ptrdiff_t)i * 1024);
#pragma unroll
                for (int e = 0; e < 8; ++e) s.v[e] += x.v[e]; }
        }
        for (int tb = t0; tb < t0 + nrows; tb += 8) {
            u32x4 curw[8]; F8 oldv[8];
#pragma unroll
            for (int k = 0; k < 8; ++k) curw[k] = *(const u32x4*)(Ub + (size_t)(tb + k) * 1024);
#pragma unroll
            for (int k = 0; k < 8; ++k) { const int i = tb + k - w + 1;
                if (i >= 0) oldv[k] = unpack8(*(const u32x4*)(Ub + (ptrdiff_t)i * 1024));
                else if (smp) oldv[k] = loadf8(hb + (ptrdiff_t)i * 1024);
                else oldv[k] = zero8(); }
#pragma unroll
            for (int k = 0; k < 8; ++k) {
                const int t = tb + k; const F8 cur = unpack8(curw[k]);
                const float icnt = 1.0f / (smp ? (float)w : (float)((t + 1 < w) ? t + 1 : w));
                F8 d;
#pragma unroll
                for (int e = 0; e < 8; ++e) { s.v[e] += cur.v[e]; d.v[e] = s.v[e] * icnt - cur.v[e]; s.v[e] -= oldv[k].v[e]; }
                *(u32x4*)(Dp + (rowbase + t) * 1024 + c0) = pack8(d);
            }
        }
    }
    const float* cw = a.in[I_CW]; const float* cb = a.in[I_CB];
    for (int u = gt; u < 196608 + 49152; u += NT) {
        const bool smp = u >= 196608; int b, t0, nrows, slab;
        if (!smp) { slab = u % 384; const int q = u / 384; t0 = (q & 63) * 32; b = q >> 6; nrows = 32; }
        else { const int v = u - 196608; slab = v % 384; b = v / 384; t0 = 0; nrows = 8; }
        const int c0 = slab * 8;
        const size_t rowbase = smp ? (size_t)MP + b * 8 : (size_t)b * 2048;
        const F8 w0 = loadf8(cw + c0), w1 = loadf8(cw + 3072 + c0), w2 = loadf8(cw + 6144 + c0), w3 = loadf8(cw + 9216 + c0), bi = loadf8(cb + c0);
        F8 xm3, xm2, xm1;
        if (smp) { xm3 = loadf8(sconv + ((size_t)b * 3 + 0) * 3072 + c0); xm2 = loadf8(sconv + ((size_t)b * 3 + 1) * 3072 + c0); xm1 = loadf8(sconv + ((size_t)b * 3 + 2) * 3072 + c0); }
        else if (t0 == 0) { xm3 = zero8(); xm2 = zero8(); xm1 = zero8(); }
        else { xm3 = unpack8(*(const u32x4*)(XBC + (rowbase + t0 - 3) * 3072 + c0)); xm2 = unpack8(*(const u32x4*)(XBC + (rowbase + t0 - 2) * 3072 + c0)); xm1 = unpack8(*(const u32x4*)(XBC + (rowbase + t0 - 1) * 3072 + c0)); }
        for (int tb = t0; tb < t0 + nrows; tb += 8) {
            u32x4 curw[8];
#pragma unroll
            for (int k = 0; k < 8; ++k) curw[k] = *(const u32x4*)(XBC + (rowbase + tb + k) * 3072 + c0);
#pragma unroll
            for (int k = 0; k < 8; ++k) {
                const F8 cur = unpack8(curw[k]);
                F8 y;
#pragma unroll
                for (int e = 0; e < 8; ++e) { const float v = bi.v[e] + xm3.v[e] * w0.v[e] + xm2.v[e] * w1.v[e] + xm1.v[e] * w2.v[e] + cur.v[e] * w3.v[e]; y.v[e] = v * __builtin_amdgcn_rcpf(1.0f + __expf(-v)); }
                *(u32x4*)(XC + (rowbase + tb + k) * 3072 + c0) = pack8(y);
                xm3 = xm2; xm2 = xm1; xm1 = cur;
            }
        }
    }
    for (int u = gt; u < (8 + 128) * 15 * 128; u += NT) {
        const int slab = u & 127, rj = u >> 7, c0 = slab * 8;
        if (rj < 120) { const int b = rj / 15, j = rj % 15;
            storef8(a.out + O_PP + ((size_t)b * 15 + j) * 1024 + c0, unpack8(*(const u32x4*)(U + ((size_t)b * 2048 + 2033 + j) * 1024 + c0))); }
        else { const int r2 = rj - 120, b = r2 / 15, j = r2 % 15;
            const F8 v = (j < 7) ? loadf8(spool + ((size_t)b * 15 + 8 + j) * 1024 + c0) : unpack8(*(const u32x4*)(U + ((size_t)MP + b * 8 + (j - 7)) * 1024 + c0));
            storef8(a.out + O_PS + ((size_t)b * 15 + j) * 1024 + c0, v); }
    }
    for (int u = gt; u < (8 + 128) * 3 * 384; u += NT) {
        const int slab = u % 384, rj = u / 384, c0 = slab * 8;
        if (rj < 24) { const int b = rj / 3, j = rj % 3;
            storef8(a.out + O_CP + ((size_t)b * 3 + j) * 3072 + c0, unpack8(*(const u32x4*)(XBC + ((size_t)b * 2048 + 2045 + j) * 3072 + c0))); }
        else { const int r2 = rj - 24, b = r2 / 3, j = r2 % 3;
            storef8(a.out + O_CS + ((size_t)b * 3 + j) * 3072 + c0, unpack8(*(const u32x4*)(XBC + ((size_t)MP + b * 8 + 5 + j) * 3072 + c0))); }
    }
}

#define MFMA16(p, q, c) __builtin_amdgcn_mfma_f32_16x16x32_bf16((p), (q), (c), 0, 0, 0)
constexpr int LDW = 136;
constexpr int LDX = 72;
typedef short v4i16_t __attribute__((ext_vector_type(4)));
__device__ __forceinline__ unsigned cvtpk(float lo, float hi) { f32x2_t v = {lo, hi}; bf16x2_t b = __builtin_convertvector(v, bf16x2_t); return __builtin_bit_cast(unsigned, b); }
__device__ __forceinline__ bf16x8 tr_frag(const LAS bf16* T, int pitch, int k0, int i0, int lane) {
    const int j = lane & 15, q = j >> 2, p = j & 3;
    const LAS bf16* ap = T + (k0 + q) * pitch + i0 + 4 * p;
    const v4i16_t lo = __builtin_amdgcn_ds_read_tr16_b64_v4i16((LAS v4i16_t*)ap), hi = __builtin_amdgcn_ds_read_tr16_b64_v4i16((LAS v4i16_t*)(ap + 4 * pitch));
    return (bf16x8){lo[0], lo[1], lo[2], lo[3], hi[0], hi[1], hi[2], hi[3]};
}
__device__ __forceinline__ void ssd_prompt_unit(LAS unsigned char* lds, int b, int h, const bf16* __restrict__ XC, const float* __restrict__ DT, const bf16* __restrict__ Z, bf16* __restrict__ YG, const float* a_log, const float* d_skip, float* __restrict__ out_ssm, float* __restrict__ SSQ2, int tid) {
    const int wave = __builtin_amdgcn_readfirstlane(tid >> 6), lane = tid & 63, l16 = lane & 15, quad = lane >> 4, g = h >> 3;
    LAS bf16* Cs = (LAS bf16*)lds;
    LAS bf16* Bs = Cs + 128 * LDW;
    LAS bf16* Xd = Bs + 128 * LDW;
    LAS bf16* Xw = Xd + 128 * LDX;
    LAS bf16* Hb = Xw + 128 * LDX;
    LAS float* acsb = (LAS float*)(Hb + 64 * LDW);
    LAS float* dtsb = acsb + 256;
    LAS bf16* HbB = (LAS bf16*)(dtsb + 256);
    const float A = -__expf(a_log[h]), Dh = d_skip[h];
    f32x4 hacc[4];
#pragma unroll
    for (int pt = 0; pt < 4; ++pt) hacc[pt] = (f32x4){0.f, 0.f, 0.f, 0.f};
    for (int i = tid; i < 64 * LDW / 2; i += NTHR) ((LAS unsigned*)Hb)[i] = 0u;
    const int lrow = 16 * wave + l16;
    u32x4 cgv[4], bgv[4], xgv[2]; float d0, d1;
    { const size_t row0 = (size_t)b * 2048;
#pragma unroll
      for (int i = 0; i < 4; ++i) { const int idx = tid + NTHR * i, l = idx >> 4, seg = idx & 15; const bf16* rp = XC + (row0 + l) * 3072 + g * 128 + seg * 8; cgv[i] = *(const u32x4*)(rp + 2560); bgv[i] = *(const u32x4*)(rp + 2048); }
#pragma unroll
      for (int i = 0; i < 2; ++i) { const int idx = tid + NTHR * i, l = idx >> 3, seg = idx & 7; xgv[i] = *(const u32x4*)(XC + (row0 + l) * 3072 + h * 64 + seg * 8); }
      d0 = DT[(row0 + lane) * 32 + h]; d1 = DT[(row0 + 64 + lane) * 32 + h]; }
#define WALK_SCAN(buf) do { if (wave == 0) { float a0_ = d0 * A, a1_ = d1 * A; \
        _Pragma("unroll") for (int o = 1; o < 64; o <<= 1) { const float t0_ = __shfl_up(a0_, o), t1_ = __shfl_up(a1_, o); if (lane >= o) { a0_ += t0_; a1_ += t1_; } } \
        a1_ += __shfl(a0_, 63); \
        acsb[(buf) * 128 + lane] = a0_; acsb[(buf) * 128 + 64 + lane] = a1_; dtsb[(buf) * 128 + lane] = d0; dtsb[(buf) * 128 + 64 + lane] = d1; } } while (0)
    WALK_SCAN(0);
    for (int c = 0; c < 16; ++c) {
        const size_t row0 = (size_t)b * 2048 + c * 128;
        LAS float* acs = acsb + (c & 1) * 128; LAS float* dts = dtsb + (c & 1) * 128;
        LDS_BARRIER();
        const float a_end = acs[127];
#pragma unroll
        for (int i = 0; i < 4; ++i) { const int idx = tid + NTHR * i, l = idx >> 4, seg = idx & 15;
            *(LAS u32x4*)(Cs + l * LDW + seg * 8) = cgv[i]; *(LAS u32x4*)(Bs + l * LDW + seg * 8) = bgv[i]; }
#pragma unroll
        for (int i = 0; i < 2; ++i) { const int idx = tid + NTHR * i, l = idx >> 3, seg = idx & 7;
            const float dtl = dts[l], wl = dtl * __expf(a_end - acs[l]); const F8 x = unpack8(xgv[i]);
            u32x4 wd, ww;
            wd.x = cvtpk(x.v[0] * dtl, x.v[1] * dtl); wd.y = cvtpk(x.v[2] * dtl, x.v[3] * dtl); wd.z = cvtpk(x.v[4] * dtl, x.v[5] * dtl); wd.w = cvtpk(x.v[6] * dtl, x.v[7] * dtl);
            ww.x = cvtpk(x.v[0] * wl, x.v[1] * wl); ww.y = cvtpk(x.v[2] * wl, x.v[3] * wl); ww.z = cvtpk(x.v[4] * wl, x.v[5] * wl); ww.w = cvtpk(x.v[6] * wl, x.v[7] * wl);
            *(LAS u32x4*)(Xd + l * LDX + seg * 8) = wd; *(LAS u32x4*)(Xw + l * LDX + seg * 8) = ww; }
        u32x2 xe[4], ze[4];
        { const size_t row = row0 + lrow;
#pragma unroll
          for (int pt = 0; pt < 4; ++pt) { const int p0 = 16 * pt + 4 * quad; xe[pt] = *(const u32x2*)(XC + row * 3072 + h * 64 + p0); ze[pt] = *(const u32x2*)(Z + row * 2048 + h * 64 + p0); } }
        if (c < 15) { const size_t rown = row0 + 128;
#pragma unroll
            for (int i = 0; i < 4; ++i) { const int idx = tid + NTHR * i, l = idx >> 4, seg = idx & 15; const bf16* rp = XC + (rown + l) * 3072 + g * 128 + seg * 8; cgv[i] = *(const u32x4*)(rp + 2560); bgv[i] = *(const u32x4*)(rp + 2048); }
#pragma unroll
            for (int i = 0; i < 2; ++i) { const int idx = tid + NTHR * i, l = idx >> 3, seg = idx & 7; xgv[i] = *(const u32x4*)(XC + (rown + l) * 3072 + h * 64 + seg * 8); }
            d0 = DT[(rown + lane) * 32 + h]; d1 = DT[(rown + 64 + lane) * 32 + h]; }
        LDS_BARRIER();
        bf16x8 cf[4];
#pragma unroll
        for (int kk = 0; kk < 4; ++kk) cf[kk] = *(const LAS bf16x8*)(Cs + lrow * LDW + kk * 32 + quad * 8);
        const float acs_l = acs[lrow];
        f32x4 yo[4];
#pragma unroll
        for (int pt = 0; pt < 4; ++pt) { f32x4 t = (f32x4){0.f, 0.f, 0.f, 0.f};
#pragma unroll
            for (int kk = 0; kk < 4; ++kk) t = MFMA16(*(const LAS bf16x8*)(((c & 1) ? HbB : Hb) + (16 * pt + l16) * LDW + kk * 32 + quad * 8), cf[kk], t);
            yo[pt] = t; }
        const int nct = (wave | 1) + 1;
        for (int ct = 0; ct < nct; ++ct) {
            f32x4 t = (f32x4){0.f, 0.f, 0.f, 0.f};
            if (ct <= wave) {
#pragma unroll
                for (int kk = 0; kk < 4; ++kk) t = MFMA16(*(const LAS bf16x8*)(Bs + (16 * ct + l16) * LDW + kk * 32 + quad * 8), cf[kk], t);
                const f32x4 as = *(const LAS f32x4*)(acs + 16 * ct + 4 * quad);
#pragma unroll
                for (int r = 0; r < 4; ++r) { const int sidx = 16 * ct + 4 * quad + r; t[r] = (sidx <= lrow) ? t[r] * __expf(acs_l - as[r]) : 0.f; }
            }
            u32x2 w; w.x = cvtpk(t[0], t[1]); w.y = cvtpk(t[2], t[3]);
            *(LAS u32x2*)(Cs + lrow * LDW + 16 * ct + 4 * quad) = w;
        }
        f32x4 yd[4];
#pragma unroll
        for (int pt = 0; pt < 4; ++pt) yd[pt] = (f32x4){0.f, 0.f, 0.f, 0.f};
        const int nks = (wave >> 1) + 1;
        for (int ks = 0; ks < nks; ++ks) { const bf16x8 gq = *(const LAS bf16x8*)(Cs + lrow * LDW + ks * 32 + quad * 8);
#pragma unroll
            for (int pt = 0; pt < 4; ++pt) yd[pt] = MFMA16(tr_frag(Xd, LDX, ks * 32 + 8 * quad, 16 * pt, lane), gq, yd[pt]); }
        { const float el = __expf(acs_l); const size_t row = row0 + lrow; float sq = 0.f;
#pragma unroll
          for (int pt = 0; pt < 4; ++pt) { const int p0 = 16 * pt + 4 * quad;
              const float xv[4] = {bflo(xe[pt].x), bfhi(xe[pt].x), bflo(xe[pt].y), bfhi(xe[pt].y)}, zv[4] = {bflo(ze[pt].x), bfhi(ze[pt].x), bflo(ze[pt].y), bfhi(ze[pt].y)};
              float o[4];
#pragma unroll
              for (int r = 0; r < 4; ++r) { const float y = yd[pt][r] + el * yo[pt][r] + Dh * xv[r]; o[r] = y * (zv[r] * __builtin_amdgcn_rcpf(1.0f + __expf(-zv[r]))); }
              sq += (o[0] * o[0] + o[1] * o[1]) + (o[2] * o[2] + o[3] * o[3]);
              u32x2 w; w.x = cvtpk(o[0], o[1]); w.y = cvtpk(o[2], o[3]);
              *(u32x2*)(YG + row * 2048 + h * 64 + p0) = w; }
          sq += __shfl_xor(sq, 16); sq += __shfl_xor(sq, 32);
          if (quad == 0) SSQ2[row * 32 + h] = sq; }
        { const float cd = __expf(a_end);
          bf16x8 bfr[4];
#pragma unroll
          for (int kk = 0; kk < 4; ++kk) bfr[kk] = tr_frag(Bs, LDW, kk * 32 + 8 * quad, 16 * wave, lane);
#pragma unroll
          for (int pt = 0; pt < 4; ++pt) { f32x4 t = hacc[pt] * cd;
#pragma unroll
              for (int kk = 0; kk < 4; ++kk) t = MFMA16(bfr[kk], tr_frag(Xw, LDX, kk * 32 + 8 * quad, 16 * pt, lane), t);
              hacc[pt] = t;
              u32x2 w; w.x = cvtpk(t[0], t[1]); w.y = cvtpk(t[2], t[3]);
              *(LAS u32x2*)(((c & 1) ? Hb : HbB) + (16 * pt + l16) * LDW + 16 * wave + 4 * quad) = w; } }
        if (c < 15) WALK_SCAN((c + 1) & 1);
    }
#undef WALK_SCAN
#pragma unroll
    for (int pt = 0; pt < 4; ++pt) *(f32x4*)(out_ssm + ((size_t)(b * 32 + h) * 64 + 16 * pt + l16) * 128 + 16 * wave + 4 * quad) = hacc[pt];
    __syncthreads();
}
constexpr int SST_BYTES = 8192;
__device__ __forceinline__ u32x4 ss_piece(int uu, int tid, const bf16* __restrict__ XC, const float* __restrict__ DT, const bf16* __restrict__ Z) {
    const int b = uu >> 5, h = uu & 31, g = h >> 3; const size_t rowb = (size_t)MP + b * 8; u32x4 pc = (u32x4){0u, 0u, 0u, 0u};
    if (tid < 256) { const int t = tid >> 5, ch = tid & 31; pc = *(const u32x4*)(XC + (rowb + t) * 3072 + 2048 + (ch >> 4) * 512 + g * 128 + (ch & 15) * 8); }
    else if (tid < 320) { const int q = tid - 256, t = q >> 3, ch = q & 7; pc = *(const u32x4*)(XC + (rowb + t) * 3072 + h * 64 + ch * 8); }
    else if (tid < 384) { const int q = tid - 320, t = q >> 3, ch = q & 7; pc = *(const u32x4*)(Z + (rowb + t) * 2048 + h * 64 + ch * 8); }
    else if (tid < 392) { pc.x = __float_as_uint(DT[(rowb + (tid - 384)) * 32 + h]); }
    return pc;
}
__device__ __forceinline__ void ss_stage(LAS unsigned char* st, int tid, u32x4 pc) {
    if (tid < 256) *(LAS u32x4*)(st + (tid >> 5) * 512 + (tid & 31) * 16) = pc;
    else if (tid < 320) *(LAS u32x4*)(st + 4096 + (tid - 256) * 16) = pc;
    else if (tid < 384) *(LAS u32x4*)(st + 5120 + (tid - 320) * 16) = pc;
    else if (tid < 392) *(LAS unsigned*)(st + 6144 + (tid - 384) * 4) = pc.x;
}
__device__ __forceinline__ void ss_state_load(int uu, int tid, const float* __restrict__ st_in, f32x4 (&hv)[4]) {
    const size_t so = ((size_t)uu * 64 + (tid >> 3)) * 128 + (tid & 7) * 16;
#pragma unroll
    for (int j = 0; j < 4; ++j) hv[j] = *(const f32x4*)(st_in + so + 4 * j);
}
__device__ __forceinline__ void ss_compute(const LAS unsigned char* st, int uu, int tid, f32x4 (&hv)[4], const float* a_log, const float* d_skip, bf16* __restrict__ YG, float* __restrict__ st_out) {
    const int p = tid >> 3, nq = tid & 7, b = uu >> 5, h = uu & 31; const size_t rowb = (size_t)MP + b * 8;
    const float A = -__expf(a_log[h]), Dh = d_skip[h];
    float yo = 0.f;
#pragma unroll 2
    for (int t = 0; t < 8; ++t) {
        const float dt = *(const LAS float*)(st + 6144 + t * 4), dA = __expf(dt * A);
        const float xv = bf2f(*(const LAS bf16*)(st + 4096 + t * 128 + p * 2)), z = bf2f(*(const LAS bf16*)(st + 5120 + t * 128 + p * 2));
        const LAS unsigned char* bc = st + t * 512 + nq * 32;
        const u32x4 Bw0 = *(const LAS u32x4*)bc, Bw1 = *(const LAS u32x4*)(bc + 16), Cw0 = *(const LAS u32x4*)(bc + 256), Cw1 = *(const LAS u32x4*)(bc + 272);
        const float coef = dt * xv; f32x2_t y2 = {0.f, 0.f}; const f32x2_t dA2 = {dA, dA}, cf2 = {coef, coef};
#define SS_PAIR(j, lohi, bw, cw) do { f32x2_t h2 = {hv[j][2 * (lohi)], hv[j][2 * (lohi) + 1]}; const f32x2_t b2 = {bflo(bw), bfhi(bw)}, c2 = {bflo(cw), bfhi(cw)}; \
            h2 = h2 * dA2 + cf2 * b2; y2 += h2 * c2; hv[j][2 * (lohi)] = h2.x; hv[j][2 * (lohi) + 1] = h2.y; } while (0)
        SS_PAIR(0, 0, Bw0.x, Cw0.x); SS_PAIR(0, 1, Bw0.y, Cw0.y); SS_PAIR(1, 0, Bw0.z, Cw0.z); SS_PAIR(1, 1, Bw0.w, Cw0.w);
        SS_PAIR(2, 0, Bw1.x, Cw1.x); SS_PAIR(2, 1, Bw1.y, Cw1.y); SS_PAIR(3, 0, Bw1.z, Cw1.z); SS_PAIR(3, 1, Bw1.w, Cw1.w);
#undef SS_PAIR
        float y = y2.x + y2.y;
        y += __shfl_xor(y, 1); y += __shfl_xor(y, 2); y += __shfl_xor(y, 4);
        y += Dh * xv;
        const float yg = y * (z * __builtin_amdgcn_rcpf(1.0f + __expf(-z)));
        yo = (nq == t) ? yg : yo;
    }
    YG[(rowb + nq) * 2048 + h * 64 + p] = (bf16)f2bf(yo);
    const size_t so = ((size_t)uu * 64 + p) * 128 + nq * 16;
#pragma unroll
    for (int j = 0; j < 4; ++j) __builtin_nontemporal_store(hv[j], (f32x4*)(st_out + so + 4 * j));
}
__device__ __forceinline__ void ssd_sample_units(LAS unsigned char* lds, int G, const bf16* __restrict__ XC, const float* __restrict__ DT, const bf16* __restrict__ Z, bf16* __restrict__ YG, const float* a_log, const float* d_skip, const float* __restrict__ st_in, float* __restrict__ st_out, int tid_in) {
    int tid = tid_in; asm volatile("" : "+v"(tid));
    int u = blockIdx.x; if (u >= 4096) return;
    f32x4 hna[4], hnb[4]; u32x4 pa = ss_piece(u, tid, XC, DT, Z), pb = (u32x4){0u, 0u, 0u, 0u};
    ss_state_load(u, tid, st_in, hna);
    if (u + G < 4096) { pb = ss_piece(u + G, tid, XC, DT, Z); ss_state_load(u + G, tid, st_in, hnb); }
    for (int it = 0; u < 4096; ++it) {
        LAS unsigned char* st0 = lds + (it & 1) * (2 * SST_BYTES); LAS unsigned char* st1 = st0 + SST_BYTES;
        const bool hasb = u + G < 4096;
        f32x4 ha[4], hb[4];
#pragma unroll
        for (int j = 0; j < 4; ++j) { ha[j] = hna[j]; hb[j] = hnb[j]; }
        ss_stage(st0, tid, pa); if (hasb) ss_stage(st1, tid, pb);
        const int un = u + 2 * G;
        if (un < 4096) { pa = ss_piece(un, tid, XC, DT, Z); ss_state_load(un, tid, st_in, hna); }
        if (un + G < 4096) { pb = ss_piece(un + G, tid, XC, DT, Z); ss_state_load(un + G, tid, st_in, hnb); }
        LDS_BARRIER();
        ss_compute(st0, u, tid, ha, a_log, d_skip, YG, st_out);
        if (hasb) ss_compute(st1, u + G, tid, hb, a_log, d_skip, YG, st_out);
        u = un;
    }
    __syncthreads();
}

__device__ __forceinline__ void ssd_sample_units_mfma(LAS unsigned char* lds, int G, const bf16* __restrict__ XC, const float* __restrict__ DT, const bf16* __restrict__ Z, bf16* __restrict__ YG, const float* a_log, const float* d_skip, const float* __restrict__ st_in, float* __restrict__ st_out, int tid_in) {
    int tid = tid_in; asm volatile("" : "+v"(tid));
    const int wave = __builtin_amdgcn_readfirstlane(tid >> 6), lane = tid & 63, l16 = lane & 15, quad = lane >> 4;
    LAS bf16* Cs = (LAS bf16*)lds;
    LAS bf16* Bs = (LAS bf16*)(lds + 4352);
    LAS bf16* Xd = (LAS bf16*)(lds + 13056);
    LAS bf16* Xw = (LAS bf16*)(lds + 17664);
    LAS bf16* Hb = (LAS bf16*)(lds + 22272);
    LAS bf16* Gs = (LAS bf16*)(lds + 39680) + wave * 640;
    LAS float* acs = (LAS float*)(lds + 44800);
    LAS float* dts = acs + 16;
    for (int i = tid; i < 44800 / 4; i += NTHR) ((LAS unsigned*)lds)[i] = 0u;
    int u = blockIdx.x; if (u >= 4096) { __syncthreads(); return; }
    f32x4 hst[4]; u32x4 pc = (u32x4){0u, 0u, 0u, 0u}; u32x2 xe = (u32x2){0u, 0u}, ze = (u32x2){0u, 0u}; float dtv = 0.f;
#define SM_LOAD(uu) do { const int b_ = (uu) >> 5, h_ = (uu) & 31, g_ = h_ >> 3; const size_t rowb_ = (size_t)MP + b_ * 8; \
        _Pragma("unroll") for (int pt = 0; pt < 4; ++pt) hst[pt] = __builtin_nontemporal_load((const f32x4*)(st_in + ((size_t)(uu) * 64 + 16 * pt + l16) * 128 + 16 * wave + 4 * quad)); \
        if (tid < 128) pc = *(const u32x4*)(XC + (rowb_ + (tid >> 4)) * 3072 + 2560 + g_ * 128 + (tid & 15) * 8); \
        else if (tid < 256) pc = *(const u32x4*)(XC + (rowb_ + ((tid - 128) >> 4)) * 3072 + 2048 + g_ * 128 + (tid & 15) * 8); \
        else if (tid < 320) pc = *(const u32x4*)(XC + (rowb_ + ((tid - 256) >> 3)) * 3072 + h_ * 64 + (tid & 7) * 8); \
        else if (tid < 328) dtv = DT[(rowb_ + (tid - 320)) * 32 + h_]; \
        if (wave < 4) { xe = *(const u32x2*)(XC + (rowb_ + (l16 & 7)) * 3072 + h_ * 64 + 16 * wave + 4 * quad); ze = *(const u32x2*)(Z + (rowb_ + (l16 & 7)) * 2048 + h_ * 64 + 16 * wave + 4 * quad); } } while (0)
    SM_LOAD(u);
    __syncthreads();
    while (u < 4096) {
        const int b = u >> 5, h = u & 31; const size_t rowb = (size_t)MP + b * 8;
        const float A = -__expf(a_log[h]), Dh = d_skip[h];
        f32x4 hacc[4]; const u32x4 pcc = pc; const u32x2 xec = xe, zec = ze;
#pragma unroll
        for (int pt = 0; pt < 4; ++pt) { hacc[pt] = hst[pt]; u32x2 w; w.x = cvtpk(hacc[pt][0], hacc[pt][1]); w.y = cvtpk(hacc[pt][2], hacc[pt][3]);
            *(LAS u32x2*)(Hb + (16 * pt + l16) * LDW + 16 * wave + 4 * quad) = w; }
        if (wave == 5) {
            float a0 = (lane < 8) ? dtv * A : 0.f;
#pragma unroll
            for (int o = 1; o < 8; o <<= 1) { const float t0 = __shfl_up(a0, o); if (lane >= o) a0 += t0; }
            const float aend = __shfl(a0, 7);
            if (lane < 16) { acs[lane] = (lane < 8) ? a0 : aend; dts[lane] = (lane < 8) ? dtv : 0.f; }
        }
        LDS_BARRIER();
        const float a_end = acs[7];
        if (tid < 128) *(LAS u32x4*)(Cs + (tid >> 4) * LDW + (tid & 15) * 8) = pcc;
        else if (tid < 256) *(LAS u32x4*)(Bs + ((tid - 128) >> 4) * LDW + (tid & 15) * 8) = pcc;
        else if (tid < 320) { const int t = (tid - 256) >> 3, seg = tid & 7; const float dtl = dts[t], wl = dtl * __expf(a_end - acs[t]); const F8 x = unpack8(pcc);
            u32x4 wd, ww;
            wd.x = cvtpk(x.v[0] * dtl, x.v[1] * dtl); wd.y = cvtpk(x.v[2] * dtl, x.v[3] * dtl); wd.z = cvtpk(x.v[4] * dtl, x.v[5] * dtl); wd.w = cvtpk(x.v[6] * dtl, x.v[7] * dtl);
            ww.x = cvtpk(x.v[0] * wl, x.v[1] * wl); ww.y = cvtpk(x.v[2] * wl, x.v[3] * wl); ww.z = cvtpk(x.v[4] * wl, x.v[5] * wl); ww.w = cvtpk(x.v[6] * wl, x.v[7] * wl);
            *(LAS u32x4*)(Xd + t * LDX + seg * 8) = wd; *(LAS u32x4*)(Xw + t * LDX + seg * 8) = ww; }
        const int un = u + G;
        if (un < 4096) SM_LOAD(un);
        LDS_BARRIER();
        if (wave < 4) {
            const int pt = wave;
            bf16x8 cf[4];
#pragma unroll
            for (int kk = 0; kk < 4; ++kk) cf[kk] = *(const LAS bf16x8*)(Cs + l16 * LDW + kk * 32 + quad * 8);
            const float acs_l = acs[l16];
            f32x4 yo = (f32x4){0.f, 0.f, 0.f, 0.f}, sc = (f32x4){0.f, 0.f, 0.f, 0.f};
#pragma unroll
            for (int kk = 0; kk < 4; ++kk) yo = MFMA16(*(const LAS bf16x8*)(Hb + (16 * pt + l16) * LDW + kk * 32 + quad * 8), cf[kk], yo);
#pragma unroll
            for (int kk = 0; kk < 4; ++kk) sc = MFMA16(*(const LAS bf16x8*)(Bs + l16 * LDW + kk * 32 + quad * 8), cf[kk], sc);
            { const f32x4 as = *(const LAS f32x4*)(acs + 4 * quad);
#pragma unroll
              for (int r = 0; r < 4; ++r) { const int sidx = 4 * quad + r; sc[r] = (sidx <= l16) ? sc[r] * __expf(acs_l - as[r]) : 0.f; }
              u32x2 w; w.x = cvtpk(sc[0], sc[1]); w.y = cvtpk(sc[2], sc[3]);
              *(LAS u32x2*)(Gs + l16 * 40 + 4 * quad) = w; }
            const bf16x8 gq = *(const LAS bf16x8*)(Gs + l16 * 40 + quad * 8);
            f32x4 yd = (f32x4){0.f, 0.f, 0.f, 0.f};
            yd = MFMA16(tr_frag(Xd, LDX, 8 * quad, 16 * pt, lane), gq, yd);
            const float el = __expf(acs_l);
            const float xv[4] = {bflo(xec.x), bfhi(xec.x), bflo(xec.y), bfhi(xec.y)}, zv[4] = {bflo(zec.x), bfhi(zec.x), bflo(zec.y), bfhi(zec.y)};
            float o[4];
#pragma unroll
            for (int r = 0; r < 4; ++r) { const float y = yd[r] + el * yo[r] + Dh * xv[r]; o[r] = y * (zv[r] * __builtin_amdgcn_rcpf(1.0f + __expf(-zv[r]))); }
            u32x2 w; w.x = cvtpk(o[0], o[1]); w.y = cvtpk(o[2], o[3]);
            if (l16 < 8) *(u32x2*)(YG + (rowb + l16) * 2048 + h * 64 + 16 * pt + 4 * quad) = w;
        }
        {
            const float cd = __expf(a_end);
            const bf16x8 bfr = tr_frag(Bs, LDW, 8 * quad, 16 * wave, lane);
#pragma unroll
            for (int pt = 0; pt < 4; ++pt) { f32x4 t = hacc[pt] * cd; t = MFMA16(bfr, tr_frag(Xw, LDX, 8 * quad, 16 * pt, lane), t);
                __builtin_nontemporal_store(t, (f32x4*)(st_out + ((size_t)u * 64 + 16 * pt + l16) * 128 + 16 * wave + 4 * quad)); }
        }
        LDS_BARRIER();
        u = un;
    }
#undef SM_LOAD
    __syncthreads();
}

#define XB_TMO      128
#define XB_XCNT(j)  (256  + 64 * (j))
#define XB_XSUB(j)  (1280 + 64 * (j))
#define XB_XGEN(j)  (2304 + 64 * (j))
#define XB_TOP      3328
#define XB_TOPGEN   3392
#define XCD_BAR_WORDS 3456
#define XB_SPIN_CAP (1u << 18)

__device__ __forceinline__ unsigned xb_ld(unsigned* p)              { return __hip_atomic_load(p, __ATOMIC_RELAXED, __HIP_MEMORY_SCOPE_AGENT); }
__device__ __forceinline__ unsigned xb_add(unsigned* p, unsigned v) { return __hip_atomic_fetch_add(p, v, __ATOMIC_RELAXED, __HIP_MEMORY_SCOPE_AGENT); }
__device__ __forceinline__ unsigned xb_xcc_id() { return (unsigned)__builtin_amdgcn_s_getreg((3 << 11) | 20) & 0xFu; }
#define XB_SPIN(cond, bar) do { unsigned _sp = 0; while (cond) { __builtin_amdgcn_s_sleep(1); \
    if ((++_sp & 255u) == 0u) { if (xb_ld(&(bar)[XB_TMO])) break; if (_sp > XB_SPIN_CAP) { atomicAdd(&(bar)[XB_TMO], 1u); break; } } } } while (0)

struct XcdBarrier {
    unsigned* bar; unsigned x;
    volatile LAS unsigned* st;
};

__device__ __forceinline__ XcdBarrier xcd_barrier_post(unsigned* bar, volatile LAS unsigned* st) {
    XcdBarrier b; b.bar = bar; b.x = xb_xcc_id(); b.st = st;
    if (threadIdx.x == 0) (void)xb_add(&bar[XB_XCNT(b.x)], 1u);
    return b;
}
__device__ __forceinline__ void xcd_barrier_complete(unsigned* bar, unsigned x, unsigned& nloc, unsigned& nx) {
    const unsigned G = gridDim.x * gridDim.y * gridDim.z;
    unsigned sum, cnt, mine, sp = 0u;
    for (;;) {
        sum = 0u; cnt = 0u; mine = 0u;
#pragma unroll
        for (unsigned j = 0; j < 16; ++j) { const unsigned c = xb_ld(&bar[XB_XCNT(j)]); sum += c; cnt += (c > 0u) ? 1u : 0u; mine = (j == x) ? c : mine; }
        if (sum == G) break;
        __builtin_amdgcn_s_sleep(1);
        if ((++sp & 255u) == 0u) { if (xb_ld(&bar[XB_TMO])) break; if (sp > XB_SPIN_CAP) { atomicAdd(&bar[XB_TMO], 1u); break; } }
    }
    nloc = mine > 0u ? mine : 1u; nx = cnt > 0u ? cnt : 1u;
}

__device__ __forceinline__ void xcd_barrier(const XcdBarrier& b) {
    asm volatile("s_waitcnt vmcnt(0)" ::: "memory");
    __syncthreads();
    if (threadIdx.x == 0) {
        unsigned* bar = b.bar;
        __builtin_amdgcn_s_waitcnt(0);
        unsigned nloc = b.st[0], nx = b.st[1];
        if (nloc == 0u) { xcd_barrier_complete(bar, b.x, nloc, nx); b.st[0] = nloc; b.st[1] = nx; }
        const unsigned old = xb_add(&bar[XB_XSUB(b.x)], 1u);
        const unsigned gen = old / nloc;
        if (old + 1u == (gen + 1u) * nloc) {
            __builtin_amdgcn_fence(__ATOMIC_RELEASE, "agent");
            asm volatile("s_waitcnt vmcnt(0)" ::: "memory");
            const unsigned og = xb_add(&bar[XB_TOP], 1u);
            const unsigned tg = og / nx;
            if (og + 1u == (tg + 1u) * nx) xb_add(&bar[XB_TOPGEN], 1u);
            else XB_SPIN(xb_ld(&bar[XB_TOPGEN]) == tg, bar);
            __builtin_amdgcn_fence(__ATOMIC_ACQUIRE, "agent");
            xb_add(&bar[XB_XGEN(b.x)], 1u);
            asm volatile("s_waitcnt vmcnt(0)" ::: "memory");
        } else {
            XB_SPIN(xb_ld(&bar[XB_XGEN(b.x)]) == gen, bar);
            __builtin_amdgcn_fence(__ATOMIC_ACQUIRE, "agent");
            asm volatile("s_waitcnt vmcnt(0)" ::: "memory");
        }
    }
    __syncthreads();
}

template <int S> __device__ __forceinline__ F8 part_sum(const float* __restrict__ P, int r, int col) {
    f32x4 va[S], vb[S];
#pragma unroll
    for (int k = 0; k < S; ++k) { const float* q = P + ((size_t)k * 1024 + r) * 1024 + col; va[k] = *(const f32x4*)q; vb[k] = *(const f32x4*)(q + 4); }
    f32x4 sa = va[0], sb = vb[0];
#pragma unroll
    for (int k = 1; k < S; ++k) { sa += va[k]; sb += vb[k]; }
    F8 s; s.v[0] = sa[0]; s.v[1] = sa[1]; s.v[2] = sa[2]; s.v[3] = sa[3]; s.v[4] = sb[0]; s.v[5] = sb[1]; s.v[6] = sb[2]; s.v[7] = sb[3];
    return s;
}
template <int S, bool BASE_BF16, bool WRITE_X, bool WRITE_XB, bool SCALED = false> __device__ __forceinline__ void pass_resid(const float* P, const float* base, float* X, bf16* XB, float* RSTD, float scale, int G, int wave, int lane) {
    for (int r = blockIdx.x * NWAVES + wave; r < MS; r += G * NWAVES) {
        const size_t row = (size_t)MP + r; float ss = 0.f; const float rinv = SCALED ? RSTD[row] : 1.0f;
#pragma unroll
        for (int hf = 0; hf < 2; ++hf) { const int col = hf * 512 + lane * 8;
            F8 b; if constexpr (BASE_BF16) b = unpack8(*(const u32x4*)(XB + row * 1024 + col)); else b = loadf8(base + row * 1024 + col);
            if constexpr (SCALED) {
#pragma unroll
                for (int e = 0; e < 8; ++e) b.v[e] *= rinv; }
            const F8 a = part_sum<S>(P, r, col); F8 v;
#pragma unroll
            for (int e = 0; e < 8; ++e) { v.v[e] = b.v[e] + scale * a.v[e]; ss += v.v[e] * v.v[e]; }
            if constexpr (WRITE_X) storef8(X + row * 1024 + col, v);
            if constexpr (WRITE_XB) *(u32x4*)(XB + row * 1024 + col) = pack8(v); }
        ss = wave_sum(ss);
        if (WRITE_XB && lane == 0) RSTD[row] = __builtin_amdgcn_rsqf(ss * (1.0f / 1024.0f) + EPS);
    }
}
template <int S> __device__ __forceinline__ void pass_final(const float* P, const bf16* XB, const float* gfin, float* Y, float scale, int G, int wave, int lane) {
    for (int r = blockIdx.x * NWAVES + wave; r < MS; r += G * NWAVES) {
        const size_t row = (size_t)MP + r; float ss = 0.f; F8 v[2];
#pragma unroll
        for (int hf = 0; hf < 2; ++hf) { const int col = hf * 512 + lane * 8;
            const F8 b = unpack8(*(const u32x4*)(XB + row * 1024 + col)), a = part_sum<S>(P, r, col);
#pragma unroll
            for (int e = 0; e < 8; ++e) { v[hf].v[e] = b.v[e] + scale * a.v[e]; ss += v[hf].v[e] * v[hf].v[e]; } }
        const float rstd = __builtin_amdgcn_rsqf(wave_sum(ss) * (1.0f / 1024.0f) + EPS);
#pragma unroll
        for (int hf = 0; hf < 2; ++hf) { const int col = hf * 512 + lane * 8; const F8 g = loadf8(gfin + col); F8 o;
#pragma unroll
            for (int e = 0; e < 8; ++e) o.v[e] = v[hf].v[e] * rstd * g.v[e];
            storef8(Y + row * 1024 + col, o); }
    }
}
__device__ __forceinline__ void pass_rstd_prompt(const float* SSQ, float* RSTD, int G, int tid) {
    for (int row = blockIdx.x * NTHR + tid; row < MP; row += G * NTHR) RSTD[row] = pg8::rstd16(SSQ, row);
}
template <int S> __device__ __forceinline__ void pass_merge(const float* P, const bf16* GL, const float* PP, bf16* O, int G, int wave, int lane) {
    for (int it = blockIdx.x * NWAVES + wave; it < 2 * MS; it += G * NWAVES) {
        const int r = it >> 1, hf = it & 1, col = hf * 512 + lane * 8; const size_t row = (size_t)MP + r;
        const F8 g0 = unpack8(*(const u32x4*)(GL + row * 2048 + col)), g1 = unpack8(*(const u32x4*)(GL + row * 2048 + 1024 + col)), bp = part_sum<4>(PP, r, col), a = part_sum<S>(P, r, col); F8 v;
#pragma unroll
        for (int e = 0; e < 8; ++e) v.v[e] = bp.v[e] * __builtin_amdgcn_rcpf(1.0f + __expf(-g0.v[e])) + a.v[e] * __builtin_amdgcn_rcpf(1.0f + __expf(-g1.v[e]));
        *(u32x4*)(O + row * 1024 + col) = pack8(v);
    }
}
template <int S> __device__ __forceinline__ void pass_plain(const float* P, bf16* O, int G, int wave, int lane) {
    for (int it = blockIdx.x * NWAVES + wave; it < 2 * MS; it += G * NWAVES) {
        const int r = it >> 1, hf = it & 1, col = hf * 512 + lane * 8; const size_t row = (size_t)MP + r;
        const F8 a = part_sum<S>(P, r, col); *(u32x4*)(O + row * 1024 + col) = pack8(a);
    }
}

__device__ unsigned g_bar[XCD_BAR_WORDS + 64];

__global__ void __launch_bounds__(NTHR, 2) fwd_kernel(Args a) {
    extern __shared__ __attribute__((aligned(16))) unsigned char lds_raw[];
    LAS unsigned char* lds = (LAS unsigned char*)lds_raw;
    const int tid = threadIdx.x, G = gridDim.x, lane = tid & 63, wave = __builtin_amdgcn_readfirstlane(tid >> 6);
    unsigned char* ws = a.ws;
    const int lo = a.ph_lo, hi = a.ph_hi;
    using namespace pg8;
    volatile LAS unsigned* MISC = (volatile LAS unsigned*)(lds + LDS_MISC_OFF);
    if (tid < 4) MISC[tid] = 0u;
    __syncthreads();
    const XcdBarrier bar = xcd_barrier_post((unsigned*)g_bar, MISC);
    bf16* XB = (bf16*)(ws + WS_XB); bf16* HID = (bf16*)(ws + WS_RA); float* SSQ = (float*)(ws + WS_SSQ); float* DT = (float*)(ws + WS_DT); float* RSTD = (float*)(ws + WS_RSTD);
    float* X = a.out + O_Y;
#ifndef PROBE_PHASE
#define PROBE_PHASE -1
#endif
#ifndef PROBE_AMP
#define PROBE_AMP 4
#endif
    unsigned long long tp0 = 0, tp1 = 0;
#define IN(k) ((((k) == PROBE_PHASE) ? (void)(tp0 = __builtin_amdgcn_s_memrealtime()) : (void)0), (lo <= (k) && (k) < hi))
#define SEAM(k) do { if ((k) + 1 < hi) { xcd_barrier(bar); } if ((k) == PROBE_PHASE) tp1 = __builtin_amdgcn_s_memrealtime(); } while (0)
    if (IN(0)) { phase0(a, lds, G, tid); SEAM(0); }
    if (IN(1)) {
        {
            Gemm gw{(const bf16_t*)(ws + WS_WPO), (const bf16_t*)(ws + WS_WPG), 1024, D, 256, D, 256, 256, nullptr}; StaticOrder Sw; Sw.init(1024, D, 256, 16, (int)blockIdx.x - (G - 16));
            if ((int)blockIdx.x >= G - 16) { EpiPlain Ew{(bf16*)(ws + WS_WEFF)}; gemm_phase<EpiPlain, StaticOrder, true, true>(lds, gw, Sw, Ew); }
        }
        Gemm g{XB, (const bf16_t*)(ws + WS_W1A), M, 2 * FF, D, D, D, 0, nullptr}; StaticOrder S; S.init(M, 2 * FF, D, G, (int)blockIdx.x);
        EpiSwiGLU E{HID, nullptr};
        gemm_phase<EpiSwiGLU, StaticOrder, true, true>(lds, g, S, E); SEAM(1);
    }
    if (IN(2)) {
        Gemm g{HID, (const bf16_t*)(ws + WS_W1B), M, D, FF, FF, FF, 0, (float*)(ws + WS_RD)}; SplitOrder S; S.init(FF, G, (int)blockIdx.x);
        typedef EpiResid<true, false, true, true> Epi2; Epi2 E{RSTD, RSTD, X, XB, SSQ, 0.5f};
        gemm_phase<Epi2, SplitOrder, true, true>(lds, g, S, E); xcd_barrier(bar);
        pass_resid<FF / 256, true, false, true, true>((const float*)(ws + WS_RD), nullptr, X, XB, RSTD, 0.5f, G, wave, lane); pass_rstd_prompt(SSQ, RSTD, G, tid); SEAM(2);
    }
    if (IN(3)) {
        Gemm g{XB, (const bf16_t*)(ws + WS_WIN), M, NPROJ_PAD, D, D, D, 0, nullptr}; StaticOrder S; S.init(M, NPROJ_PAD, D, G, (int)blockIdx.x);
        EpiInProj E{(bf16*)(ws + WS_RC), (bf16*)(ws + WS_RD), (bf16*)(ws + WS_RA), (bf16*)(ws + WS_RE), DT, a.in[I_DTB], RSTD};
        gemm_phase<EpiInProj, StaticOrder, true, true>(lds, g, S, E); SEAM(3);
    }
    if (IN(4)) { phase4(a, G, tid); SEAM(4); }
    if (IN(5)) {
        const bf16* XC = (const bf16*)(ws + WS_RB); const bf16* Z = (const bf16*)(ws + WS_RD); bf16* YG = (bf16*)(ws + WS_RA);
        if (PROBE_PHASE == 50) tp0 = __builtin_amdgcn_s_memrealtime();
        for (int u = blockIdx.x; u < 256; u += G) ssd_prompt_unit(lds, u >> 5, u & 31, XC, DT, Z, YG, a.in[I_ALOG], a.in[I_DSKIP], a.out + O_SP, (float*)(ws + WS_RC), tid);
        if (PROBE_PHASE == 50) tp1 = __builtin_amdgcn_s_memrealtime();
        if (PROBE_PHASE == 51) tp0 = __builtin_amdgcn_s_memrealtime();
        ssd_sample_units_mfma(lds, G, XC, DT, Z, YG, a.in[I_ALOG], a.in[I_DSKIP], a.in[I_SSSM], a.out + O_SS, tid);
        if (PROBE_PHASE == 51) tp1 = __builtin_amdgcn_s_memrealtime();
SEAM(5);
    }
    if (IN(6)) {
        Gemm g{(const bf16_t*)(ws + WS_RF), (const bf16_t*)(ws + WS_WEFF), M, D, D, D, D, 0, (float*)(ws + WS_RC + 4 * MiB)}; SplitOrder S; S.init(D, G, (int)blockIdx.x);
        EpiPlain E{(bf16*)(ws + WS_RB)};
        gemm_phase<EpiPlain, SplitOrder, true, true>(lds, g, S, E);
        bf16* YG = (bf16*)(ws + WS_RA);
        for (int u = MP * 4 + blockIdx.x * NWAVES + wave; u < M * 4; u += G * NWAVES) {
            u32x4* p = (u32x4*)(YG + (size_t)u * 512) + lane; F8 v = unpack8(*p); float sq = 0.f;
#pragma unroll
            for (int e = 0; e < 8; ++e) sq += v.v[e] * v.v[e];
            const float r = __builtin_amdgcn_rsqf(wave_sum(sq) * (1.0f / 512.0f) + EPS);
#pragma unroll
            for (int e = 0; e < 8; ++e) v.v[e] *= r;
            *p = pack8(v);
        }
        {
            const float* SSQ2 = (const float*)(ws + WS_RC); float* RAT = (float*)(ws + WS_RAT);
            for (int row = blockIdx.x * NTHR + tid; row < MP; row += G * NTHR) {
                const f32x4* q = (const f32x4*)(SSQ2 + (size_t)row * 32); float r[4];
#pragma unroll
                for (int g = 0; g < 4; ++g) { const f32x4 x0 = q[2 * g], x1 = q[2 * g + 1]; r[g] = __builtin_amdgcn_rsqf((((x0[0] + x0[1]) + (x0[2] + x0[3])) + ((x1[0] + x1[1]) + (x1[2] + x1[3]))) * (1.0f / 512.0f) + EPS); }
                *(f32x4*)(RAT + (size_t)row * 4) = (f32x4){r[0] / r[1], r[1] / r[2], r[2] / r[3], r[3]};
            }
        }
        SEAM(6);
    }
    if (IN(7)) {
        Gemm g{(const bf16_t*)(ws + WS_RA), (const bf16_t*)(ws + WS_WSO), M, D, 2048, 2048, 2048, 0, (float*)(ws + WS_RD)}; SplitOrder S; S.init(2048, G, (int)blockIdx.x);
        EpiMerge E{(const bf16_t*)(ws + WS_RE), (const bf16_t*)(ws + WS_RB), (bf16*)(ws + WS_RB + SZ1K), (const float*)(ws + WS_RAT)};
        gemm_phase<EpiMerge, SplitOrder, true, true>(lds, g, S, E); xcd_barrier(bar);
        pass_merge<8>((const float*)(ws + WS_RD), (const bf16*)(ws + WS_RE), (const float*)(ws + WS_RC + 4 * MiB), (bf16*)(ws + WS_RB + SZ1K), G, wave, lane); SEAM(7);
    }
    if (IN(8)) {
        Gemm g{(const bf16_t*)(ws + WS_RB + SZ1K), (const bf16_t*)(ws + WS_WO), M, D, D, D, D, 0, (float*)(ws + WS_RD)}; SplitOrder S; S.init(D, G, (int)blockIdx.x);
        typedef EpiResid<true, false, true> Epi8; Epi8 E{X, X, X, XB, SSQ, 1.0f};
        gemm_phase<Epi8, SplitOrder, true, true>(lds, g, S, E); xcd_barrier(bar);
        pass_resid<D / 256, true, false, true>((const float*)(ws + WS_RD), X, X, XB, RSTD, 1.0f, G, wave, lane); pass_rstd_prompt(SSQ, RSTD, G, tid); SEAM(8);
    }
    if (IN(9)) {
        Gemm g{XB, (const bf16_t*)(ws + WS_W2A), M, 2 * FF, D, D, D, 0, nullptr}; StaticOrder S; S.init(M, 2 * FF, D, G, (int)blockIdx.x);
        EpiSwiGLU E{HID, RSTD};
        gemm_phase<EpiSwiGLU, StaticOrder, true, true>(lds, g, S, E); SEAM(9);
    }
    if (IN(10)) {
        Gemm g{HID, (const bf16_t*)(ws + WS_W2B), M, D, FF, FF, FF, 0, (float*)(ws + WS_RD)}; SplitOrder S; S.init(FF, G, (int)blockIdx.x);
        typedef EpiResid<true, false, true> Epi10; Epi10 E{X, X, X, XB, SSQ, 0.5f};
        gemm_phase<Epi10, SplitOrder, true, true>(lds, g, S, E); xcd_barrier(bar);
        pass_final<FF / 256>((const float*)(ws + WS_RD), XB, a.in[I_NFIN], X, 0.5f, G, wave, lane);
        const float* gn = a.in[I_NFIN];
        for (int m0 = (blockIdx.x * NWAVES + wave) * 4; m0 < MP; m0 += G * NWAVES * 4) {
            const u32x4* xr = (const u32x4*)(XB + (size_t)m0 * D) + lane; u32x4 raw[4][2];
#pragma unroll
            for (int q = 0; q < 4; ++q) { raw[q][0] = xr[128 * q]; raw[q][1] = xr[128 * q + 64]; }
            const F8 g0 = loadf8(gn + lane * 8), g1 = loadf8(gn + 512 + lane * 8);
#pragma unroll
            for (int q = 0; q < 4; ++q) { const F8 a0 = unpack8(raw[q][0]), a1 = unpack8(raw[q][1]); float ss = 0.f;
#pragma unroll
                for (int e = 0; e < 8; ++e) ss += a0.v[e] * a0.v[e] + a1.v[e] * a1.v[e];
                const float rstd = __builtin_amdgcn_rsqf(wave_sum(ss) * (1.f / D) + EPS); F8 o0, o1;
#pragma unroll
                for (int e = 0; e < 8; ++e) { o0.v[e] = a0.v[e] * rstd * g0.v[e]; o1.v[e] = a1.v[e] * rstd * g1.v[e]; }
                storef8(X + (size_t)(m0 + q) * D + lane * 8, o0); storef8(X + (size_t)(m0 + q) * D + 512 + lane * 8, o1); }
        }
    }
    {
        __syncthreads();
        __shared__ unsigned s_last;
        if (tid == 0) s_last = (__hip_atomic_fetch_add(&g_bar[XCD_BAR_WORDS], 1u, __ATOMIC_RELAXED, __HIP_MEMORY_SCOPE_AGENT) == (unsigned)G - 1u) ? 1u : 0u;
        __syncthreads();
        if (s_last) { for (int i = tid; i < XCD_BAR_WORDS + 64; i += NTHR) __hip_atomic_store(&g_bar[i], 0u, __ATOMIC_RELAXED, __HIP_MEMORY_SCOPE_AGENT); }
    }
    if (hi > N_PHASES) cg::this_grid().sync();
    if (PROBE_PHASE == 99) { for (int i = 0; i < 16; ++i) xcd_barrier(bar); }
    if (PROBE_PHASE >= 0 && PROBE_PHASE != 99 && blockIdx.x == 0) { const unsigned long long t2 = __builtin_amdgcn_s_memrealtime(), want = (tp1 - tp0) * PROBE_AMP; while (__builtin_amdgcn_s_memrealtime() - t2 < want) __builtin_amdgcn_s_sleep(8); }
#undef IN
#undef SEAM
}

extern "C" void kernel_launch(void* const* d_in, const int* in_sizes, int n_in, void* d_out, int out_size, void* d_ws, size_t ws_size, hipStream_t stream) {
    static int grid = 0;
    if (grid == 0) {
        if (n_in != 25 || out_size != (int)O_END || ws_size < WS_END) { fprintf(stderr, "kernel_launch: unexpected sizes n_in %d out %d ws %zu (need %zu)\n", n_in, out_size, ws_size, (size_t)WS_END); grid = -1; return; }
        int dev = 0, cus = 0, per_cu = 0;
        hipGetDevice(&dev); hipDeviceGetAttribute(&cus, hipDeviceAttributeMultiprocessorCount, dev);
        if (hipFuncSetAttribute((const void*)fwd_kernel, hipFuncAttributeMaxDynamicSharedMemorySize, LDS_BYTES) != hipSuccess) { fprintf(stderr, "kernel_launch: hipFuncSetAttribute failed\n"); grid = -1; return; }
        hipOccupancyMaxActiveBlocksPerMultiprocessor(&per_cu, (const void*)fwd_kernel, NTHR, LDS_BYTES);
        (void)hipGetLastError();
        if (per_cu < 1) fprintf(stderr, "kernel_launch: occupancy query says %d blocks per CU\n", per_cu);
        grid = cus;
    }
    if (grid < 0) return;
    Args a{};
    for (int i = 0; i < 25; ++i) a.in[i] = (const float*)d_in[i];
    a.out = (float*)d_out; a.ws = (unsigned char*)d_ws;
    a.ph_lo = 0; a.ph_hi = N_PHASES;
    void* args[] = {&a};
    hipError_t e = hipLaunchCooperativeKernel((const void*)fwd_kernel, dim3(grid), dim3(NTHR), args, LDS_BYTES, stream);
    if (e != hipSuccess) fprintf(stderr, "cooperative launch failed: %s (grid %d)\n", hipGetErrorString(e), grid);

}
```

```cpp
#include <hip/hip_runtime.h>
#include <cstdio>
#include <cstdint>
namespace pg8 {
#define PG8_LAS __attribute__((address_space(3)))
typedef unsigned short bf16_t;
typedef short bf16x8 __attribute__((ext_vector_type(8)));
typedef float f32x4 __attribute__((ext_vector_type(4)));
typedef unsigned u32x4 __attribute__((ext_vector_type(4)));
constexpr int BM = 256, BK = 64, HALF = 128, HTB = HALF * BK * 2  , STAGE_BYTES = 8 * HTB, NXCD = 8, WGM = 8;

__host__ __device__ __forceinline__ int lds_byte(int r, int c) { const int st = (r >> 4) * 2 + (c >> 5), rr = r & 15, cc = c & 31, ob = rr * 64 + cc * 2; return st * 1024 + (ob ^ (((ob >> 9) & 1) << 5)); }
__host__ __device__ __forceinline__ void stage_rc(int b, int& R, int& C) { const int st = b / 1024, sb = b % 1024, swz = sb ^ (((sb >> 9) & 1) << 5); R = (st >> 1) * 16 + swz / 64; C = (st & 1) * 32 + (swz % 64) / 2; }
__host__ __device__ __forceinline__ int perm32(int rho) { const int n = rho >> 4, i = rho & 15; return 8 * (i >> 2) + 4 * n + (i & 3); }

struct Unit { int pm, pn, kofs, nt, part; };
struct Gemm { const bf16_t* A; const bf16_t* Bt; int M, N, K, lda, ldb, a_pn_off; float* part; };

struct StaticOrder {
    int nM, nN, nwg, G, c, ntf;
    __host__ __device__ void init(int M, int N, int K, int G_, int c_) { nM = M / BM; nN = N / BM; nwg = nM * nN; G = G_; c = c_; ntf = K / BK; }
    __host__ __device__ bool next(int i, Unit& u) const {
        const long L = (long)i * G + c; if (L >= nwg) return false;
        int wgid = (int)L; { const int q = nwg / NXCD, r = nwg % NXCD, xcd = wgid % NXCD, off = wgid / NXCD; wgid = (xcd < r ? xcd * (q + 1) : r * (q + 1) + (xcd - r) * q) + off; }
        const int nig = WGM * nN, gid = wgid / nig, fm = gid * WGM, gsz = (nM - fm) < WGM ? (nM - fm) : WGM;
        u.pm = fm + ((wgid % nig) % gsz); u.pn = (wgid % nig) / gsz; u.kofs = 0; u.nt = ntf; u.part = -1; return true;
    }
    __device__ __forceinline__ void a_ready(const Unit&) const {}
    __device__ __forceinline__ void done(const Unit&) const {}
};


struct SplitOrder {
    StaticOrder so; int S, G, c;
    __host__ __device__ void init(int K, int G_, int c_) { so.init(16384, 1024, K, G_, c_); S = K / 256; G = G_; c = c_; }
    __host__ __device__ bool next(int i, Unit& u) const {
        const int np = (c < 16 * S) ? 1 : 0;
        if (i < np) { const int tile = c / S, sp = c % S; u.pm = 64 + (tile >> 2); u.pn = tile & 3; u.kofs = sp * 512; u.nt = 4; u.part = sp; return true; }
        const long L = (long)(i - np) * G + c;
        if (L < 256) { StaticOrder t = so; t.c = (int)L; t.G = 0; return t.next(0, u); }
        const int j = (int)(L - 256) + ((G < 16 * S) ? G : 16 * S);
        if (j >= 16 * S || G >= 16 * S) return false;
        const int tile = j / S, sp = j % S;
        u.pm = 64 + (tile >> 2); u.pn = tile & 3; u.kofs = sp * 512; u.nt = 4; u.part = sp; return true;
    }
    __device__ __forceinline__ void a_ready(const Unit&) const {}
    __device__ __forceinline__ void done(const Unit&) const {}
};

__device__ __forceinline__ unsigned cvt_pk_bf16(float lo, float hi) { unsigned r; asm volatile("v_cvt_pk_bf16_f32 %0, %1, %2" : "=v"(r) : "v"(lo), "v"(hi)); return r; }
typedef float f32x2 __attribute__((ext_vector_type(2)));
__device__ __forceinline__ float bf_lo(unsigned w) { return __uint_as_float(w << 16); }
__device__ __forceinline__ float bf_hi(unsigned w) { return __uint_as_float(w & 0xffff0000u); }
__device__ __forceinline__ float silu_f(float g) { return g * __builtin_amdgcn_rcpf(1.0f + __expf(-g)); }
__device__ __forceinline__ float sigm_f(float g) { return __builtin_amdgcn_rcpf(1.0f + __expf(-g)); }
__device__ __forceinline__ float rstd16(const float* ssq, int row) {
    const f32x4* p = (const f32x4*)(ssq + (size_t)row * 16);
    const f32x4 a = p[0], b = p[1], c = p[2], d = p[3];
    const float s = ((a[0] + a[1]) + (a[2] + a[3])) + ((b[0] + b[1]) + (b[2] + b[3])) + ((c[0] + c[1]) + (c[2] + c[3])) + ((d[0] + d[1]) + (d[2] + d[3]));
    return __builtin_amdgcn_rsqf(s * (1.0f / 1024.0f) + 1e-6f);
}
struct EpiSwiGLU {
    static constexpr bool PERM = true, AFTER_DRAIN = false, KSEG = false, PREF = true;
    bf16_t* O; const float* rstd;
    __device__ __forceinline__ void operator()(const f32x4 (&acc)[2][2][4][2], const Unit& u, int wr, int wc, int fr, int fq, const PG8_LAS float* epl) const {
        float rsv[2][4];
#pragma unroll
        for (int ai = 0; ai < 2; ++ai)
#pragma unroll
            for (int m = 0; m < 4; ++m) rsv[ai][m] = epl[ai * HALF + wr * 64 + m * 16 + fr];
#pragma unroll
        for (int ai = 0; ai < 2; ++ai)
#pragma unroll
            for (int m = 0; m < 4; ++m) {
                const int row = u.pm * BM + ai * HALF + wr * 64 + m * 16 + fr;
                const float rs = rsv[ai][m];
                const f32x4 g0 = acc[ai][0][m][0] * rs, g1 = acc[ai][0][m][1] * rs, u0 = acc[ai][1][m][0] * rs, u1 = acc[ai][1][m][1] * rs;
                u32x4 w;
                w.x = cvt_pk_bf16(silu_f(g0[0]) * u0[0], silu_f(g0[1]) * u0[1]); w.y = cvt_pk_bf16(silu_f(g0[2]) * u0[2], silu_f(g0[3]) * u0[3]);
                w.z = cvt_pk_bf16(silu_f(g1[0]) * u1[0], silu_f(g1[1]) * u1[1]); w.w = cvt_pk_bf16(silu_f(g1[2]) * u1[2], silu_f(g1[3]) * u1[3]);
                *(u32x4*)(O + (size_t)row * 2816 + u.pn * 128 + wc * 32 + fq * 8) = w;
            }
    }
};
template <bool BASE_BF16, bool WRITE_X, bool WRITE_XB, bool SCALED = false> struct EpiResid {
    static constexpr bool PERM = true, AFTER_DRAIN = false, KSEG = false, PREF = false;
    const float* baseP; const float* baseS;
    float* X; bf16_t* XB; float* ssq; float scale;
    __device__ __forceinline__ void operator()(const f32x4 (&acc)[2][2][4][2], const Unit& u, int wr, int wc, int fr, int fq) const {
        const float* base = (u.pm < 64) ? baseP : baseS;
#pragma unroll
        for (int ai = 0; ai < 2; ++ai) {
            f32x4 bv[4][2][2];
            float rinv[4];
#pragma unroll
            for (int m = 0; m < 4; ++m) rinv[m] = SCALED ? baseP[u.pm * BM + ai * HALF + wr * 64 + m * 16 + fr] : 1.0f;
#pragma unroll
            for (int m = 0; m < 4; ++m) { const size_t off = (size_t)(u.pm * BM + ai * HALF + wr * 64 + m * 16 + fr) * 1024 + u.pn * BM + wc * 32 + fq * 8;
#pragma unroll
                for (int bj = 0; bj < 2; ++bj) {
                    if constexpr (BASE_BF16) { const u32x4 w = *(const u32x4*)(XB + off + bj * HALF);
                        bv[m][bj][0] = (f32x4){bf_lo(w.x), bf_hi(w.x), bf_lo(w.y), bf_hi(w.y)}; bv[m][bj][1] = (f32x4){bf_lo(w.z), bf_hi(w.z), bf_lo(w.w), bf_hi(w.w)};
                        if constexpr (SCALED) { bv[m][bj][0] *= rinv[m]; bv[m][bj][1] *= rinv[m]; } }
                    else { bv[m][bj][0] = *(const f32x4*)(base + off + bj * HALF); bv[m][bj][1] = *(const f32x4*)(base + off + bj * HALF + 4); } } }
#pragma unroll
            for (int m = 0; m < 4; ++m) {
                const int row = u.pm * BM + ai * HALF + wr * 64 + m * 16 + fr;
                const size_t off = (size_t)row * 1024 + u.pn * BM + wc * 32 + fq * 8;
                float s = 0.f;
#pragma unroll
                for (int bj = 0; bj < 2; ++bj) {
                    const f32x4 v0 = bv[m][bj][0] + acc[ai][bj][m][0] * scale, v1 = bv[m][bj][1] + acc[ai][bj][m][1] * scale;
                    if constexpr (WRITE_X) { *(f32x4*)(X + off + bj * HALF) = v0; *(f32x4*)(X + off + bj * HALF + 4) = v1; }
                    if constexpr (WRITE_XB) { u32x4 w; w.x = cvt_pk_bf16(v0[0], v0[1]); w.y = cvt_pk_bf16(v0[2], v0[3]); w.z = cvt_pk_bf16(v1[0], v1[1]); w.w = cvt_pk_bf16(v1[2], v1[3]);
                        *(u32x4*)(XB + off + bj * HALF) = w;
                        s += (v0[0] * v0[0] + v0[1] * v0[1]) + (v0[2] * v0[2] + v0[3] * v0[3]) + (v1[0] * v1[0] + v1[1] * v1[1]) + (v1[2] * v1[2] + v1[3] * v1[3]); }
                }
                if constexpr (WRITE_XB) { s += __shfl_xor(s, 16); s += __shfl_xor(s, 32); if (fq == 0) ssq[(size_t)row * 16 + u.pn * 4 + wc] = s; }
            }
        }
    }
};
struct EpiInProj {
    static constexpr bool PERM = true, AFTER_DRAIN = false, KSEG = false, PREF = true;
    bf16_t* U; bf16_t* Z; bf16_t* XBC; bf16_t* GL; float* DT; const float* dt_bias; const float* rstd;
    __device__ __forceinline__ void operator()(const f32x4 (&acc)[2][2][4][2], const Unit& u, int wr, int wc, int fr, int fq, const PG8_LAS float* epl) const {
        bf16_t* O; int ldc, colt;
        if (u.pn < 4) { O = U; ldc = 1024; colt = u.pn * 256; }
        else if (u.pn < 12) { O = Z; ldc = 2048; colt = (u.pn - 4) * 256; }
        else if (u.pn < 24) { O = XBC; ldc = 3072; colt = (u.pn - 12) * 256; }
        else { O = GL; ldc = 2048; colt = (u.pn - 24) * 256; }
        const bool isdt = (u.pn == 32);
        float rsv[2][4];
#pragma unroll
        for (int ai = 0; ai < 2; ++ai)
#pragma unroll
            for (int m = 0; m < 4; ++m) rsv[ai][m] = epl[ai * HALF + wr * 64 + m * 16 + fr];
#pragma unroll
        for (int ai = 0; ai < 2; ++ai)
#pragma unroll
            for (int m = 0; m < 4; ++m) {
                const int row = u.pm * BM + ai * HALF + wr * 64 + m * 16 + fr;
                const float rs = rsv[ai][m];
                if (!isdt) {
#pragma unroll
                    for (int bj = 0; bj < 2; ++bj) {
                        const f32x4 v0 = acc[ai][bj][m][0] * rs, v1 = acc[ai][bj][m][1] * rs;
                        u32x4 w; w.x = cvt_pk_bf16(v0[0], v0[1]); w.y = cvt_pk_bf16(v0[2], v0[3]); w.z = cvt_pk_bf16(v1[0], v1[1]); w.w = cvt_pk_bf16(v1[2], v1[3]);
                        *(u32x4*)(O + (size_t)row * ldc + colt + bj * HALF + wc * 32 + fq * 8) = w;
                    }
                } else if (wc == 0) {
                    const int c = fq * 8;
                    const f32x4 bb0 = *(const f32x4*)(dt_bias + c), bb1 = *(const f32x4*)(dt_bias + c + 4);
                    f32x4 v0 = acc[ai][0][m][0] * rs + bb0, v1 = acc[ai][0][m][1] * rs + bb1;
#pragma unroll
                    for (int i = 0; i < 4; ++i) { v0[i] = v0[i] > 20.f ? v0[i] : log1pf(__expf(v0[i])); v1[i] = v1[i] > 20.f ? v1[i] : log1pf(__expf(v1[i])); }
                    *(f32x4*)(DT + (size_t)row * 32 + c) = v0; *(f32x4*)(DT + (size_t)row * 32 + c + 4) = v1;
                }
            }
    }
};
struct EpiPlain {
    static constexpr bool PERM = true, AFTER_DRAIN = false, KSEG = false, PREF = false;
    bf16_t* O;
    __device__ __forceinline__ void operator()(const f32x4 (&acc)[2][2][4][2], const Unit& u, int wr, int wc, int fr, int fq) const {
#pragma unroll
        for (int ai = 0; ai < 2; ++ai)
#pragma unroll
            for (int m = 0; m < 4; ++m) {
                const int row = u.pm * BM + ai * HALF + wr * 64 + m * 16 + fr;
#pragma unroll
                for (int bj = 0; bj < 2; ++bj) {
                    const f32x4 v0 = acc[ai][bj][m][0], v1 = acc[ai][bj][m][1];
                    u32x4 w; w.x = cvt_pk_bf16(v0[0], v0[1]); w.y = cvt_pk_bf16(v0[2], v0[3]); w.z = cvt_pk_bf16(v1[0], v1[1]); w.w = cvt_pk_bf16(v1[2], v1[3]);
                    *(u32x4*)(O + (size_t)row * 1024 + u.pn * BM + bj * HALF + wc * 32 + fq * 8) = w;
                }
            }
    }
};
struct EpiMerge {
    static constexpr bool PERM = true, AFTER_DRAIN = false, KSEG = true, PREF = false;
    const bf16_t* GL; const bf16_t* BP; bf16_t* O; const float* RAT;
    __device__ __forceinline__ void kseg(f32x4 (&acc)[2][2][4][2], const Unit& u, int g, int wr, int fr) const {
        if (u.pm >= 64) return;
        const float* rp = RAT + (size_t)(u.pm * BM + wr * 64 + fr) * 4 + g;
#pragma unroll
        for (int ai = 0; ai < 2; ++ai) {
            float f[4];
#pragma unroll
            for (int m = 0; m < 4; ++m) f[m] = rp[(ai * HALF + m * 16) * 4];
#pragma unroll
            for (int m = 0; m < 4; ++m)
#pragma unroll
                for (int bj = 0; bj < 2; ++bj) { acc[ai][bj][m][0] *= f[m]; acc[ai][bj][m][1] *= f[m]; }
        }
    }
    __device__ __forceinline__ void operator()(const f32x4 (&acc)[2][2][4][2], const Unit& u, int wr, int wc, int fr, int fq) const {
#pragma unroll
        for (int ai = 0; ai < 2; ++ai)
#pragma unroll
            for (int mp = 0; mp < 2; ++mp) {
                u32x4 g0v[2][2], g1v[2][2], bpv[2][2];
                float r3v[2];
#pragma unroll
                for (int mm = 0; mm < 2; ++mm) r3v[mm] = (u.pm < 64) ? RAT[(size_t)(u.pm * BM + ai * HALF + wr * 64 + (2 * mp + mm) * 16 + fr) * 4 + 3] : 1.0f;
#pragma unroll
                for (int mm = 0; mm < 2; ++mm) { const int row = u.pm * BM + ai * HALF + wr * 64 + (2 * mp + mm) * 16 + fr;
#pragma unroll
                    for (int bj = 0; bj < 2; ++bj) { const int col = u.pn * BM + bj * HALF + wc * 32 + fq * 8;
                        g0v[mm][bj] = *(const u32x4*)(GL + (size_t)row * 2048 + col); g1v[mm][bj] = *(const u32x4*)(GL + (size_t)row * 2048 + 1024 + col); bpv[mm][bj] = *(const u32x4*)(BP + (size_t)row * 1024 + col); } }
#pragma unroll
                for (int mm = 0; mm < 2; ++mm) { const int m = 2 * mp + mm; const int row = u.pm * BM + ai * HALF + wr * 64 + m * 16 + fr;
#pragma unroll
                    for (int bj = 0; bj < 2; ++bj) {
                        const int col = u.pn * BM + bj * HALF + wc * 32 + fq * 8;
                        const u32x4 g0 = g0v[mm][bj], g1 = g1v[mm][bj], bp = bpv[mm][bj];
                        const f32x4 a0 = acc[ai][bj][m][0] * r3v[mm], a1 = acc[ai][bj][m][1] * r3v[mm];
                        u32x4 w;
                        w.x = cvt_pk_bf16(sigm_f(bf_lo(g0.x)) * bf_lo(bp.x) + sigm_f(bf_lo(g1.x)) * a0[0], sigm_f(bf_hi(g0.x)) * bf_hi(bp.x) + sigm_f(bf_hi(g1.x)) * a0[1]);
                        w.y = cvt_pk_bf16(sigm_f(bf_lo(g0.y)) * bf_lo(bp.y) + sigm_f(bf_lo(g1.y)) * a0[2], sigm_f(bf_hi(g0.y)) * bf_hi(bp.y) + sigm_f(bf_hi(g1.y)) * a0[3]);
                        w.z = cvt_pk_bf16(sigm_f(bf_lo(g0.z)) * bf_lo(bp.z) + sigm_f(bf_lo(g1.z)) * a1[0], sigm_f(bf_hi(g0.z)) * bf_hi(bp.z) + sigm_f(bf_hi(g1.z)) * a1[1]);
                        w.w = cvt_pk_bf16(sigm_f(bf_lo(g0.w)) * bf_lo(bp.w) + sigm_f(bf_lo(g1.w)) * a1[2], sigm_f(bf_hi(g0.w)) * bf_hi(bp.w) + sigm_f(bf_hi(g1.w)) * a1[3]);
                        *(u32x4*)(O + (size_t)row * 1024 + col) = w;
                    } }
            }
    }
};

template <class Epi, class Sched, bool ALIGN_EPI = false, bool SP2 = false>
__device__ __forceinline__ void gemm_phase(PG8_LAS unsigned char* lds, const Gemm g, const Sched& S, const Epi& E) {
    const int tid = threadIdx.x, wid = __builtin_amdgcn_readfirstlane(tid >> 6), lane = tid & 63, wr = wid >> 2, wc = wid & 3, fr = lane & 15, fq = lane >> 4;
    const int K = g.K; (void)K;
    unsigned voffA[2], voffB[2];
#pragma unroll
    for (int i = 0; i < 2; ++i) { int R, C; stage_rc(tid * 16 + i * 8192, R, C); const int Rb = Epi::PERM ? ((R & ~31) + perm32(R & 31)) : R;
        voffA[i] = (unsigned)(R * g.lda + C) * 2u; voffB[i] = (unsigned)(Rb * g.ldb + C) * 2u; }
    const size_t kstep = (size_t)(BK * 2);
    const size_t hstepA = (size_t)HALF * g.lda * 2, hstepB = (size_t)HALF * g.ldb * 2;
    const size_t tstepA = 2 * hstepA, tstepB = 2 * hstepB; const size_t pnoffA = (size_t)g.a_pn_off * 2;
    const unsigned ldsw = (unsigned)wid * 1024u;
    const int aoff = lds_byte(wr * 64 + fr, fq * 8), boff = lds_byte(wc * 32 + fr, fq * 8);
#define PG8_SA(b, h) (((b) * 2 + (h)) * HTB)
#define PG8_SB(b, h) ((4 + (b) * 2 + (h)) * HTB)
#define PG8_STAGE(bufoff, gbase, voff) do { _Pragma("unroll") for (int _i = 0; _i < 2; ++_i) \
        __builtin_amdgcn_global_load_lds((const unsigned*)((const char*)(gbase) + (voff)[_i]), (PG8_LAS unsigned*)(lds + (bufoff) + ldsw + _i * 8192), 16, 0, 0); } while (0)
#define PG8_LDA(dst, b, h) do { _Pragma("unroll") for (int m = 0; m < 4; ++m) _Pragma("unroll") for (int k = 0; k < 2; ++k) dst[m][k] = *(const PG8_LAS bf16x8*)(lds + PG8_SA(b, h) + aoff + m * 2048 + k * 1024); } while (0)
#define PG8_LDB(dst, b, h) do { _Pragma("unroll") for (int n = 0; n < 2; ++n) _Pragma("unroll") for (int k = 0; k < 2; ++k) dst[n][k] = *(const PG8_LAS bf16x8*)(lds + PG8_SB(b, h) + boff + n * 2048 + k * 1024); } while (0)
#define PG8_MMA(ai, bj, At, Bt) do { __builtin_amdgcn_s_setprio(1); _Pragma("unroll") for (int m = 0; m < 4; ++m) _Pragma("unroll") for (int n = 0; n < 2; ++n) _Pragma("unroll") for (int k = 0; k < 2; ++k) \
        acc[ai][bj][m][n] = __builtin_amdgcn_mfma_f32_16x16x32_bf16(Bt[n][k], At[m][k], acc[ai][bj][m][n], 0, 0, 0); __builtin_amdgcn_s_setprio(0); } while (0)
#define PG8_WAIT_V(n) asm volatile("s_waitcnt vmcnt(" #n ")" ::: "memory")
#define PG8_WAIT_L(n) asm volatile("s_waitcnt lgkmcnt(" #n ")" ::: "memory")
#define PG8_BAR __builtin_amdgcn_s_barrier()
#define PG8_SCHED __builtin_amdgcn_sched_barrier(0)
    Unit cur, nxt; int ui = 0;
    if (!S.next(0, cur)) return;
    f32x4 acc[2][2][4][2];
#pragma unroll
    for (int a = 0; a < 2; ++a)
#pragma unroll
        for (int b = 0; b < 2; ++b)
#pragma unroll
            for (int m = 0; m < 4; ++m)
#pragma unroll
                for (int n = 0; n < 2; ++n) acc[a][b][m][n] = (f32x4){0.f, 0.f, 0.f, 0.f};
    bf16x8 At[4][2], B0[2][2], B1[2][2];
    const char* cA = (const char*)g.A + (size_t)cur.pm * tstepA + (size_t)cur.pn * pnoffA + cur.kofs; const char* cB = (const char*)g.Bt + (size_t)cur.pn * tstepB + cur.kofs;
    S.a_ready(cur);
    if constexpr (SP2) {
        PG8_STAGE(PG8_SB(0, 0), cB, voffB); PG8_STAGE(PG8_SB(0, 1), cB + hstepB, voffB); PG8_STAGE(PG8_SA(0, 0), cA, voffA); PG8_STAGE(PG8_SA(0, 1), cA + hstepA, voffA);
        if (wr == 1) PG8_BAR;
        PG8_WAIT_V(2); PG8_BAR;
        PG8_STAGE(PG8_SB(1, 0), cB + kstep, voffB); PG8_STAGE(PG8_SA(1, 0), cA + kstep, voffA); PG8_STAGE(PG8_SB(1, 1), cB + hstepB + kstep, voffB);
        PG8_WAIT_V(6); PG8_BAR;
    } else {
        PG8_STAGE(PG8_SB(0, 0), cB, voffB); PG8_STAGE(PG8_SA(0, 0), cA, voffA); PG8_STAGE(PG8_SB(0, 1), cB + hstepB, voffB); PG8_STAGE(PG8_SA(0, 1), cA + hstepA, voffA);
        if (wr == 1) PG8_BAR;
        PG8_WAIT_V(4); PG8_BAR;
        PG8_STAGE(PG8_SB(1, 0), cB + kstep, voffB); PG8_STAGE(PG8_SA(1, 0), cA + kstep, voffA); PG8_STAGE(PG8_SB(1, 1), cB + hstepB + kstep, voffB);
        PG8_WAIT_V(6); PG8_BAR;
    }
    for (;;) {
        const bool has_next = S.next(ui + 1, nxt);
        const char* nA = has_next ? (const char*)g.A + (size_t)nxt.pm * tstepA + (size_t)nxt.pn * pnoffA + nxt.kofs : cA; const char* nB = has_next ? (const char*)g.Bt + (size_t)nxt.pn * tstepB + nxt.kofs : cB;
        const int nt = cur.nt;
        PG8_LAS float* epl = (PG8_LAS float*)(lds + 131072 + 2048) + (ui & 1) * 256;
        float epv = 1.0f;
        if constexpr (Epi::PREF) { if (cur.part < 0 && wid < 4 && E.rstd) epv = E.rstd[cur.pm * BM + tid]; }
        for (int t = 0; t < nt; t += 2) {
            const bool last = (t == nt - 2);
            const char* a1 = cA + (size_t)(t + 1) * kstep;
            const char* a2 = last ? nA : cA + (size_t)(t + 2) * kstep; const char* b2 = last ? nB : cB + (size_t)(t + 2) * kstep;
            const char* a3 = a2 + kstep; const char* b3 = b2 + kstep;
            if (last && has_next) S.a_ready(nxt);
            if constexpr (Epi::PREF) { if (last && cur.part < 0 && wid < 4) epl[tid] = epv; }
            if constexpr (SP2) {
            PG8_LDB(B0, 0, 0); PG8_LDB(B1, 0, 1); PG8_SCHED; PG8_LDA(At, 0, 0); PG8_STAGE(PG8_SA(1, 1), a1 + hstepA, voffA);
            PG8_WAIT_V(8); PG8_WAIT_L(0); PG8_BAR; PG8_MMA(0, 0, At, B0); PG8_MMA(0, 1, At, B1); PG8_BAR; PG8_SCHED;
            PG8_LDA(At, 0, 1); PG8_STAGE(PG8_SB(0, 0), b2, voffB); PG8_STAGE(PG8_SB(0, 1), b2 + hstepB, voffB); PG8_STAGE(PG8_SA(0, 0), a2, voffA);
            PG8_WAIT_V(8); PG8_WAIT_L(0); PG8_BAR; PG8_MMA(1, 0, At, B0); PG8_MMA(1, 1, At, B1); PG8_BAR; PG8_SCHED;
            PG8_LDB(B0, 1, 0); PG8_LDB(B1, 1, 1); PG8_SCHED; PG8_LDA(At, 1, 0); PG8_STAGE(PG8_SA(0, 1), a2 + hstepA, voffA);
            PG8_WAIT_V(8); PG8_WAIT_L(0); PG8_BAR; PG8_MMA(0, 0, At, B0); PG8_MMA(0, 1, At, B1); PG8_BAR; PG8_SCHED;
            PG8_LDA(At, 1, 1); PG8_STAGE(PG8_SB(1, 0), b3, voffB); PG8_STAGE(PG8_SB(1, 1), b3 + hstepB, voffB); PG8_STAGE(PG8_SA(1, 0), a3, voffA);
            PG8_WAIT_V(8); PG8_WAIT_L(0); PG8_BAR; PG8_MMA(1, 0, At, B0); PG8_MMA(1, 1, At, B1); PG8_BAR; PG8_SCHED;
            } else {
            PG8_LDB(B0, 0, 0); PG8_SCHED; PG8_LDA(At, 0, 0); PG8_STAGE(PG8_SA(1, 1), a1 + hstepA, voffA);
            PG8_WAIT_L(8); PG8_BAR; PG8_WAIT_L(0); PG8_MMA(0, 0, At, B0); PG8_BAR; PG8_SCHED;
            PG8_LDB(B1, 0, 1); PG8_STAGE(PG8_SB(0, 0), b2, voffB);
            PG8_BAR; PG8_WAIT_L(0); PG8_MMA(0, 1, At, B1); PG8_BAR;
            PG8_LDA(At, 0, 1); PG8_STAGE(PG8_SA(0, 0), a2, voffA);
            PG8_BAR; PG8_WAIT_L(0); PG8_MMA(1, 0, At, B0); PG8_BAR; PG8_SCHED;
            PG8_STAGE(PG8_SB(0, 1), b2 + hstepB, voffB);
            PG8_WAIT_V(6); PG8_BAR; PG8_MMA(1, 1, At, B1); PG8_BAR;
            PG8_LDB(B0, 1, 0); PG8_SCHED; PG8_LDA(At, 1, 0); PG8_STAGE(PG8_SA(0, 1), a2 + hstepA, voffA);
            PG8_WAIT_L(8); PG8_BAR; PG8_WAIT_L(0); PG8_MMA(0, 0, At, B0); PG8_BAR; PG8_SCHED;
            PG8_LDB(B1, 1, 1); PG8_STAGE(PG8_SB(1, 0), b3, voffB);
            PG8_BAR; PG8_WAIT_L(0); PG8_MMA(0, 1, At, B1); PG8_BAR;
            PG8_LDA(At, 1, 1); PG8_STAGE(PG8_SA(1, 0), a3, voffA);
            PG8_BAR; PG8_WAIT_L(0); PG8_MMA(1, 0, At, B0); PG8_BAR; PG8_SCHED;
            PG8_STAGE(PG8_SB(1, 1), b3 + hstepB, voffB);
            PG8_WAIT_V(6); PG8_BAR; PG8_MMA(1, 1, At, B1); PG8_BAR;
            }
            if constexpr (Epi::KSEG) { if (cur.part < 0 && ((t + 2) & 7) == 0 && (t + 2) < nt) E.kseg(acc, cur, ((t + 2) >> 3) - 1, wr, fr); }
        }
        if constexpr (ALIGN_EPI) { if (wr == 0) PG8_BAR; }
        if constexpr (!Epi::AFTER_DRAIN) {
            if (cur.part >= 0) {
                static_assert(Epi::PERM, "partial store assumes the PERM column layout");
#pragma unroll
                for (int ai = 0; ai < 2; ++ai)
#pragma unroll
                    for (int m = 0; m < 4; ++m) { bf16_t* pp = (bf16_t*)g.part + ((size_t)cur.part * 1024 + (cur.pm - 64) * BM + ai * HALF + wr * 64 + m * 16 + fr) * 1024 + cur.pn * BM + wc * 32 + fq * 8;
#pragma unroll
                        for (int bj = 0; bj < 2; ++bj) { const f32x4 v0 = acc[ai][bj][m][0], v1 = acc[ai][bj][m][1]; u32x4 w; w.x = cvt_pk_bf16(v0[0], v0[1]); w.y = cvt_pk_bf16(v0[2], v0[3]); w.z = cvt_pk_bf16(v1[0], v1[1]); w.w = cvt_pk_bf16(v1[2], v1[3]); *(u32x4*)(pp + bj * HALF) = w; } }
            } else { if constexpr (Epi::PREF) E(acc, cur, wr, wc, fr, fq, epl); else E(acc, cur, wr, wc, fr, fq); }
            S.done(cur); }
        if (!has_next) break;
#pragma unroll
        for (int a = 0; a < 2; ++a)
#pragma unroll
            for (int b = 0; b < 2; ++b)
#pragma unroll
                for (int m = 0; m < 4; ++m)
#pragma unroll
                    for (int n = 0; n < 2; ++n) acc[a][b][m][n] = (f32x4){0.f, 0.f, 0.f, 0.f};
        cur = nxt; cA = nA; cB = nB; ++ui;
        if constexpr (ALIGN_EPI) { if (wr == 1) PG8_BAR; }
    }
    PG8_WAIT_V(0);
    if constexpr (!ALIGN_EPI) { if (wr == 0) PG8_BAR; }
    PG8_BAR;
    if constexpr (Epi::AFTER_DRAIN) { E.fused(acc, cur, wr, wc, fr, fq, lds, wid, lane); S.done(cur); }
#undef PG8_SA
#undef PG8_SB
#undef PG8_STAGE
#undef PG8_LDA
#undef PG8_LDB
#undef PG8_MMA
#undef PG8_WAIT_V
#undef PG8_WAIT_L
#undef PG8_BAR
#undef PG8_SCHED
}
}

#include <hip/hip_cooperative_groups.h>
namespace cg = cooperative_groups;
#ifndef ONE_LAUNCH
#define ONE_LAUNCH 1
#endif
#define LAS __attribute__((address_space(3)))
typedef unsigned short bf16;
typedef unsigned u32x4 __attribute__((ext_vector_type(4)));
typedef unsigned u32x2 __attribute__((ext_vector_type(2)));
typedef float f32x4 __attribute__((ext_vector_type(4)));
typedef short bf16x8 __attribute__((ext_vector_type(8)));
constexpr int NWAVES = 8, NTHR = 512;
constexpr int MP = 16384, MS = 1024, M = MP + MS;
constexpr int D = 1024, FF = 2816, NPROJ = 8224, NPROJ_PAD = 8448;
constexpr float EPS = 1e-6f;
constexpr int N_PHASES = 11;
constexpr size_t O_Y = 0, O_PP = 17825792, O_CP = 17948672, O_SP = 18022400, O_PS = 20119552, O_CS = 22085632, O_SS = 23265280, O_END = 56819712;
constexpr size_t MiB = 1u << 20;
constexpr size_t WS_W1A = 0, WS_W1B = 11 * MiB, WS_WIN = WS_W1B + 5632 * 1024, WS_WPG = WS_WIN + (size_t)NPROJ_PAD * 1024 * 2, WS_WPO = WS_WPG + 512 * 1024, WS_WSO = WS_WPO + 2 * MiB,
                 WS_WO = WS_WSO + 4 * MiB, WS_W2A = WS_WO + 2 * MiB, WS_W2B = WS_W2A + 11 * MiB, WS_WEND = WS_W2B + 5632 * 1024;
constexpr size_t SZ1K = (size_t)M * 1024 * 2, SZ2K = 2 * SZ1K, SZ3K = 3 * SZ1K;
constexpr size_t WS_SMALL = 58 * MiB;
constexpr size_t WS_SSQ = WS_SMALL, WS_DT = WS_SSQ + (size_t)M * 16 * 4, WS_RSTD = WS_DT + (size_t)M * 32 * 4, WS_RAT = WS_RSTD + (size_t)M * 4, WS_SMALL_END = WS_RAT + (size_t)MP * 16;
constexpr size_t WS_XB = 62 * MiB;
constexpr size_t WS_RA = WS_XB + SZ1K;
constexpr size_t WS_RB = WS_RA + SZ3K;
constexpr size_t WS_RC = WS_RB + SZ3K;
constexpr size_t WS_RD = WS_RC + SZ1K;
constexpr size_t WS_RE = WS_RD + SZ2K;
constexpr size_t WS_RF = WS_RE + SZ2K;
constexpr size_t WS_CTL = WS_RF + SZ1K, CTL_BYTES = 16384;
constexpr size_t WS_WEFF = WS_CTL + CTL_BYTES;
constexpr size_t WS_END = WS_WEFF + 2 * MiB;
static_assert(WS_WEND <= WS_SMALL && WS_SMALL_END <= WS_XB && WS_END <= 512 * MiB, "d_ws map");
constexpr int LDS_BYTES = 145408;
constexpr int LDS_MISC_OFF = 144384;

__device__ __forceinline__ unsigned f2bf(float f) { unsigned u = __float_as_uint(f); return (u + 0x7fffu + ((u >> 16) & 1u)) >> 16; }
typedef float f32x2_t __attribute__((ext_vector_type(2))); typedef __bf16 bf16x2_t __attribute__((ext_vector_type(2)));
__device__ __forceinline__ unsigned pk2(float lo, float hi) { f32x2_t v = {lo, hi}; bf16x2_t b = __builtin_convertvector(v, bf16x2_t); return __builtin_bit_cast(unsigned, b); }
__device__ __forceinline__ float bflo(unsigned w) { return __uint_as_float(w << 16); }
__device__ __forceinline__ float bfhi(unsigned w) { return __uint_as_float(w & 0xffff0000u); }
__device__ __forceinline__ float bf2f(bf16 v) { return __uint_as_float((unsigned)v << 16); }
__device__ __forceinline__ float wave_sum(float v) {
#pragma unroll
    for (int o = 1; o < 64; o <<= 1) v += __shfl_xor(v, o);
    return v;
}
#define LDS_WAIT() asm volatile("s_waitcnt lgkmcnt(0)" ::: "memory")
#define LDS_BARRIER() do { asm volatile("s_waitcnt lgkmcnt(0)" ::: "memory"); __builtin_amdgcn_s_barrier(); asm volatile("" ::: "memory"); } while (0)
struct F8 { float v[8]; };
__device__ __forceinline__ F8 unpack8(u32x4 w) { F8 r; r.v[0] = bflo(w.x); r.v[1] = bfhi(w.x); r.v[2] = bflo(w.y); r.v[3] = bfhi(w.y); r.v[4] = bflo(w.z); r.v[5] = bfhi(w.z); r.v[6] = bflo(w.w); r.v[7] = bfhi(w.w); return r; }
__device__ __forceinline__ u32x4 pack8(const F8& a) { u32x4 w; w.x = pk2(a.v[0], a.v[1]); w.y = pk2(a.v[2], a.v[3]); w.z = pk2(a.v[4], a.v[5]); w.w = pk2(a.v[6], a.v[7]); return w; }
__device__ __forceinline__ F8 loadf8(const float* p) { const f32x4 a = *(const f32x4*)p, b = *(const f32x4*)(p + 4); F8 r; r.v[0] = a[0]; r.v[1] = a[1]; r.v[2] = a[2]; r.v[3] = a[3]; r.v[4] = b[0]; r.v[5] = b[1]; r.v[6] = b[2]; r.v[7] = b[3]; return r; }
__device__ __forceinline__ void storef8(float* p, const F8& a) { *(f32x4*)p = (f32x4){a.v[0], a.v[1], a.v[2], a.v[3]}; *(f32x4*)(p + 4) = (f32x4){a.v[4], a.v[5], a.v[6], a.v[7]}; }
__device__ __forceinline__ F8 zero8() { F8 r;
#pragma unroll
    for (int i = 0; i < 8; ++i) r.v[i] = 0.f;
    return r; }

struct Args { const float* in[25]; float* out; unsigned char* ws; int ph_lo, ph_hi; };
enum { I_XP = 0, I_XS, I_SPOOL, I_SCONV, I_SSSM, I_NF1, I_F1IN, I_F1OUT, I_NMIX, I_WIN, I_PWG, I_PSC, I_PWO, I_CW, I_CB, I_DTB, I_ALOG, I_DSKIP, I_SNORM, I_SWO, I_WO, I_NF2, I_F2IN, I_F2OUT, I_NFIN };

__device__ __forceinline__ void p0_item(const float* W, int K, int N, bf16* WT, int row_off, int mode, const float* gain, LAS float* scr, int item, int lane) {
    const int nblk = N / 32, kb = item / nblk, nb = item % nblk, k0 = 64 * kb, n0 = 32 * nb;
    const float gv = gain ? gain[k0 + lane] : 1.0f;
    float wv[32];
#pragma unroll
    for (int i = 0; i < 32; ++i) { const int kk = 2 * i + (lane >> 5); wv[i] = __builtin_nontemporal_load(W + (size_t)(k0 + kk) * N + n0 + (lane & 31)); }
#pragma unroll
    for (int i = 0; i < 32; ++i) { const int kk = 2 * i + (lane >> 5); scr[kk * 33 + (lane & 31)] = wv[i] * __shfl(gv, kk); }
    LDS_WAIT(); asm volatile("" ::: "memory");
    int dr = n0;
    if (mode == 1) { if (n0 < FF) dr = (n0 >> 7) * 256 + (n0 & 127); else { const int j = n0 - FF; dr = (j >> 7) * 256 + 128 + (j & 127); } }
    else if (mode == 2) { if (n0 >= 6176) dr = n0 - 32; else if (n0 >= 6144) dr = 8192 + (n0 - 6144); }
    const int c = lane & 7;
#pragma unroll
    for (int j = 0; j < 4; ++j) { const int n = (lane >> 3) + 8 * j; const LAS float* s = scr + (8 * c) * 33 + n;
        u32x4 o; o.x = pk2(s[0 * 33], s[1 * 33]); o.y = pk2(s[2 * 33], s[3 * 33]); o.z = pk2(s[4 * 33], s[5 * 33]); o.w = pk2(s[6 * 33], s[7 * 33]);
        *(u32x4*)(WT + (size_t)(row_off + dr + n) * K + k0 + 8 * c) = o; }
    LDS_WAIT(); asm volatile("" ::: "memory");
}
__device__ __forceinline__ void phase0(const Args& a, LAS unsigned char* lds, int G, int tid) {
    const int lane = tid & 63, wave = __builtin_amdgcn_readfirstlane(tid >> 6);
    LAS float* scr = (LAS float*)(lds + wave * 16384);
    const int gw = blockIdx.x * NWAVES + wave, NGW = G * NWAVES;
    unsigned char* ws = a.ws;
    constexpr int I1A = 16 * 176, I1B = 44 * 32, IIN = 16 * 257, IPG = 4 * 32, IPO = 16 * 32, ISO = 32 * 32, IWO = 16 * 32;
    constexpr int NITEMS = 2 * I1A + 2 * I1B + IIN + IPO + ISO + IWO; (void)IPG;
    for (int it = gw; it < NITEMS; it += NGW) {
        int r = it;
        if (r < I1A) { p0_item(a.in[I_F1IN], D, 2 * FF, (bf16*)(ws + WS_W1A), 0, 1, a.in[I_NF1], scr, r, lane); continue; } r -= I1A;
        if (r < I1A) { p0_item(a.in[I_F2IN], D, 2 * FF, (bf16*)(ws + WS_W2A), 0, 1, a.in[I_NF2], scr, r, lane); continue; } r -= I1A;
        if (r < IIN) { p0_item(a.in[I_WIN], D, NPROJ, (bf16*)(ws + WS_WIN), 0, 2, a.in[I_NMIX], scr, r, lane); continue; } r -= IIN;
        if (r < I1B) { p0_item(a.in[I_F1OUT], FF, D, (bf16*)(ws + WS_W1B), 0, 0, nullptr, scr, r, lane); continue; } r -= I1B;
        if (r < I1B) { p0_item(a.in[I_F2OUT], FF, D, (bf16*)(ws + WS_W2B), 0, 0, nullptr, scr, r, lane); continue; } r -= I1B;
        if (r < IPO) { p0_item(a.in[I_PWO], D, D, (bf16*)(ws + WS_WPO), 0, 0, a.in[I_PSC], scr, r, lane); continue; } r -= IPO;
        if (r < ISO) { p0_item(a.in[I_SWO], 2048, D, (bf16*)(ws + WS_WSO), 0, 0, a.in[I_SNORM], scr, r, lane); continue; } r -= ISO;
        p0_item(a.in[I_WO], D, D, (bf16*)(ws + WS_WO), 0, 0, nullptr, scr, r, lane);
    }
    { const float* wg = a.in[I_PWG]; u32x4* o = (u32x4*)(ws + WS_WPG);
      for (int i = blockIdx.x * NTHR + tid; i < 262144 / 8; i += G * NTHR) o[i] = pack8(loadf8(wg + (size_t)i * 8)); }
    { u32x4* z = (u32x4*)(ws + WS_WIN + (size_t)NPROJ * 1024 * 2); const int n16 = (NPROJ_PAD - NPROJ) * 1024 * 2 / 16;
      for (int i = blockIdx.x * NTHR + tid; i < n16; i += G * NTHR) z[i] = (u32x4){0u, 0u, 0u, 0u}; }
    bf16* XN = (bf16*)(ws + WS_XB);
    for (int m0 = gw * 2; m0 < M; m0 += NGW * 2) {
        const float* xrow = (m0 < MP) ? a.in[I_XP] + (size_t)m0 * D : a.in[I_XS] + (size_t)(m0 - MP) * D;
        const f32x4* xr = (const f32x4*)xrow + lane;
        f32x4 v[2][4]; float s[2] = {0.f, 0.f};
#pragma unroll
        for (int q = 0; q < 2; ++q)
#pragma unroll
            for (int j = 0; j < 4; ++j) v[q][j] = __builtin_nontemporal_load(xr + 256 * q + 64 * j);
#pragma unroll
        for (int q = 0; q < 2; ++q)
#pragma unroll
            for (int j = 0; j < 4; ++j) s[q] += (v[q][j][0] * v[q][j][0] + v[q][j][1] * v[q][j][1]) + (v[q][j][2] * v[q][j][2] + v[q][j][3] * v[q][j][3]);
#pragma unroll
        for (int q = 0; q < 2; ++q) { const float ms = wave_sum(s[q]) * (1.f / D) + EPS, rstd = __builtin_amdgcn_rsqf(ms);
            if (lane == 0) ((float*)(ws + WS_RSTD))[m0 + q] = ms * rstd;
            u32x2* o8 = (u32x2*)(XN + (size_t)(m0 + q) * D) + lane;
#pragma unroll
            for (int j = 0; j < 4; ++j) { u32x2 w; w.x = pk2(v[q][j][0] * rstd, v[q][j][1] * rstd); w.y = pk2(v[q][j][2] * rstd, v[q][j][3] * rstd); o8[64 * j] = w; } }
    }
}

__device__ __forceinline__ void phase4(const Args& a, int G, int tid) {
    unsigned char* ws = a.ws;
    const bf16* U = (const bf16*)(ws + WS_RC); const bf16* XBC = (const bf16*)(ws + WS_RA);
    bf16* Dp = (bf16*)(ws + WS_RF); bf16* XC = (bf16*)(ws + WS_RB);
    const float* spool = a.in[I_SPOOL]; const float* sconv = a.in[I_SCONV];
    const int gt = blockIdx.x * NTHR + tid, NT = G * NTHR;
    for (int u = gt; u < 65536 + 16384; u += NT) {
        const bool smp = u >= 65536; int b, t0, nrows, slab;
        if (!smp) { slab = u & 127; t0 = ((u >> 7) & 63) * 32; b = u >> 13; nrows = 32; }
        else { const int v = u - 65536; slab = v & 127; b = v >> 7; t0 = 0; nrows = 8; }
        const int c0 = slab * 8, w = 2 << (c0 >> 8);
        const size_t rowbase = smp ? (size_t)MP + b * 8 : (size_t)b * 2048;
        const bf16* Ub = U + rowbase * 1024 + c0; const float* hb = spool + ((size_t)b * 15 + 15) * 1024 + c0;
        F8 s = zero8();
        for (int j = 1; j < w; ++j) {
            const int i = t0 - j;
            if (i >= 0) { const F8 x = unpack8(*(const u32x4*)(Ub + (ptrdiff_t)i * 1024));
#pragma unroll
                for (int e = 0; e < 8; ++e) s.v[e] += x.v[e]; }
            else if (smp) { const F8 x = loadf8(hb + (ptrdiff_t)i * 1024);
#pragma unroll
                for (int e = 0; e < 8; ++e) s.v[e] += x.v[e]; }
        }
        for (int tb = t0; tb < t0 + nrows; tb += 8) {
            u32x4 curw[8]; F8 oldv[8];
#pragma unroll
            for (int k = 0; k < 8; ++k) curw[k] = *(const u32x4*)(Ub + (size_t)(tb + k) * 1024);
#pragma unroll
            for (int k = 0; k < 8; ++k) { const int i = tb + k - w + 1;
                if (i >= 0) oldv[k] = unpack8(*(const u32x4*)(Ub + (ptrdiff_t)i * 1024));
                else if (smp) oldv[k] = loadf8(hb + (ptrdiff_t)i * 1024);
                else oldv[k] = zero8(); }
#pragma unroll
            for (int k = 0; k < 8; ++k) {
                const int t = tb + k; const F8 cur = unpack8(curw[k]);
                const float icnt = 1.0f / (smp ? (float)w : (float)((t + 1 < w) ? t + 1 : w));
                F8 d;
#pragma unroll
                for (int e = 0; e < 8; ++e) { s.v[e] += cur.v[e]; d.v[e] = s.v[e] * icnt - cur.v[e]; s.v[e] -= oldv[k].v[e]; }
                *(u32x4*)(Dp + (rowbase + t) * 1024 + c0) = pack8(d);
            }
        }
    }
    const float* cw = a.in[I_CW]; const float* cb = a.in[I_CB];
    for (int u = gt; u < 196608 + 49152; u += NT) {
        const bool smp = u >= 196608; int b, t0, nrows, slab;
        if (!smp) { slab = u % 384; const int q = u / 384; t0 = (q & 63) * 32; b = q >> 6; nrows = 32; }
        else { const int v = u - 196608; slab = v % 384; b = v / 384; t0 = 0; nrows = 8; }
        const int c0 = slab * 8;
        const size_t rowbase = smp ? (size_t)MP + b * 8 : (size_t)b * 2048;
        const F8 w0 = loadf8(cw + c0), w1 = loadf8(cw + 3072 + c0), w2 = loadf8(cw + 6144 + c0), w3 = loadf8(cw + 9216 + c0), bi = loadf8(cb + c0);
        F8 xm3, xm2, xm1;
        if (smp) { xm3 = loadf8(sconv + ((size_t)b * 3 + 0) * 3072 + c0); xm2 = loadf8(sconv + ((size_t)b * 3 + 1) * 3072 + c0); xm1 = loadf8(sconv + ((size_t)b * 3 + 2) * 3072 + c0); }
        else if (t0 == 0) { xm3 = zero8(); xm2 = zero8(); xm1 = zero8(); }
        else { xm3 = unpack8(*(const u32x4*)(XBC + (rowbase + t0 - 3) * 3072 + c0)); xm2 = unpack8(*(const u32x4*)(XBC + (rowbase + t0 - 2) * 3072 + c0)); xm1 = unpack8(*(const u32x4*)(XBC + (rowbase + t0 - 1) * 3072 + c0)); }
        for (int tb = t0; tb < t0 + nrows; tb += 8) {
            u32x4 curw[8];
#pragma unroll
            for (int k = 0; k < 8; ++k) curw[k] = *(const u32x4*)(XBC + (rowbase + tb + k) * 3072 + c0);
#pragma unroll
            for (int k = 0; k < 8; ++k) {
                const F8 cur = unpack8(curw[k]);
                F8 y;
#pragma unroll
                for (int e = 0; e < 8; ++e) { const float v = bi.v[e] + xm3.v[e] * w0.v[e] + xm2.v[e] * w1.v[e] + xm1.v[e] * w2.v[e] + cur.v[e] * w3.v[e]; y.v[e] = v * __builtin_amdgcn_rcpf(1.0f + __expf(-v)); }
                *(u32x4*)(XC + (rowbase + tb + k) * 3072 + c0) = pack8(y);
                xm3 = xm2; xm2 = xm1; xm1 = cur;
            }
        }
    }
    for (int u = gt; u < (8 + 128) * 15 * 128; u += NT) {
        const int slab = u & 127, rj = u >> 7, c0 = slab * 8;
        if (rj < 120) { const int b = rj / 15, j = rj % 15;
            storef8(a.out + O_PP + ((size_t)b * 15 + j) * 1024 + c0, unpack8(*(const u32x4*)(U + ((size_t)b * 2048 + 2033 + j) * 1024 + c0))); }
        else { const int r2 = rj - 120, b = r2 / 15, j = r2 % 15;
            const F8 v = (j < 7) ? loadf8(spool + ((size_t)b * 15 + 8 + j) * 1024 + c0) : unpack8(*(const u32x4*)(U + ((size_t)MP + b * 8 + (j - 7)) * 1024 + c0));
            storef8(a.out + O_PS + ((size_t)b * 15 + j) * 1024 + c0, v); }
    }
    for (int u = gt; u < (8 + 128) * 3 * 384; u += NT) {
        const int slab = u % 384, rj = u / 384, c0 = slab * 8;
        if (rj < 24) { const int b = rj / 3, j = rj % 3;
            storef8(a.out + O_CP + ((size_t)b * 3 + j) * 3072 + c0, unpack8(*(const u32x4*)(XBC + ((size_t)b * 2048 + 2045 + j) * 3072 + c0))); }
        else { const int r2 = rj - 24, b = r2 / 3, j = r2 % 3;
            storef8(a.out + O_CS + ((size_t)b * 3 + j) * 3072 + c0, unpack8(*(const u32x4*)(XBC + ((size_t)MP + b * 8 + 5 + j) * 3072 + c0))); }
    }
}

#define MFMA16(p, q, c) __builtin_amdgcn_mfma_f32_16x16x32_bf16((p), (q), (c), 0, 0, 0)
constexpr int LDW = 136;
constexpr int LDX = 72;
typedef short v4i16_t __attribute__((ext_vector_type(4)));
__device__ __forceinline__ unsigned cvtpk(float lo, float hi) { f32x2_t v = {lo, hi}; bf16x2_t b = __builtin_convertvector(v, bf16x2_t); return __builtin_bit_cast(unsigned, b); }
__device__ __forceinline__ bf16x8 tr_frag(const LAS bf16* T, int pitch, int k0, int i0, int lane) {
    const int j = lane & 15, q = j >> 2, p = j & 3;
    const LAS bf16* ap = T + (k0 + q) * pitch + i0 + 4 * p;
    const v4i16_t lo = __builtin_amdgcn_ds_read_tr16_b64_v4i16((LAS v4i16_t*)ap), hi = __builtin_amdgcn_ds_read_tr16_b64_v4i16((LAS v4i16_t*)(ap + 4 * pitch));
    return (bf16x8){lo[0], lo[1], lo[2], lo[3], hi[0], hi[1], hi[2], hi[3]};
}
__device__ __forceinline__ void ssd_prompt_unit(LAS unsigned char* lds, int b, int h, const bf16* __restrict__ XC, const float* __restrict__ DT, const bf16* __restrict__ Z, bf16* __restrict__ YG, const float* a_log, const float* d_skip, float* __restrict__ out_ssm, float* __restrict__ SSQ2, int tid) {
    const int wave = __builtin_amdgcn_readfirstlane(tid >> 6), lane = tid & 63, l16 = lane & 15, quad = lane >> 4, g = h >> 3;
    LAS bf16* Cs = (LAS bf16*)lds;
    LAS bf16* Bs = Cs + 128 * LDW;
    LAS bf16* Xd = Bs + 128 * LDW;
    LAS bf16* Xw = Xd + 128 * LDX;
    LAS bf16* Hb = Xw + 128 * LDX;
    LAS float* acsb = (LAS float*)(Hb + 64 * LDW);
    LAS float* dtsb = acsb + 256;
    LAS bf16* HbB = (LAS bf16*)(dtsb + 256);
    const float A = -__expf(a_log[h]), Dh = d_skip[h];
    f32x4 hacc[4];
#pragma unroll
    for (int pt = 0; pt < 4; ++pt) hacc[pt] = (f32x4){0.f, 0.f, 0.f, 0.f};
    for (int i = tid; i < 64 * LDW / 2; i += NTHR) ((LAS unsigned*)Hb)[i] = 0u;
    const int lrow = 16 * wave + l16;
    u32x4 cgv[4], bgv[4], xgv[2]; float d0, d1;
    { const size_t row0 = (size_t)b * 2048;
#pragma unroll
      for (int i = 0; i < 4; ++i) { const int idx = tid + NTHR * i, l = idx >> 4, seg = idx & 15; const bf16* rp = XC + (row0 + l) * 3072 + g * 128 + seg * 8; cgv[i] = *(const u32x4*)(rp + 2560); bgv[i] = *(const u32x4*)(rp + 2048); }
#pragma unroll
      for (int i = 0; i < 2; ++i) { const int idx = tid + NTHR * i, l = idx >> 3, seg = idx & 7; xgv[i] = *(const u32x4*)(XC + (row0 + l) * 3072 + h * 64 + seg * 8); }
      d0 = DT[(row0 + lane) * 32 + h]; d1 = DT[(row0 + 64 + lane) * 32 + h]; }
#define WALK_SCAN(buf) do { if (wave == 0) { float a0_ = d0 * A, a1_ = d1 * A; \
        _Pragma("unroll") for (int o = 1; o < 64; o <<= 1) { const float t0_ = __shfl_up(a0_, o), t1_ = __shfl_up(a1_, o); if (lane >= o) { a0_ += t0_; a1_ += t1_; } } \
        a1_ += __shfl(a0_, 63); \
        acsb[(buf) * 128 + lane] = a0_; acsb[(buf) * 128 + 64 + lane] = a1_; dtsb[(buf) * 128 + lane] = d0; dtsb[(buf) * 128 + 64 + lane] = d1; } } while (0)
    WALK_SCAN(0);
    for (int c = 0; c < 16; ++c) {
        const size_t row0 = (size_t)b * 2048 + c * 128;
        LAS float* acs = acsb + (c & 1) * 128; LAS float* dts = dtsb + (c & 1) * 128;
        LDS_BARRIER();
        const float a_end = acs[127];
#pragma unroll
        for (int i = 0; i < 4; ++i) { const int idx = tid + NTHR * i, l = idx >> 4, seg = idx & 15;
            *(LAS u32x4*)(Cs + l * LDW + seg * 8) = cgv[i]; *(LAS u32x4*)(Bs + l * LDW + seg * 8) = bgv[i]; }
#pragma unroll
        for (int i = 0; i < 2; ++i) { const int idx = tid + NTHR * i, l = idx >> 3, seg = idx & 7;
            const float dtl = dts[l], wl = dtl * __expf(a_end - acs[l]); const F8 x = unpack8(xgv[i]);
            u32x4 wd, ww;
            wd.x = cvtpk(x.v[0] * dtl, x.v[1] * dtl); wd.y = cvtpk(x.v[2] * dtl, x.v[3] * dtl); wd.z = cvtpk(x.v[4] * dtl, x.v[5] * dtl); wd.w = cvtpk(x.v[6] * dtl, x.v[7] * dtl);
            ww.x = cvtpk(x.v[0] * wl, x.v[1] * wl); ww.y = cvtpk(x.v[2] * wl, x.v[3] * wl); ww.z = cvtpk(x.v[4] * wl, x.v[5] * wl); ww.w = cvtpk(x.v[6] * wl, x.v[7] * wl);
            *(LAS u32x4*)(Xd + l * LDX + seg * 8) = wd; *(LAS u32x4*)(Xw + l * LDX + seg * 8) = ww; }
        u32x2 xe[4], ze[4];
        { const size_t row = row0 + lrow;
#pragma unroll
          for (int pt = 0; pt < 4; ++pt) { const int p0 = 16 * pt + 4 * quad; xe[pt] = *(const u32x2*)(XC + row * 3072 + h * 64 + p0); ze[pt] = *(const u32x2*)(Z + row * 2048 + h * 64 + p0); } }
        if (c < 15) { const size_t rown = row0 + 128;
#pragma unroll
            for (int i = 0; i < 4; ++i) { const int idx = tid + NTHR * i, l = idx >> 4, seg = idx & 15; const bf16* rp = XC + (rown + l) * 3072 + g * 128 + seg * 8; cgv[i] = *(const u32x4*)(rp + 2560); bgv[i] = *(const u32x4*)(rp + 2048); }
#pragma unroll
            for (int i = 0; i < 2; ++i) { const int idx = tid + NTHR * i, l = idx >> 3, seg = idx & 7; xgv[i] = *(const u32x4*)(XC + (rown + l) * 3072 + h * 64 + seg * 8); }
            d0 = DT[(rown + lane) * 32 + h]; d1 = DT[(rown + 64 + lane) * 32 + h]; }
        LDS_BARRIER();
        bf16x8 cf[4];
#pragma unroll
        for (int kk = 0; kk < 4; ++kk) cf[kk] = *(const LAS bf16x8*)(Cs + lrow * LDW + kk * 32 + quad * 8);
        const float acs_l = acs[lrow];
        f32x4 yo[4];
#pragma unroll
        for (int pt = 0; pt < 4; ++pt) { f32x4 t = (f32x4){0.f, 0.f, 0.f, 0.f};
#pragma unroll
            for (int kk = 0; kk < 4; ++kk) t = MFMA16(*(const LAS bf16x8*)(((c & 1) ? HbB : Hb) + (16 * pt + l16) * LDW + kk * 32 + quad * 8), cf[kk], t);
            yo[pt] = t; }
        const int nct = (wave | 1) + 1;
        for (int ct = 0; ct < nct; ++ct) {
            f32x4 t = (f32x4){0.f, 0.f, 0.f, 0.f};
            if (ct <= wave) {
#pragma unroll
                for (int kk = 0; kk < 4; ++kk) t = MFMA16(*(const LAS bf16x8*)(Bs + (16 * ct + l16) * LDW + kk * 32 + quad * 8), cf[kk], t);
                const f32x4 as = *(const LAS f32x4*)(acs + 16 * ct + 4 * quad);
#pragma unroll
                for (int r = 0; r < 4; ++r) { const int sidx = 16 * ct + 4 * quad + r; t[r] = (sidx <= lrow) ? t[r] * __expf(acs_l - as[r]) : 0.f; }
            }
            u32x2 w; w.x = cvtpk(t[0], t[1]); w.y = cvtpk(t[2], t[3]);
            *(LAS u32x2*)(Cs + lrow * LDW + 16 * ct + 4 * quad) = w;
        }
        f32x4 yd[4];
#pragma unroll
        for (int pt = 0; pt < 4; ++pt) yd[pt] = (f32x4){0.f, 0.f, 0.f, 0.f};
        const int nks = (wave >> 1) + 1;
        for (int ks = 0; ks < nks; ++ks) { const bf16x8 gq = *(const LAS bf16x8*)(Cs + lrow * LDW + ks * 32 + quad * 8);
#pragma unroll
            for (int pt = 0; pt < 4; ++pt) yd[pt] = MFMA16(tr_frag(Xd, LDX, ks * 32 + 8 * quad, 16 * pt, lane), gq, yd[pt]); }
        { const float el = __expf(acs_l); const size_t row = row0 + lrow; float sq = 0.f;
#pragma unroll
          for (int pt = 0; pt < 4; ++pt) { const int p0 = 16 * pt + 4 * quad;
              const float xv[4] = {bflo(xe[pt].x), bfhi(xe[pt].x), bflo(xe[pt].y), bfhi(xe[pt].y)}, zv[4] = {bflo(ze[pt].x), bfhi(ze[pt].x), bflo(ze[pt].y), bfhi(ze[pt].y)};
              float o[4];
#pragma unroll
              for (int r = 0; r < 4; ++r) { const float y = yd[pt][r] + el * yo[pt][r] + Dh * xv[r]; o[r] = y * (zv[r] * __builtin_amdgcn_rcpf(1.0f + __expf(-zv[r]))); }
              sq += (o[0] * o[0] + o[1] * o[1]) + (o[2] * o[2] + o[3] * o[3]);
              u32x2 w; w.x = cvtpk(o[0], o[1]); w.y = cvtpk(o[2], o[3]);
              *(u32x2*)(YG + row * 2048 + h * 64 + p0) = w; }
          sq += __shfl_xor(sq, 16); sq += __shfl_xor(sq, 32);
          if (quad == 0) SSQ2[row * 32 + h] = sq; }
        { const float cd = __expf(a_end);
          bf16x8 bfr[4];
#pragma unroll
          for (int kk = 0; kk < 4; ++kk) bfr[kk] = tr_frag(Bs, LDW, kk * 32 + 8 * quad, 16 * wave, lane);
#pragma unroll
          for (int pt = 0; pt < 4; ++pt) { f32x4 t = hacc[pt] * cd;
#pragma unroll
              for (int kk = 0; kk < 4; ++kk) t = MFMA16(bfr[kk], tr_frag(Xw, LDX, kk * 32 + 8 * quad, 16 * pt, lane), t);
              hacc[pt] = t;
              u32x2 w; w.x = cvtpk(t[0], t[1]); w.y = cvtpk(t[2], t[3]);
              *(LAS u32x2*)(((c & 1) ? Hb : HbB) + (16 * pt + l16) * LDW + 16 * wave + 4 * quad) = w; } }
        if (c < 15) WALK_SCAN((c + 1) & 1);
    }
#undef WALK_SCAN
#pragma unroll
    for (int pt = 0; pt < 4; ++pt) *(f32x4*)(out_ssm + ((size_t)(b * 32 + h) * 64 + 16 * pt + l16) * 128 + 16 * wave + 4 * quad) = hacc[pt];
    __syncthreads();
}
constexpr int SST_BYTES = 8192;
__device__ __forceinline__ u32x4 ss_piece(int uu, int tid, const bf16* __restrict__ XC, const float* __restrict__ DT, const bf16* __restrict__ Z) {
    const int b = uu >> 5, h = uu & 31, g = h >> 3; const size_t rowb = (size_t)MP + b * 8; u32x4 pc = (u32x4){0u, 0u, 0u, 0u};
    if (tid < 256) { const int t = tid >> 5, ch = tid & 31; pc = *(const u32x4*)(XC + (rowb + t) * 3072 + 2048 + (ch >> 4) * 512 + g * 128 + (ch & 15) * 8); }
    else if (tid < 320) { const int q = tid - 256, t = q >> 3, ch = q & 7; pc = *(const u32x4*)(XC + (rowb + t) * 3072 + h * 64 + ch * 8); }
    else if (tid < 384) { const int q = tid - 320, t = q >> 3, ch = q & 7; pc = *(const u32x4*)(Z + (rowb + t) * 2048 + h * 64 + ch * 8); }
    else if (tid < 392) { pc.x = __float_as_uint(DT[(rowb + (tid - 384)) * 32 + h]); }
    return pc;
}
__device__ __forceinline__ void ss_stage(LAS unsigned char* st, int tid, u32x4 pc) {
    if (tid < 256) *(LAS u32x4*)(st + (tid >> 5) * 512 + (tid & 31) * 16) = pc;
    else if (tid < 320) *(LAS u32x4*)(st + 4096 + (tid - 256) * 16) = pc;
    else if (tid < 384) *(LAS u32x4*)(st + 5120 + (tid - 320) * 16) = pc;
    else if (tid < 392) *(LAS unsigned*)(st + 6144 + (tid - 384) * 4) = pc.x;
}
__device__ __forceinline__ void ss_state_load(int uu, int tid, const float* __restrict__ st_in, f32x4 (&hv)[4]) {
    const size_t so = ((size_t)uu * 64 + (tid >> 3)) * 128 + (tid & 7) * 16;
#pragma unroll
    for (int j = 0; j < 4; ++j) hv[j] = *(const f32x4*)(st_in + so + 4 * j);
}
__device__ __forceinline__ void ss_compute(const LAS unsigned char* st, int uu, int tid, f32x4 (&hv)[4], const float* a_log, const float* d_skip, bf16* __restrict__ YG, float* __restrict__ st_out) {
    const int p = tid >> 3, nq = tid & 7, b = uu >> 5, h = uu & 31; const size_t rowb = (size_t)MP + b * 8;
    const float A = -__expf(a_log[h]), Dh = d_skip[h];
    float yo = 0.f;
#pragma unroll 2
    for (int t = 0; t < 8; ++t) {
        const float dt = *(const LAS float*)(st + 6144 + t * 4), dA = __expf(dt * A);
        const float xv = bf2f(*(const LAS bf16*)(st + 4096 + t * 128 + p * 2)), z = bf2f(*(const LAS bf16*)(st + 5120 + t * 128 + p * 2));
        const LAS unsigned char* bc = st + t * 512 + nq * 32;
        const u32x4 Bw0 = *(const LAS u32x4*)bc, Bw1 = *(const LAS u32x4*)(bc + 16), Cw0 = *(const LAS u32x4*)(bc + 256), Cw1 = *(const LAS u32x4*)(bc + 272);
        const float coef = dt * xv; f32x2_t y2 = {0.f, 0.f}; const f32x2_t dA2 = {dA, dA}, cf2 = {coef, coef};
#define SS_PAIR(j, lohi, bw, cw) do { f32x2_t h2 = {hv[j][2 * (lohi)], hv[j][2 * (lohi) + 1]}; const f32x2_t b2 = {bflo(bw), bfhi(bw)}, c2 = {bflo(cw), bfhi(cw)}; \
            h2 = h2 * dA2 + cf2 * b2; y2 += h2 * c2; hv[j][2 * (lohi)] = h2.x; hv[j][2 * (lohi) + 1] = h2.y; } while (0)
        SS_PAIR(0, 0, Bw0.x, Cw0.x); SS_PAIR(0, 1, Bw0.y, Cw0.y); SS_PAIR(1, 0, Bw0.z, Cw0.z); SS_PAIR(1, 1, Bw0.w, Cw0.w);
        SS_PAIR(2, 0, Bw1.x, Cw1.x); SS_PAIR(2, 1, Bw1.y, Cw1.y); SS_PAIR(3, 0, Bw1.z, Cw1.z); SS_PAIR(3, 1, Bw1.w, Cw1.w);
#undef SS_PAIR
        float y = y2.x + y2.y;
        y += __shfl_xor(y, 1); y += __shfl_xor(y, 2); y += __shfl_xor(y, 4);
        y += Dh * xv;
        const float yg = y * (z * __builtin_amdgcn_rcpf(1.0f + __expf(-z)));
        yo = (nq == t) ? yg : yo;
    }
    YG[(rowb + nq) * 2048 + h * 64 + p] = (bf16)f2bf(yo);
    const size_t so = ((size_t)uu * 64 + p) * 128 + nq * 16;
#pragma unroll
    for (int j = 0; j < 4; ++j) __builtin_nontemporal_store(hv[j], (f32x4*)(st_out + so + 4 * j));
}
__device__ __forceinline__ void ssd_sample_units(LAS unsigned char* lds, int G, const bf16* __restrict__ XC, const float* __restrict__ DT, const bf16* __restrict__ Z, bf16* __restrict__ YG, const float* a_log, const float* d_skip, const float* __restrict__ st_in, float* __restrict__ st_out, int tid_in) {
    int tid = tid_in; asm volatile("" : "+v"(tid));
    int u = blockIdx.x; if (u >= 4096) return;
    f32x4 hna[4], hnb[4]; u32x4 pa = ss_piece(u, tid, XC, DT, Z), pb = (u32x4){0u, 0u, 0u, 0u};
    ss_state_load(u, tid, st_in, hna);
    if (u + G < 4096) { pb = ss_piece(u + G, tid, XC, DT, Z); ss_state_load(u + G, tid, st_in, hnb); }
    for (int it = 0; u < 4096; ++it) {
        LAS unsigned char* st0 = lds + (it & 1) * (2 * SST_BYTES); LAS unsigned char* st1 = st0 + SST_BYTES;
        const bool hasb = u + G < 4096;
        f32x4 ha[4], hb[4];
#pragma unroll
        for (int j = 0; j < 4; ++j) { ha[j] = hna[j]; hb[j] = hnb[j]; }
        ss_stage(st0, tid, pa); if (hasb) ss_stage(st1, tid, pb);
        const int un = u + 2 * G;
        if (un < 4096) { pa = ss_piece(un, tid, XC, DT, Z); ss_state_load(un, tid, st_in, hna); }
        if (un + G < 4096) { pb = ss_piece(un + G, tid, XC, DT, Z); ss_state_load(un + G, tid, st_in, hnb); }
        LDS_BARRIER();
        ss_compute(st0, u, tid, ha, a_log, d_skip, YG, st_out);
        if (hasb) ss_compute(st1, u + G, tid, hb, a_log, d_skip, YG, st_out);
        u = un;
    }
    __syncthreads();
}

__device__ __forceinline__ void ssd_sample_units_mfma(LAS unsigned char* lds, int G, const bf16* __restrict__ XC, const float* __restrict__ DT, const bf16* __restrict__ Z, bf16* __restrict__ YG, const float* a_log, const float* d_skip, const float* __restrict__ st_in, float* __restrict__ st_out, int tid_in) {
    int tid = tid_in; asm volatile("" : "+v"(tid));
    const int wave = __builtin_amdgcn_readfirstlane(tid >> 6), lane = tid & 63, l16 = lane & 15, quad = lane >> 4;
    LAS bf16* Cs = (LAS bf16*)lds;
    LAS bf16* Bs = (LAS bf16*)(lds + 4352);
    LAS bf16* Xd = (LAS bf16*)(lds + 13056);
    LAS bf16* Xw = (LAS bf16*)(lds + 17664);
    LAS bf16* Hb = (LAS bf16*)(lds + 22272);
    LAS bf16* Gs = (LAS bf16*)(lds + 39680) + wave * 640;
    LAS float* acs = (LAS float*)(lds + 44800);
    LAS float* dts = acs + 16;
    for (int i = tid; i < 44800 / 4; i += NTHR) ((LAS unsigned*)lds)[i] = 0u;
    int u = blockIdx.x; if (u >= 4096) { __syncthreads(); return; }
    f32x4 hst[4]; u32x4 pc = (u32x4){0u, 0u, 0u, 0u}; u32x2 xe = (u32x2){0u, 0u}, ze = (u32x2){0u, 0u}; float dtv = 0.f;
#define SM_LOAD(uu) do { const int b_ = (uu) >> 5, h_ = (uu) & 31, g_ = h_ >> 3; const size_t rowb_ = (size_t)MP + b_ * 8; \
        _Pragma("unroll") for (int pt = 0; pt < 4; ++pt) hst[pt] = *(const f32x4*)(st_in + ((size_t)(uu) * 64 + 16 * pt + l16) * 128 + 16 * wave + 4 * quad); \
        if (tid < 128) pc = *(const u32x4*)(XC + (rowb_ + (tid >> 4)) * 3072 + 2560 + g_ * 128 + (tid & 15) * 8); \
        else if (tid < 256) pc = *(const u32x4*)(XC + (rowb_ + ((tid - 128) >> 4)) * 3072 + 2048 + g_ * 128 + (tid & 15) * 8); \
        else if (tid < 320) pc = *(const u32x4*)(XC + (rowb_ + ((tid - 256) >> 3)) * 3072 + h_ * 64 + (tid & 7) * 8); \
        else if (tid < 328) dtv = DT[(rowb_ + (tid - 320)) * 32 + h_]; \
        if (wave < 4) { xe = *(const u32x2*)(XC + (rowb_ + (l16 & 7)) * 3072 + h_ * 64 + 16 * wave + 4 * quad); ze = *(const u32x2*)(Z + (rowb_ + (l16 & 7)) * 2048 + h_ * 64 + 16 * wave + 4 * quad); } } while (0)
    SM_LOAD(u);
    __syncthreads();
    while (u < 4096) {
        const int b = u >> 5, h = u & 31; const size_t rowb = (size_t)MP + b * 8;
        const float A = -__expf(a_log[h]), Dh = d_skip[h];
        f32x4 hacc[4]; const u32x4 pcc = pc; const u32x2 xec = xe, zec = ze;
#pragma unroll
        for (int pt = 0; pt < 4; ++pt) { hacc[pt] = hst[pt]; u32x2 w; w.x = cvtpk(hacc[pt][0], hacc[pt][1]); w.y = cvtpk(hacc[pt][2], hacc[pt][3]);
            *(LAS u32x2*)(Hb + (16 * pt + l16) * LDW + 16 * wave + 4 * quad) = w; }
        if (wave == 5) {
            float a0 = (lane < 8) ? dtv * A : 0.f;
#pragma unroll
            for (int o = 1; o < 8; o <<= 1) { const float t0 = __shfl_up(a0, o); if (lane >= o) a0 += t0; }
            const float aend = __shfl(a0, 7);
            if (lane < 16) { acs[lane] = (lane < 8) ? a0 : aend; dts[lane] = (lane < 8) ? dtv : 0.f; }
        }
        LDS_BARRIER();
        const float a_end = acs[7];
        if (tid < 128) *(LAS u32x4*)(Cs + (tid >> 4) * LDW + (tid & 15) * 8) = pcc;
        else if (tid < 256) *(LAS u32x4*)(Bs + ((tid - 128) >> 4) * LDW + (tid & 15) * 8) = pcc;
        else if (tid < 320) { const int t = (tid - 256) >> 3, seg = tid & 7; const float dtl = dts[t], wl = dtl * __expf(a_end - acs[t]); const F8 x = unpack8(pcc);
            u32x4 wd, ww;
            wd.x = cvtpk(x.v[0] * dtl, x.v[1] * dtl); wd.y = cvtpk(x.v[2] * dtl, x.v[3] * dtl); wd.z = cvtpk(x.v[4] * dtl, x.v[5] * dtl); wd.w = cvtpk(x.v[6] * dtl, x.v[7] * dtl);
            ww.x = cvtpk(x.v[0] * wl, x.v[1] * wl); ww.y = cvtpk(x.v[2] * wl, x.v[3] * wl); ww.z = cvtpk(x.v[4] * wl, x.v[5] * wl); ww.w = cvtpk(x.v[6] * wl, x.v[7] * wl);
            *(LAS u32x4*)(Xd + t * LDX + seg * 8) = wd; *(LAS u32x4*)(Xw + t * LDX + seg * 8) = ww; }
        const int un = u + G;
        if (un < 4096) SM_LOAD(un);
        LDS_BARRIER();
        if (wave < 4) {
            const int pt = wave;
            bf16x8 cf[4];
#pragma unroll
            for (int kk = 0; kk < 4; ++kk) cf[kk] = *(const LAS bf16x8*)(Cs + l16 * LDW + kk * 32 + quad * 8);
            const float acs_l = acs[l16];
            f32x4 yo = (f32x4){0.f, 0.f, 0.f, 0.f}, sc = (f32x4){0.f, 0.f, 0.f, 0.f};
#pragma unroll
            for (int kk = 0; kk < 4; ++kk) yo = MFMA16(*(const LAS bf16x8*)(Hb + (16 * pt + l16) * LDW + kk * 32 + quad * 8), cf[kk], yo);
#pragma unroll
            for (int kk = 0; kk < 4; ++kk) sc = MFMA16(*(const LAS bf16x8*)(Bs + l16 * LDW + kk * 32 + quad * 8), cf[kk], sc);
            { const f32x4 as = *(const LAS f32x4*)(acs + 4 * quad);
#pragma unroll
              for (int r = 0; r < 4; ++r) { const int sidx = 4 * quad + r; sc[r] = (sidx <= l16) ? sc[r] * __expf(acs_l - as[r]) : 0.f; }
              u32x2 w; w.x = cvtpk(sc[0], sc[1]); w.y = cvtpk(sc[2], sc[3]);
              *(LAS u32x2*)(Gs + l16 * 40 + 4 * quad) = w; }
            const bf16x8 gq = *(const LAS bf16x8*)(Gs + l16 * 40 + quad * 8);
            f32x4 yd = (f32x4){0.f, 0.f, 0.f, 0.f};
            yd = MFMA16(tr_frag(Xd, LDX, 8 * quad, 16 * pt, lane), gq, yd);
            const float el = __expf(acs_l);
            const float xv[4] = {bflo(xec.x), bfhi(xec.x), bflo(xec.y), bfhi(xec.y)}, zv[4] = {bflo(zec.x), bfhi(zec.x), bflo(zec.y), bfhi(zec.y)};
            float o[4];
#pragma unroll
            for (int r = 0; r < 4; ++r) { const float y = yd[r] + el * yo[r] + Dh * xv[r]; o[r] = y * (zv[r] * __builtin_amdgcn_rcpf(1.0f + __expf(-zv[r]))); }
            u32x2 w; w.x = cvtpk(o[0], o[1]); w.y = cvtpk(o[2], o[3]);
            if (l16 < 8) *(u32x2*)(YG + (rowb + l16) * 2048 + h * 64 + 16 * pt + 4 * quad) = w;
        }
        {
            const float cd = __expf(a_end);
            const bf16x8 bfr = tr_frag(Bs, LDW, 8 * quad, 16 * wave, lane);
#pragma unroll
            for (int pt = 0; pt < 4; ++pt) { f32x4 t = hacc[pt] * cd; t = MFMA16(bfr, tr_frag(Xw, LDX, 8 * quad, 16 * pt, lane), t);
                __builtin_nontemporal_store(t, (f32x4*)(st_out + ((size_t)u * 64 + 16 * pt + l16) * 128 + 16 * wave + 4 * quad)); }
        }
        LDS_BARRIER();
        u = un;
    }
#undef SM_LOAD
    __syncthreads();
}

#define XB_TMO      128
#define XB_XCNT(j)  (256  + 64 * (j))
#define XB_XSUB(j)  (1280 + 64 * (j))
#define XB_XGEN(j)  (2304 + 64 * (j))
#define XB_TOP      3328
#define XB_TOPGEN   3392
#define XCD_BAR_WORDS 3456
#define XB_SPIN_CAP (1u << 18)

__device__ __forceinline__ unsigned xb_ld(unsigned* p)              { return __hip_atomic_load(p, __ATOMIC_RELAXED, __HIP_MEMORY_SCOPE_AGENT); }
__device__ __forceinline__ unsigned xb_add(unsigned* p, unsigned v) { return __hip_atomic_fetch_add(p, v, __ATOMIC_RELAXED, __HIP_MEMORY_SCOPE_AGENT); }
__device__ __forceinline__ unsigned xb_xcc_id() { return (unsigned)__builtin_amdgcn_s_getreg((3 << 11) | 20) & 0xFu; }
#define XB_SPIN(cond, bar) do { unsigned _sp = 0; while (cond) { __builtin_amdgcn_s_sleep(1); \
    if ((++_sp & 255u) == 0u) { if (xb_ld(&(bar)[XB_TMO])) break; if (_sp > XB_SPIN_CAP) { atomicAdd(&(bar)[XB_TMO], 1u); break; } } } } while (0)

struct XcdBarrier {
    unsigned* bar; unsigned x;
    volatile LAS unsigned* st;
};

__device__ __forceinline__ XcdBarrier xcd_barrier_post(unsigned* bar, volatile LAS unsigned* st) {
    XcdBarrier b; b.bar = bar; b.x = xb_xcc_id(); b.st = st;
    if (threadIdx.x == 0) (void)xb_add(&bar[XB_XCNT(b.x)], 1u);
    return b;
}
__device__ __forceinline__ void xcd_barrier_complete(unsigned* bar, unsigned x, unsigned& nloc, unsigned& nx) {
    const unsigned G = gridDim.x * gridDim.y * gridDim.z;
    unsigned sum, cnt, mine, sp = 0u;
    for (;;) {
        sum = 0u; cnt = 0u; mine = 0u;
#pragma unroll
        for (unsigned j = 0; j < 16; ++j) { const unsigned c = xb_ld(&bar[XB_XCNT(j)]); sum += c; cnt += (c > 0u) ? 1u : 0u; mine = (j == x) ? c : mine; }
        if (sum == G) break;
        __builtin_amdgcn_s_sleep(1);
        if ((++sp & 255u) == 0u) { if (xb_ld(&bar[XB_TMO])) break; if (sp > XB_SPIN_CAP) { atomicAdd(&bar[XB_TMO], 1u); break; } }
    }
    nloc = mine > 0u ? mine : 1u; nx = cnt > 0u ? cnt : 1u;
}

__device__ __forceinline__ void xcd_barrier(const XcdBarrier& b) {
    asm volatile("s_waitcnt vmcnt(0)" ::: "memory");
    __syncthreads();
    if (threadIdx.x == 0) {
        unsigned* bar = b.bar;
        __builtin_amdgcn_s_waitcnt(0);
        unsigned nloc = b.st[0], nx = b.st[1];
        if (nloc == 0u) { xcd_barrier_complete(bar, b.x, nloc, nx); b.st[0] = nloc; b.st[1] = nx; }
        const unsigned old = xb_add(&bar[XB_XSUB(b.x)], 1u);
        const unsigned gen = old / nloc;
        if (old + 1u == (gen + 1u) * nloc) {
            __builtin_amdgcn_fence(__ATOMIC_RELEASE, "agent");
            asm volatile("s_waitcnt vmcnt(0)" ::: "memory");
            const unsigned og = xb_add(&bar[XB_TOP], 1u);
            const unsigned tg = og / nx;
            if (og + 1u == (tg + 1u) * nx) xb_add(&bar[XB_TOPGEN], 1u);
            else XB_SPIN(xb_ld(&bar[XB_TOPGEN]) == tg, bar);
            __builtin_amdgcn_fence(__ATOMIC_ACQUIRE, "agent");
            xb_add(&bar[XB_XGEN(b.x)], 1u);
            asm volatile("s_waitcnt vmcnt(0)" ::: "memory");
        } else {
            XB_SPIN(xb_ld(&bar[XB_XGEN(b.x)]) == gen, bar);
            __builtin_amdgcn_fence(__ATOMIC_ACQUIRE, "agent");
            asm volatile("s_waitcnt vmcnt(0)" ::: "memory");
        }
    }
    __syncthreads();
}

template <int S> __device__ __forceinline__ F8 part_sum(const float* __restrict__ Pf, int r, int col) {
    const bf16* P = (const bf16*)Pf; u32x4 w[S];
#pragma unroll
    for (int k = 0; k < S; ++k) w[k] = *(const u32x4*)(P + ((size_t)k * 1024 + r) * 1024 + col);
    F8 s = unpack8(w[0]);
#pragma unroll
    for (int k = 1; k < S; ++k) { const F8 v = unpack8(w[k]);
#pragma unroll
        for (int e = 0; e < 8; ++e) s.v[e] += v.v[e]; }
    return s;
}
template <int S, bool BASE_BF16, bool WRITE_X, bool WRITE_XB, bool SCALED = false> __device__ __forceinline__ void pass_resid(const float* P, const float* base, float* X, bf16* XB, float* RSTD, float scale, int G, int wave, int lane) {
    for (int r = blockIdx.x * NWAVES + wave; r < MS; r += G * NWAVES) {
        const size_t row = (size_t)MP + r; float ss = 0.f; const float rinv = SCALED ? RSTD[row] : 1.0f;
#pragma unroll
        for (int hf = 0; hf < 2; ++hf) { const int col = hf * 512 + lane * 8;
            F8 b; if constexpr (BASE_BF16) b = unpack8(*(const u32x4*)(XB + row * 1024 + col)); else b = loadf8(base + row * 1024 + col);
            if constexpr (SCALED) {
#pragma unroll
                for (int e = 0; e < 8; ++e) b.v[e] *= rinv; }
            const F8 a = part_sum<S>(P, r, col); F8 v;
#pragma unroll
            for (int e = 0; e < 8; ++e) { v.v[e] = b.v[e] + scale * a.v[e]; ss += v.v[e] * v.v[e]; }
            if constexpr (WRITE_X) storef8(X + row * 1024 + col, v);
            if constexpr (WRITE_XB) *(u32x4*)(XB + row * 1024 + col) = pack8(v); }
        ss = wave_sum(ss);
        if (WRITE_XB && lane == 0) RSTD[row] = __builtin_amdgcn_rsqf(ss * (1.0f / 1024.0f) + EPS);
    }
}
template <int S> __device__ __forceinline__ void pass_final(const float* P, const bf16* XB, const float* gfin, float* Y, float scale, int G, int wave, int lane) {
    for (int r = blockIdx.x * NWAVES + wave; r < MS; r += G * NWAVES) {
        const size_t row = (size_t)MP + r; float ss = 0.f; F8 v[2];
#pragma unroll
        for (int hf = 0; hf < 2; ++hf) { const int col = hf * 512 + lane * 8;
            const F8 b = unpack8(*(const u32x4*)(XB + row * 1024 + col)), a = part_sum<S>(P, r, col);
#pragma unroll
            for (int e = 0; e < 8; ++e) { v[hf].v[e] = b.v[e] + scale * a.v[e]; ss += v[hf].v[e] * v[hf].v[e]; } }
        const float rstd = __builtin_amdgcn_rsqf(wave_sum(ss) * (1.0f / 1024.0f) + EPS);
#pragma unroll
        for (int hf = 0; hf < 2; ++hf) { const int col = hf * 512 + lane * 8; const F8 g = loadf8(gfin + col); F8 o;
#pragma unroll
            for (int e = 0; e < 8; ++e) o.v[e] = v[hf].v[e] * rstd * g.v[e];
            storef8(Y + row * 1024 + col, o); }
    }
}
__device__ __forceinline__ void pass_rstd_prompt(const float* SSQ, float* RSTD, int G, int tid) {
    for (int row = blockIdx.x * NTHR + tid; row < MP; row += G * NTHR) RSTD[row] = pg8::rstd16(SSQ, row);
}
template <int S> __device__ __forceinline__ void pass_merge(const float* P, const bf16* GL, const float* PP, bf16* O, int G, int wave, int lane) {
    for (int it = blockIdx.x * NWAVES + wave; it < 2 * MS; it += G * NWAVES) {
        const int r = it >> 1, hf = it & 1, col = hf * 512 + lane * 8; const size_t row = (size_t)MP + r;
        const F8 g0 = unpack8(*(const u32x4*)(GL + row * 2048 + col)), g1 = unpack8(*(const u32x4*)(GL + row * 2048 + 1024 + col)), bp = part_sum<4>(PP, r, col), a = part_sum<S>(P, r, col); F8 v;
#pragma unroll
        for (int e = 0; e < 8; ++e) v.v[e] = bp.v[e] * __builtin_amdgcn_rcpf(1.0f + __expf(-g0.v[e])) + a.v[e] * __builtin_amdgcn_rcpf(1.0f + __expf(-g1.v[e]));
        *(u32x4*)(O + row * 1024 + col) = pack8(v);
    }
}
template <int S> __device__ __forceinline__ void pass_plain(const float* P, bf16* O, int G, int wave, int lane) {
    for (int it = blockIdx.x * NWAVES + wave; it < 2 * MS; it += G * NWAVES) {
        const int r = it >> 1, hf = it & 1, col = hf * 512 + lane * 8; const size_t row = (size_t)MP + r;
        const F8 a = part_sum<S>(P, r, col); *(u32x4*)(O + row * 1024 + col) = pack8(a);
    }
}

__device__ unsigned g_bar[XCD_BAR_WORDS + 64];

__global__ void __launch_bounds__(NTHR, 2) fwd_kernel(Args a) {
    extern __shared__ __attribute__((aligned(16))) unsigned char lds_raw[];
    LAS unsigned char* lds = (LAS unsigned char*)lds_raw;
    const int tid = threadIdx.x, G = gridDim.x, lane = tid & 63, wave = __builtin_amdgcn_readfirstlane(tid >> 6);
    unsigned char* ws = a.ws;
    const int lo = a.ph_lo, hi = a.ph_hi;
    using namespace pg8;
    volatile LAS unsigned* MISC = (volatile LAS unsigned*)(lds + LDS_MISC_OFF);
    if (tid < 4) MISC[tid] = 0u;
    __syncthreads();
    const XcdBarrier bar = xcd_barrier_post((unsigned*)g_bar, MISC);
    bf16* XB = (bf16*)(ws + WS_XB); bf16* HID = (bf16*)(ws + WS_RA); float* SSQ = (float*)(ws + WS_SSQ); float* DT = (float*)(ws + WS_DT); float* RSTD = (float*)(ws + WS_RSTD);
    float* X = a.out + O_Y;
#ifndef PROBE_PHASE
#define PROBE_PHASE -1
#endif
#ifndef PROBE_AMP
#define PROBE_AMP 4
#endif
    unsigned long long tp0 = 0, tp1 = 0;
#define IN(k) ((((k) == PROBE_PHASE) ? (void)(tp0 = __builtin_amdgcn_s_memrealtime()) : (void)0), (lo <= (k) && (k) < hi))
#define SEAM(k) do { if ((k) + 1 < hi) { xcd_barrier(bar); } if ((k) == PROBE_PHASE) tp1 = __builtin_amdgcn_s_memrealtime(); } while (0)
    if (IN(0)) { phase0(a, lds, G, tid); SEAM(0); }
    if (IN(1)) {
        {
            Gemm gw{(const bf16_t*)(ws + WS_WPO), (const bf16_t*)(ws + WS_WPG), 1024, D, 256, D, 256, 256, nullptr}; StaticOrder Sw; Sw.init(1024, D, 256, 16, (int)blockIdx.x - (G - 16));
            if ((int)blockIdx.x >= G - 16) { EpiPlain Ew{(bf16*)(ws + WS_WEFF)}; gemm_phase<EpiPlain, StaticOrder, true, true>(lds, gw, Sw, Ew); }
        }
        Gemm g{XB, (const bf16_t*)(ws + WS_W1A), M, 2 * FF, D, D, D, 0, nullptr}; StaticOrder S; S.init(M, 2 * FF, D, G, (int)blockIdx.x);
        EpiSwiGLU E{HID, nullptr};
        gemm_phase<EpiSwiGLU, StaticOrder, true, true>(lds, g, S, E); SEAM(1);
    }
    if (IN(2)) {
        Gemm g{HID, (const bf16_t*)(ws + WS_W1B), M, D, FF, FF, FF, 0, (float*)(ws + WS_RD)}; SplitOrder S; S.init(FF, G, (int)blockIdx.x);
        typedef EpiResid<true, false, true, true> Epi2; Epi2 E{RSTD, RSTD, X, XB, SSQ, 0.5f};
        gemm_phase<Epi2, SplitOrder, true, true>(lds, g, S, E); xcd_barrier(bar);
        pass_resid<FF / 256, true, false, true, true>((const float*)(ws + WS_RD), nullptr, X, XB, RSTD, 0.5f, G, wave, lane); pass_rstd_prompt(SSQ, RSTD, G, tid); SEAM(2);
    }
    if (IN(3)) {
        Gemm g{XB, (const bf16_t*)(ws + WS_WIN), M, NPROJ_PAD, D, D, D, 0, nullptr}; StaticOrder S; S.init(M, NPROJ_PAD, D, G, (int)blockIdx.x);
        EpiInProj E{(bf16*)(ws + WS_RC), (bf16*)(ws + WS_RD), (bf16*)(ws + WS_RA), (bf16*)(ws + WS_RE), DT, a.in[I_DTB], RSTD};
        gemm_phase<EpiInProj, StaticOrder, true, true>(lds, g, S, E); SEAM(3);
    }
    if (IN(4)) { phase4(a, G, tid); SEAM(4); }
    if (IN(5)) {
        const bf16* XC = (const bf16*)(ws + WS_RB); const bf16* Z = (const bf16*)(ws + WS_RD); bf16* YG = (bf16*)(ws + WS_RA);
        if (PROBE_PHASE == 50) tp0 = __builtin_amdgcn_s_memrealtime();
        for (int u = blockIdx.x; u < 256; u += G) ssd_prompt_unit(lds, u >> 5, u & 31, XC, DT, Z, YG, a.in[I_ALOG], a.in[I_DSKIP], a.out + O_SP, (float*)(ws + WS_RC), tid);
        if (PROBE_PHASE == 50) tp1 = __builtin_amdgcn_s_memrealtime();
        if (PROBE_PHASE == 51) tp0 = __builtin_amdgcn_s_memrealtime();
        ssd_sample_units_mfma(lds, G, XC, DT, Z, YG, a.in[I_ALOG], a.in[I_DSKIP], a.in[I_SSSM], a.out + O_SS, tid);
        if (PROBE_PHASE == 51) tp1 = __builtin_amdgcn_s_memrealtime();
SEAM(5);
    }
    if (IN(6)) {
        Gemm g{(const bf16_t*)(ws + WS_RF), (const bf16_t*)(ws + WS_WEFF), M, D, D, D, D, 0, (float*)(ws + WS_RC + 4 * MiB)}; SplitOrder S; S.init(D, G, (int)blockIdx.x);
        EpiPlain E{(bf16*)(ws + WS_RB)};
        gemm_phase<EpiPlain, SplitOrder, true, true>(lds, g, S, E);
        bf16* YG = (bf16*)(ws + WS_RA);
        for (int u = MP * 4 + blockIdx.x * NWAVES + wave; u < M * 4; u += G * NWAVES) {
            u32x4* p = (u32x4*)(YG + (size_t)u * 512) + lane; F8 v = unpack8(*p); float sq = 0.f;
#pragma unroll
            for (int e = 0; e < 8; ++e) sq += v.v[e] * v.v[e];
            const float r = __builtin_amdgcn_rsqf(wave_sum(sq) * (1.0f / 512.0f) + EPS);
#pragma unroll
            for (int e = 0; e < 8; ++e) v.v[e] *= r;
            *p = pack8(v);
        }
        {
            const float* SSQ2 = (const float*)(ws + WS_RC); float* RAT = (float*)(ws + WS_RAT);
            for (int row = blockIdx.x * NTHR + tid; row < MP; row += G * NTHR) {
                const f32x4* q = (const f32x4*)(SSQ2 + (size_t)row * 32); float r[4];
#pragma unroll
                for (int g = 0; g < 4; ++g) { const f32x4 x0 = q[2 * g], x1 = q[2 * g + 1]; r[g] = __builtin_amdgcn_rsqf((((x0[0] + x0[1]) + (x0[2] + x0[3])) + ((x1[0] + x1[1]) + (x1[2] + x1[3]))) * (1.0f / 512.0f) + EPS); }
                *(f32x4*)(RAT + (size_t)row * 4) = (f32x4){r[0] / r[1], r[1] / r[2], r[2] / r[3], r[3]};
            }
        }
        SEAM(6);
    }
    if (IN(7)) {
        Gemm g{(const bf16_t*)(ws + WS_RA), (const bf16_t*)(ws + WS_WSO), M, D, 2048, 2048, 2048, 0, (float*)(ws + WS_RD)}; SplitOrder S; S.init(2048, G, (int)blockIdx.x);
        EpiMerge E{(const bf16_t*)(ws + WS_RE), (const bf16_t*)(ws + WS_RB), (bf16*)(ws + WS_RB + SZ1K), (const float*)(ws + WS_RAT)};
        gemm_phase<EpiMerge, SplitOrder, true, true>(lds, g, S, E); xcd_barrier(bar);
        pass_merge<8>((const float*)(ws + WS_RD), (const bf16*)(ws + WS_RE), (const float*)(ws + WS_RC + 4 * MiB), (bf16*)(ws + WS_RB + SZ1K), G, wave, lane); SEAM(7);
    }
    if (IN(8)) {
        Gemm g{(const bf16_t*)(ws + WS_RB + SZ1K), (const bf16_t*)(ws + WS_WO), M, D, D, D, D, 0, (float*)(ws + WS_RD)}; SplitOrder S; S.init(D, G, (int)blockIdx.x);
        typedef EpiResid<true, false, true> Epi8; Epi8 E{X, X, X, XB, SSQ, 1.0f};
        gemm_phase<Epi8, SplitOrder, true, true>(lds, g, S, E); xcd_barrier(bar);
        pass_resid<D / 256, true, false, true>((const float*)(ws + WS_RD), X, X, XB, RSTD, 1.0f, G, wave, lane); pass_rstd_prompt(SSQ, RSTD, G, tid); SEAM(8);
    }
    if (IN(9)) {
        Gemm g{XB, (const bf16_t*)(ws + WS_W2A), M, 2 * FF, D, D, D, 0, nullptr}; StaticOrder S; S.init(M, 2 * FF, D, G, (int)blockIdx.x);
        EpiSwiGLU E{HID, RSTD};
        gemm_phase<EpiSwiGLU, StaticOrder, true, true>(lds, g, S, E); SEAM(9);
    }
    if (IN(10)) {
        Gemm g{HID, (const bf16_t*)(ws + WS_W2B), M, D, FF, FF, FF, 0, (float*)(ws + WS_RD)}; SplitOrder S; S.init(FF, G, (int)blockIdx.x);
        typedef EpiResid<true, false, true> Epi10; Epi10 E{X, X, X, XB, SSQ, 0.5f};
        gemm_phase<Epi10, SplitOrder, true, true>(lds, g, S, E); xcd_barrier(bar);
        pass_final<FF / 256>((const float*)(ws + WS_RD), XB, a.in[I_NFIN], X, 0.5f, G, wave, lane);
        const float* gn = a.in[I_NFIN];
        for (int m0 = (blockIdx.x * NWAVES + wave) * 4; m0 < MP; m0 += G * NWAVES * 4) {
            const u32x4* xr = (const u32x4*)(XB + (size_t)m0 * D) + lane; u32x4 raw[4][2];
#pragma unroll
            for (int q = 0; q < 4; ++q) { raw[q][0] = xr[128 * q]; raw[q][1] = xr[128 * q + 64]; }
            const F8 g0 = loadf8(gn + lane * 8), g1 = loadf8(gn + 512 + lane * 8);
#pragma unroll
            for (int q = 0; q < 4; ++q) { const F8 a0 = unpack8(raw[q][0]), a1 = unpack8(raw[q][1]); float ss = 0.f;
#pragma unroll
                for (int e = 0; e < 8; ++e) ss += a0.v[e] * a0.v[e] + a1.v[e] * a1.v[e];
                const float rstd = __builtin_amdgcn_rsqf(wave_sum(ss) * (1.f / D) + EPS); F8 o0, o1;
#pragma unroll
                for (int e = 0; e < 8; ++e) { o0.v[e] = a0.v[e] * rstd * g0.v[e]; o1.v[e] = a1.v[e] * rstd * g1.v[e]; }
                storef8(X + (size_t)(m0 + q) * D + lane * 8, o0); storef8(X + (size_t)(m0 + q) * D + 512 + lane * 8, o1); }
        }
    }
    {
        __syncthreads();
        __shared__ unsigned s_last;
        if (tid == 0) s_last = (__hip_atomic_fetch_add(&g_bar[XCD_BAR_WORDS], 1u, __ATOMIC_RELAXED, __HIP_MEMORY_SCOPE_AGENT) == (unsigned)G - 1u) ? 1u : 0u;
        __syncthreads();
        if (s_last) { for (int i = tid; i < XCD_BAR_WORDS + 64; i += NTHR) __hip_atomic_store(&g_bar[i], 0u, __ATOMIC_RELAXED, __HIP_MEMORY_SCOPE_AGENT); }
    }
    if (hi > N_PHASES) cg::this_grid().sync();
    if (PROBE_PHASE == 99) { for (int i = 0; i < 16; ++i) xcd_barrier(bar); }
    if (PROBE_PHASE >= 0 && PROBE_PHASE != 99 && blockIdx.x == 0) { const unsigned long long t2 = __builtin_amdgcn_s_memrealtime(), want = (tp1 - tp0) * PROBE_AMP; while (__builtin_amdgcn_s_memrealtime() - t2 < want) __builtin_amdgcn_s_sleep(8); }
#undef IN
#undef SEAM
}

extern "C" void kernel_launch(void* const* d_in, const int* in_sizes, int n_in, void* d_out, int out_size, void* d_ws, size_t ws_size, hipStream_t stream) {
    static int grid = 0;
    if (grid == 0) {
        if (n_in != 25 || out_size != (int)O_END || ws_size < WS_END) { fprintf(stderr, "kernel_launch: unexpected sizes n_in %d out %d ws %zu (need %zu)\n", n_in, out_size, ws_size, (size_t)WS_END); grid = -1; return; }
        int dev = 0, cus = 0, per_cu = 0;
        hipGetDevice(&dev); hipDeviceGetAttribute(&cus, hipDeviceAttributeMultiprocessorCount, dev);
        if (hipFuncSetAttribute((const void*)fwd_kernel, hipFuncAttributeMaxDynamicSharedMemorySize, LDS_BYTES) != hipSuccess) { fprintf(stderr, "kernel_launch: hipFuncSetAttribute failed\n"); grid = -1; return; }
        hipOccupancyMaxActiveBlocksPerMultiprocessor(&per_cu, (const void*)fwd_kernel, NTHR, LDS_BYTES);
        (void)hipGetLastError();
        if (per_cu < 1) fprintf(stderr, "kernel_launch: occupancy query says %d blocks per CU\n", per_cu);
        grid = cus;
    }
    if (grid < 0) return;
    Args a{};
    for (int i = 0; i < 25; ++i) a.in[i] = (const float*)d_in[i];
    a.out = (float*)d_out; a.ws = (unsigned char*)d_ws;
    a.ph_lo = 0; a.ph_hi = N_PHASES;
    void* args[] = {&a};
    hipError_t e = hipLaunchCooperativeKernel((const void*)fwd_kernel, dim3(grid), dim3(NTHR), args, LDS_BYTES, stream);
    if (e != hipSuccess) fprintf(stderr, "cooperative launch failed: %s (grid %d)\n", hipGetErrorString(e), grid);

}
```

```cpp
#include <hip/hip_runtime.h>
#include <cstdio>
#include <cstdint>
namespace pg8 {
#define PG8_LAS __attribute__((address_space(3)))
typedef unsigned short bf16_t;
typedef short bf16x8 __attribute__((ext_vector_type(8)));
typedef float f32x4 __attribute__((ext_vector_type(4)));
typedef unsigned u32x4 __attribute__((ext_vector_type(4)));
constexpr int BM = 256, BK = 64, HALF = 128, HTB = HALF * BK * 2  , STAGE_BYTES = 8 * HTB, NXCD = 8, WGM = 8;

__host__ __device__ __forceinline__ int lds_byte(int r, int c) { const int st = (r >> 4) * 2 + (c >> 5), rr = r & 15, cc = c & 31, ob = rr * 64 + cc * 2; return st * 1024 + (ob ^ (((ob >> 9) & 1) << 5)); }
__host__ __device__ __forceinline__ void stage_rc(int b, int& R, int& C) { const int st = b / 1024, sb = b % 1024, swz = sb ^ (((sb >> 9) & 1) << 5); R = (st >> 1) * 16 + swz / 64; C = (st & 1) * 32 + (swz % 64) / 2; }
__host__ __device__ __forceinline__ int perm32(int rho) { const int n = rho >> 4, i = rho & 15; return 8 * (i >> 2) + 4 * n + (i & 3); }

struct Unit { int pm, pn, kofs, nt, part; };
struct Gemm { const bf16_t* A; const bf16_t* Bt; int M, N, K, lda, ldb, a_pn_off; float* part; };

struct StaticOrder {
    int nM, nN, nwg, G, c, ntf;
    __host__ __device__ void init(int M, int N, int K, int G_, int c_) { nM = M / BM; nN = N / BM; nwg = nM * nN; G = G_; c = c_; ntf = K / BK; }
    __host__ __device__ bool next(int i, Unit& u) const {
        const long L = (long)i * G + c; if (L >= nwg) return false;
        int wgid = (int)L; { const int q = nwg / NXCD, r = nwg % NXCD, xcd = wgid % NXCD, off = wgid / NXCD; wgid = (xcd < r ? xcd * (q + 1) : r * (q + 1) + (xcd - r) * q) + off; }
        const int nig = WGM * nN, gid = wgid / nig, fm = gid * WGM, gsz = (nM - fm) < WGM ? (nM - fm) : WGM;
        u.pm = fm + ((wgid % nig) % gsz); u.pn = (wgid % nig) / gsz; u.kofs = 0; u.nt = ntf; u.part = -1; return true;
    }
    __device__ __forceinline__ void a_ready(const Unit&) const {}
    __device__ __forceinline__ void done(const Unit&) const {}
};


struct SplitOrder {
    StaticOrder so; int S, G, c;
    __host__ __device__ void init(int K, int G_, int c_) { so.init(16384, 1024, K, G_, c_); S = K / 256; G = G_; c = c_; }
    __host__ __device__ bool next(int i, Unit& u) const {
        const int np = (c < 16 * S) ? 1 : 0;
        if (i < np) { const int tile = c / S, sp = c % S; u.pm = 64 + (tile >> 2); u.pn = tile & 3; u.kofs = sp * 512; u.nt = 4; u.part = sp; return true; }
        const long L = (long)(i - np) * G + c;
        if (L < 256) { StaticOrder t = so; t.c = (int)L; t.G = 0; return t.next(0, u); }
        const int j = (int)(L - 256) + ((G < 16 * S) ? G : 16 * S);
        if (j >= 16 * S || G >= 16 * S) return false;
        const int tile = j / S, sp = j % S;
        u.pm = 64 + (tile >> 2); u.pn = tile & 3; u.kofs = sp * 512; u.nt = 4; u.part = sp; return true;
    }
    __device__ __forceinline__ void a_ready(const Unit&) const {}
    __device__ __forceinline__ void done(const Unit&) const {}
};

__device__ __forceinline__ unsigned cvt_pk_bf16(float lo, float hi) { unsigned r; asm volatile("v_cvt_pk_bf16_f32 %0, %1, %2" : "=v"(r) : "v"(lo), "v"(hi)); return r; }
typedef float f32x2 __attribute__((ext_vector_type(2)));
__device__ __forceinline__ float bf_lo(unsigned w) { return __uint_as_float(w << 16); }
__device__ __forceinline__ float bf_hi(unsigned w) { return __uint_as_float(w & 0xffff0000u); }
__device__ __forceinline__ float silu_f(float g) { return g * __builtin_amdgcn_rcpf(1.0f + __expf(-g)); }
__device__ __forceinline__ float sigm_f(float g) { return __builtin_amdgcn_rcpf(1.0f + __expf(-g)); }
__device__ __forceinline__ float rstd16(const float* ssq, int row) {
    const f32x4* p = (const f32x4*)(ssq + (size_t)row * 16);
    const f32x4 a = p[0], b = p[1], c = p[2], d = p[3];
    const float s = ((a[0] + a[1]) + (a[2] + a[3])) + ((b[0] + b[1]) + (b[2] + b[3])) + ((c[0] + c[1]) + (c[2] + c[3])) + ((d[0] + d[1]) + (d[2] + d[3]));
    return __builtin_amdgcn_rsqf(s * (1.0f / 1024.0f) + 1e-6f);
}
struct EpiSwiGLU {
    static constexpr bool PERM = true, AFTER_DRAIN = false, KSEG = false, PREF = true;
    bf16_t* O; const float* rstd;
    __device__ __forceinline__ void operator()(const f32x4 (&acc)[2][2][4][2], const Unit& u, int wr, int wc, int fr, int fq, const PG8_LAS float* epl) const {
        float rsv[2][4];
#pragma unroll
        for (int ai = 0; ai < 2; ++ai)
#pragma unroll
            for (int m = 0; m < 4; ++m) rsv[ai][m] = epl[ai * HALF + wr * 64 + m * 16 + fr];
#pragma unroll
        for (int ai = 0; ai < 2; ++ai)
#pragma unroll
            for (int m = 0; m < 4; ++m) {
                const int row = u.pm * BM + ai * HALF + wr * 64 + m * 16 + fr;
                const float rs = rsv[ai][m];
                const f32x4 g0 = acc[ai][0][m][0] * rs, g1 = acc[ai][0][m][1] * rs, u0 = acc[ai][1][m][0] * rs, u1 = acc[ai][1][m][1] * rs;
                u32x4 w;
                w.x = cvt_pk_bf16(silu_f(g0[0]) * u0[0], silu_f(g0[1]) * u0[1]); w.y = cvt_pk_bf16(silu_f(g0[2]) * u0[2], silu_f(g0[3]) * u0[3]);
                w.z = cvt_pk_bf16(silu_f(g1[0]) * u1[0], silu_f(g1[1]) * u1[1]); w.w = cvt_pk_bf16(silu_f(g1[2]) * u1[2], silu_f(g1[3]) * u1[3]);
                *(u32x4*)(O + (size_t)row * 2816 + u.pn * 128 + wc * 32 + fq * 8) = w;
            }
    }
};
template <bool BASE_BF16, bool WRITE_X, bool WRITE_XB, bool SCALED = false> struct EpiResid {
    static constexpr bool PERM = true, AFTER_DRAIN = false, KSEG = false, PREF = false;
    const float* baseP; const float* baseS;
    float* X; bf16_t* XB; float* ssq; float scale;
    __device__ __forceinline__ void operator()(const f32x4 (&acc)[2][2][4][2], const Unit& u, int wr, int wc, int fr, int fq) const {
        const float* base = (u.pm < 64) ? baseP : baseS;
#pragma unroll
        for (int ai = 0; ai < 2; ++ai) {
            f32x4 bv[4][2][2];
            float rinv[4];
#pragma unroll
            for (int m = 0; m < 4; ++m) rinv[m] = SCALED ? baseP[u.pm * BM + ai * HALF + wr * 64 + m * 16 + fr] : 1.0f;
#pragma unroll
            for (int m = 0; m < 4; ++m) { const size_t off = (size_t)(u.pm * BM + ai * HALF + wr * 64 + m * 16 + fr) * 1024 + u.pn * BM + wc * 32 + fq * 8;
#pragma unroll
                for (int bj = 0; bj < 2; ++bj) {
                    if constexpr (BASE_BF16) { const u32x4 w = *(const u32x4*)(XB + off + bj * HALF);
                        bv[m][bj][0] = (f32x4){bf_lo(w.x), bf_hi(w.x), bf_lo(w.y), bf_hi(w.y)}; bv[m][bj][1] = (f32x4){bf_lo(w.z), bf_hi(w.z), bf_lo(w.w), bf_hi(w.w)};
                        if constexpr (SCALED) { bv[m][bj][0] *= rinv[m]; bv[m][bj][1] *= rinv[m]; } }
                    else { bv[m][bj][0] = *(const f32x4*)(base + off + bj * HALF); bv[m][bj][1] = *(const f32x4*)(base + off + bj * HALF + 4); } } }
#pragma unroll
            for (int m = 0; m < 4; ++m) {
                const int row = u.pm * BM + ai * HALF + wr * 64 + m * 16 + fr;
                const size_t off = (size_t)row * 1024 + u.pn * BM + wc * 32 + fq * 8;
                float s = 0.f;
#pragma unroll
                for (int bj = 0; bj < 2; ++bj) {
                    const f32x4 v0 = bv[m][bj][0] + acc[ai][bj][m][0] * scale, v1 = bv[m][bj][1] + acc[ai][bj][m][1] * scale;
                    if constexpr (WRITE_X) { *(f32x4*)(X + off + bj * HALF) = v0; *(f32x4*)(X + off + bj * HALF + 4) = v1; }
                    if constexpr (WRITE_XB) { u32x4 w; w.x = cvt_pk_bf16(v0[0], v0[1]); w.y = cvt_pk_bf16(v0[2], v0[3]); w.z = cvt_pk_bf16(v1[0], v1[1]); w.w = cvt_pk_bf16(v1[2], v1[3]);
                        *(u32x4*)(XB + off + bj * HALF) = w;
                        s += (v0[0] * v0[0] + v0[1] * v0[1]) + (v0[2] * v0[2] + v0[3] * v0[3]) + (v1[0] * v1[0] + v1[1] * v1[1]) + (v1[2] * v1[2] + v1[3] * v1[3]); }
                }
                if constexpr (WRITE_XB) { s += __shfl_xor(s, 16); s += __shfl_xor(s, 32); if (fq == 0) ssq[(size_t)row * 16 + u.pn * 4 + wc] = s; }
            }
        }
    }
};
struct EpiInProj {
    static constexpr bool PERM = true, AFTER_DRAIN = false, KSEG = false, PREF = true;
    bf16_t* U; bf16_t* Z; bf16_t* XBC; bf16_t* GL; float* DT; const float* dt_bias; const float* rstd;
    __device__ __forceinline__ void operator()(const f32x4 (&acc)[2][2][4][2], const Unit& u, int wr, int wc, int fr, int fq, const PG8_LAS float* epl) const {
        bf16_t* O; int ldc, colt;
        if (u.pn < 4) { O = U; ldc = 1024; colt = u.pn * 256; }
        else if (u.pn < 12) { O = Z; ldc = 2048; colt = (u.pn - 4) * 256; }
        else if (u.pn < 24) { O = XBC; ldc = 3072; colt = (u.pn - 12) * 256; }
        else { O = GL; ldc = 2048; colt = (u.pn - 24) * 256; }
        const bool isdt = (u.pn == 32);
        float rsv[2][4];
#pragma unroll
        for (int ai = 0; ai < 2; ++ai)
#pragma unroll
            for (int m = 0; m < 4; ++m) rsv[ai][m] = epl[ai * HALF + wr * 64 + m * 16 + fr];
#pragma unroll
        for (int ai = 0; ai < 2; ++ai)
#pragma unroll
            for (int m = 0; m < 4; ++m) {
                const int row = u.pm * BM + ai * HALF + wr * 64 + m * 16 + fr;
                const float rs = rsv[ai][m];
                if (!isdt) {
#pragma unroll
                    for (int bj = 0; bj < 2; ++bj) {
                        const f32x4 v0 = acc[ai][bj][m][0] * rs, v1 = acc[ai][bj][m][1] * rs;
                        u32x4 w; w.x = cvt_pk_bf16(v0[0], v0[1]); w.y = cvt_pk_bf16(v0[2], v0[3]); w.z = cvt_pk_bf16(v1[0], v1[1]); w.w = cvt_pk_bf16(v1[2], v1[3]);
                        *(u32x4*)(O + (size_t)row * ldc + colt + bj * HALF + wc * 32 + fq * 8) = w;
                    }
                } else if (wc == 0) {
                    const int c = fq * 8;
                    const f32x4 bb0 = *(const f32x4*)(dt_bias + c), bb1 = *(const f32x4*)(dt_bias + c + 4);
                    f32x4 v0 = acc[ai][0][m][0] * rs + bb0, v1 = acc[ai][0][m][1] * rs + bb1;
#pragma unroll
                    for (int i = 0; i < 4; ++i) { v0[i] = v0[i] > 20.f ? v0[i] : log1pf(__expf(v0[i])); v1[i] = v1[i] > 20.f ? v1[i] : log1pf(__expf(v1[i])); }
                    *(f32x4*)(DT + (size_t)row * 32 + c) = v0; *(f32x4*)(DT + (size_t)row * 32 + c + 4) = v1;
                }
            }
    }
};
struct EpiPlain {
    static constexpr bool PERM = true, AFTER_DRAIN = false, KSEG = false, PREF = false;
    bf16_t* O;
    __device__ __forceinline__ void operator()(const f32x4 (&acc)[2][2][4][2], const Unit& u, int wr, int wc, int fr, int fq) const {
#pragma unroll
        for (int ai = 0; ai < 2; ++ai)
#pragma unroll
            for (int m = 0; m < 4; ++m) {
                const int row = u.pm * BM + ai * HALF + wr * 64 + m * 16 + fr;
#pragma unroll
                for (int bj = 0; bj < 2; ++bj) {
                    const f32x4 v0 = acc[ai][bj][m][0], v1 = acc[ai][bj][m][1];
                    u32x4 w; w.x = cvt_pk_bf16(v0[0], v0[1]); w.y = cvt_pk_bf16(v0[2], v0[3]); w.z = cvt_pk_bf16(v1[0], v1[1]); w.w = cvt_pk_bf16(v1[2], v1[3]);
                    *(u32x4*)(O + (size_t)row * 1024 + u.pn * BM + bj * HALF + wc * 32 + fq * 8) = w;
                }
            }
    }
};
struct EpiMerge {
    static constexpr bool PERM = true, AFTER_DRAIN = false, KSEG = true, PREF = false;
    const bf16_t* GL; const bf16_t* BP; bf16_t* O; const float* RAT;
    __device__ __forceinline__ void kseg(f32x4 (&acc)[2][2][4][2], const Unit& u, int g, int wr, int fr) const {
        if (u.pm >= 64) return;
        const float* rp = RAT + (size_t)(u.pm * BM + wr * 64 + fr) * 4 + g;
#pragma unroll
        for (int ai = 0; ai < 2; ++ai) {
            float f[4];
#pragma unroll
            for (int m = 0; m < 4; ++m) f[m] = rp[(ai * HALF + m * 16) * 4];
#pragma unroll
            for (int m = 0; m < 4; ++m)
#pragma unroll
                for (int bj = 0; bj < 2; ++bj) { acc[ai][bj][m][0] *= f[m]; acc[ai][bj][m][1] *= f[m]; }
        }
    }
    __device__ __forceinline__ void operator()(const f32x4 (&acc)[2][2][4][2], const Unit& u, int wr, int wc, int fr, int fq) const {
#pragma unroll
        for (int ai = 0; ai < 2; ++ai)
#pragma unroll
            for (int mp = 0; mp < 2; ++mp) {
                u32x4 g0v[2][2], g1v[2][2], bpv[2][2];
                float r3v[2];
#pragma unroll
                for (int mm = 0; mm < 2; ++mm) r3v[mm] = (u.pm < 64) ? RAT[(size_t)(u.pm * BM + ai * HALF + wr * 64 + (2 * mp + mm) * 16 + fr) * 4 + 3] : 1.0f;
#pragma unroll
                for (int mm = 0; mm < 2; ++mm) { const int row = u.pm * BM + ai * HALF + wr * 64 + (2 * mp + mm) * 16 + fr;
#pragma unroll
                    for (int bj = 0; bj < 2; ++bj) { const int col = u.pn * BM + bj * HALF + wc * 32 + fq * 8;
                        g0v[mm][bj] = *(const u32x4*)(GL + (size_t)row * 2048 + col); g1v[mm][bj] = *(const u32x4*)(GL + (size_t)row * 2048 + 1024 + col); bpv[mm][bj] = *(const u32x4*)(BP + (size_t)row * 1024 + col); } }
#pragma unroll
                for (int mm = 0; mm < 2; ++mm) { const int m = 2 * mp + mm; const int row = u.pm * BM + ai * HALF + wr * 64 + m * 16 + fr;
#pragma unroll
                    for (int bj = 0; bj < 2; ++bj) {
                        const int col = u.pn * BM + bj * HALF + wc * 32 + fq * 8;
                        const u32x4 g0 = g0v[mm][bj], g1 = g1v[mm][bj], bp = bpv[mm][bj];
                        const f32x4 a0 = acc[ai][bj][m][0] * r3v[mm], a1 = acc[ai][bj][m][1] * r3v[mm];
                        u32x4 w;
                        w.x = cvt_pk_bf16(sigm_f(bf_lo(g0.x)) * bf_lo(bp.x) + sigm_f(bf_lo(g1.x)) * a0[0], sigm_f(bf_hi(g0.x)) * bf_hi(bp.x) + sigm_f(bf_hi(g1.x)) * a0[1]);
                        w.y = cvt_pk_bf16(sigm_f(bf_lo(g0.y)) * bf_lo(bp.y) + sigm_f(bf_lo(g1.y)) * a0[2], sigm_f(bf_hi(g0.y)) * bf_hi(bp.y) + sigm_f(bf_hi(g1.y)) * a0[3]);
                        w.z = cvt_pk_bf16(sigm_f(bf_lo(g0.z)) * bf_lo(bp.z) + sigm_f(bf_lo(g1.z)) * a1[0], sigm_f(bf_hi(g0.z)) * bf_hi(bp.z) + sigm_f(bf_hi(g1.z)) * a1[1]);
                        w.w = cvt_pk_bf16(sigm_f(bf_lo(g0.w)) * bf_lo(bp.w) + sigm_f(bf_lo(g1.w)) * a1[2], sigm_f(bf_hi(g0.w)) * bf_hi(bp.w) + sigm_f(bf_hi(g1.w)) * a1[3]);
                        *(u32x4*)(O + (size_t)row * 1024 + col) = w;
                    } }
            }
    }
};

template <class Epi, class Sched, bool ALIGN_EPI = false, bool SP2 = false>
__device__ __forceinline__ void gemm_phase(PG8_LAS unsigned char* lds, const Gemm g, const Sched& S, const Epi& E) {
    const int tid = threadIdx.x, wid = __builtin_amdgcn_readfirstlane(tid >> 6), lane = tid & 63, wr = wid >> 2, wc = wid & 3, fr = lane & 15, fq = lane >> 4;
    const int K = g.K; (void)K;
    unsigned voffA[2], voffB[2];
#pragma unroll
    for (int i = 0; i < 2; ++i) { int R, C; stage_rc(tid * 16 + i * 8192, R, C); const int Rb = Epi::PERM ? ((R & ~31) + perm32(R & 31)) : R;
        voffA[i] = (unsigned)(R * g.lda + C) * 2u; voffB[i] = (unsigned)(Rb * g.ldb + C) * 2u; }
    const size_t kstep = (size_t)(BK * 2);
    const size_t hstepA = (size_t)HALF * g.lda * 2, hstepB = (size_t)HALF * g.ldb * 2;
    const size_t tstepA = 2 * hstepA, tstepB = 2 * hstepB; const size_t pnoffA = (size_t)g.a_pn_off * 2;
    const unsigned ldsw = (unsigned)wid * 1024u;
    const int aoff = lds_byte(wr * 64 + fr, fq * 8), boff = lds_byte(wc * 32 + fr, fq * 8);
#define PG8_SA(b, h) (((b) * 2 + (h)) * HTB)
#define PG8_SB(b, h) ((4 + (b) * 2 + (h)) * HTB)
#define PG8_STAGE(bufoff, gbase, voff) do { _Pragma("unroll") for (int _i = 0; _i < 2; ++_i) \
        __builtin_amdgcn_global_load_lds((const unsigned*)((const char*)(gbase) + (voff)[_i]), (PG8_LAS unsigned*)(lds + (bufoff) + ldsw + _i * 8192), 16, 0, 0); } while (0)
#define PG8_LDA(dst, b, h) do { _Pragma("unroll") for (int m = 0; m < 4; ++m) _Pragma("unroll") for (int k = 0; k < 2; ++k) dst[m][k] = *(const PG8_LAS bf16x8*)(lds + PG8_SA(b, h) + aoff + m * 2048 + k * 1024); } while (0)
#define PG8_LDB(dst, b, h) do { _Pragma("unroll") for (int n = 0; n < 2; ++n) _Pragma("unroll") for (int k = 0; k < 2; ++k) dst[n][k] = *(const PG8_LAS bf16x8*)(lds + PG8_SB(b, h) + boff + n * 2048 + k * 1024); } while (0)
#define PG8_MMA(ai, bj, At, Bt) do { __builtin_amdgcn_s_setprio(1); _Pragma("unroll") for (int m = 0; m < 4; ++m) _Pragma("unroll") for (int n = 0; n < 2; ++n) _Pragma("unroll") for (int k = 0; k < 2; ++k) \
        acc[ai][bj][m][n] = __builtin_amdgcn_mfma_f32_16x16x32_bf16(Bt[n][k], At[m][k], acc[ai][bj][m][n], 0, 0, 0); __builtin_amdgcn_s_setprio(0); } while (0)
#define PG8_WAIT_V(n) asm volatile("s_waitcnt vmcnt(" #n ")" ::: "memory")
#define PG8_WAIT_L(n) asm volatile("s_waitcnt lgkmcnt(" #n ")" ::: "memory")
#define PG8_BAR __builtin_amdgcn_s_barrier()
#define PG8_SCHED __builtin_amdgcn_sched_barrier(0)
    Unit cur, nxt; int ui = 0;
    if (!S.next(0, cur)) return;
    f32x4 acc[2][2][4][2];
#pragma unroll
    for (int a = 0; a < 2; ++a)
#pragma unroll
        for (int b = 0; b < 2; ++b)
#pragma unroll
            for (int m = 0; m < 4; ++m)
#pragma unroll
                for (int n = 0; n < 2; ++n) acc[a][b][m][n] = (f32x4){0.f, 0.f, 0.f, 0.f};
    bf16x8 At[4][2], B0[2][2], B1[2][2];
    const char* cA = (const char*)g.A + (size_t)cur.pm * tstepA + (size_t)cur.pn * pnoffA + cur.kofs; const char* cB = (const char*)g.Bt + (size_t)cur.pn * tstepB + cur.kofs;
    S.a_ready(cur);
    if constexpr (SP2) {
        PG8_STAGE(PG8_SB(0, 0), cB, voffB); PG8_STAGE(PG8_SB(0, 1), cB + hstepB, voffB); PG8_STAGE(PG8_SA(0, 0), cA, voffA); PG8_STAGE(PG8_SA(0, 1), cA + hstepA, voffA);
        if (wr == 1) PG8_BAR;
        PG8_WAIT_V(2); PG8_BAR;
        PG8_STAGE(PG8_SB(1, 0), cB + kstep, voffB); PG8_STAGE(PG8_SA(1, 0), cA + kstep, voffA); PG8_STAGE(PG8_SB(1, 1), cB + hstepB + kstep, voffB);
        PG8_WAIT_V(6); PG8_BAR;
    } else {
        PG8_STAGE(PG8_SB(0, 0), cB, voffB); PG8_STAGE(PG8_SA(0, 0), cA, voffA); PG8_STAGE(PG8_SB(0, 1), cB + hstepB, voffB); PG8_STAGE(PG8_SA(0, 1), cA + hstepA, voffA);
        if (wr == 1) PG8_BAR;
        PG8_WAIT_V(4); PG8_BAR;
        PG8_STAGE(PG8_SB(1, 0), cB + kstep, voffB); PG8_STAGE(PG8_SA(1, 0), cA + kstep, voffA); PG8_STAGE(PG8_SB(1, 1), cB + hstepB + kstep, voffB);
        PG8_WAIT_V(6); PG8_BAR;
    }
    for (;;) {
        const bool has_next = S.next(ui + 1, nxt);
        const char* nA = has_next ? (const char*)g.A + (size_t)nxt.pm * tstepA + (size_t)nxt.pn * pnoffA + nxt.kofs : cA; const char* nB = has_next ? (const char*)g.Bt + (size_t)nxt.pn * tstepB + nxt.kofs : cB;
        const int nt = cur.nt;
        PG8_LAS float* epl = (PG8_LAS float*)(lds + 131072 + 2048) + (ui & 1) * 256;
        float epv = 1.0f;
        if constexpr (Epi::PREF) { if (cur.part < 0 && wid < 4 && E.rstd) epv = E.rstd[cur.pm * BM + tid]; }
        for (int t = 0; t < nt; t += 2) {
            const bool last = (t == nt - 2);
            const char* a1 = cA + (size_t)(t + 1) * kstep;
            const char* a2 = last ? nA : cA + (size_t)(t + 2) * kstep; const char* b2 = last ? nB : cB + (size_t)(t + 2) * kstep;
            const char* a3 = a2 + kstep; const char* b3 = b2 + kstep;
            if (last && has_next) S.a_ready(nxt);
            if constexpr (Epi::PREF) { if (last && cur.part < 0 && wid < 4) epl[tid] = epv; }
            if constexpr (SP2) {
            PG8_LDB(B0, 0, 0); PG8_LDB(B1, 0, 1); PG8_SCHED; PG8_LDA(At, 0, 0); PG8_STAGE(PG8_SA(1, 1), a1 + hstepA, voffA);
            PG8_WAIT_V(8); PG8_WAIT_L(0); PG8_BAR; PG8_MMA(0, 0, At, B0); PG8_MMA(0, 1, At, B1); PG8_BAR; PG8_SCHED;
            PG8_LDA(At, 0, 1); PG8_STAGE(PG8_SB(0, 0), b2, voffB); PG8_STAGE(PG8_SB(0, 1), b2 + hstepB, voffB); PG8_STAGE(PG8_SA(0, 0), a2, voffA);
            PG8_WAIT_V(8); PG8_WAIT_L(0); PG8_BAR; PG8_MMA(1, 0, At, B0); PG8_MMA(1, 1, At, B1); PG8_BAR; PG8_SCHED;
            PG8_LDB(B0, 1, 0); PG8_LDB(B1, 1, 1); PG8_SCHED; PG8_LDA(At, 1, 0); PG8_STAGE(PG8_SA(0, 1), a2 + hstepA, voffA);
            PG8_WAIT_V(8); PG8_WAIT_L(0); PG8_BAR; PG8_MMA(0, 0, At, B0); PG8_MMA(0, 1, At, B1); PG8_BAR; PG8_SCHED;
            PG8_LDA(At, 1, 1); PG8_STAGE(PG8_SB(1, 0), b3, voffB); PG8_STAGE(PG8_SB(1, 1), b3 + hstepB, voffB); PG8_STAGE(PG8_SA(1, 0), a3, voffA);
            PG8_WAIT_V(8); PG8_WAIT_L(0); PG8_BAR; PG8_MMA(1, 0, At, B0); PG8_MMA(1, 1, At, B1); PG8_BAR; PG8_SCHED;
            } else {
            PG8_LDB(B0, 0, 0); PG8_SCHED; PG8_LDA(At, 0, 0); PG8_STAGE(PG8_SA(1, 1), a1 + hstepA, voffA);
            PG8_WAIT_L(8); PG8_BAR; PG8_WAIT_L(0); PG8_MMA(0, 0, At, B0); PG8_BAR; PG8_SCHED;
            PG8_LDB(B1, 0, 1); PG8_STAGE(PG8_SB(0, 0), b2, voffB);
            PG8_BAR; PG8_WAIT_L(0); PG8_MMA(0, 1, At, B1); PG8_BAR;
            PG8_LDA(At, 0, 1); PG8_STAGE(PG8_SA(0, 0), a2, voffA);
            PG8_BAR; PG8_WAIT_L(0); PG8_MMA(1, 0, At, B0); PG8_BAR; PG8_SCHED;
            PG8_STAGE(PG8_SB(0, 1), b2 + hstepB, voffB);
            PG8_WAIT_V(6); PG8_BAR; PG8_MMA(1, 1, At, B1); PG8_BAR;
            PG8_LDB(B0, 1, 0); PG8_SCHED; PG8_LDA(At, 1, 0); PG8_STAGE(PG8_SA(0, 1), a2 + hstepA, voffA);
            PG8_WAIT_L(8); PG8_BAR; PG8_WAIT_L(0); PG8_MMA(0, 0, At, B0); PG8_BAR; PG8_SCHED;
            PG8_LDB(B1, 1, 1); PG8_STAGE(PG8_SB(1, 0), b3, voffB);
            PG8_BAR; PG8_WAIT_L(0); PG8_MMA(0, 1, At, B1); PG8_BAR;
            PG8_LDA(At, 1, 1); PG8_STAGE(PG8_SA(1, 0), a3, voffA);
            PG8_BAR; PG8_WAIT_L(0); PG8_MMA(1, 0, At, B0); PG8_BAR; PG8_SCHED;
            PG8_STAGE(PG8_SB(1, 1), b3 + hstepB, voffB);
            PG8_WAIT_V(6); PG8_BAR; PG8_MMA(1, 1, At, B1); PG8_BAR;
            }
            if constexpr (Epi::KSEG) { if (cur.part < 0 && ((t + 2) & 7) == 0 && (t + 2) < nt) E.kseg(acc, cur, ((t + 2) >> 3) - 1, wr, fr); }
        }
        if constexpr (ALIGN_EPI) { if (wr == 0) PG8_BAR; }
        if constexpr (!Epi::AFTER_DRAIN) {
            if (cur.part >= 0) {
                static_assert(Epi::PERM, "partial store assumes the PERM column layout");
#pragma unroll
                for (int ai = 0; ai < 2; ++ai)
#pragma unroll
                    for (int m = 0; m < 4; ++m) { bf16_t* pp = (bf16_t*)g.part + ((size_t)cur.part * 1024 + (cur.pm - 64) * BM + ai * HALF + wr * 64 + m * 16 + fr) * 1024 + cur.pn * BM + wc * 32 + fq * 8;
#pragma unroll
                        for (int bj = 0; bj < 2; ++bj) { const f32x4 v0 = acc[ai][bj][m][0], v1 = acc[ai][bj][m][1]; u32x4 w; w.x = cvt_pk_bf16(v0[0], v0[1]); w.y = cvt_pk_bf16(v0[2], v0[3]); w.z = cvt_pk_bf16(v1[0], v1[1]); w.w = cvt_pk_bf16(v1[2], v1[3]); *(u32x4*)(pp + bj * HALF) = w; } }
            } else { if constexpr (Epi::PREF) E(acc, cur, wr, wc, fr, fq, epl); else E(acc, cur, wr, wc, fr, fq); }
            S.done(cur); }
        if (!has_next) break;
#pragma unroll
        for (int a = 0; a < 2; ++a)
#pragma unroll
            for (int b = 0; b < 2; ++b)
#pragma unroll
                for (int m = 0; m < 4; ++m)
#pragma unroll
                    for (int n = 0; n < 2; ++n) acc[a][b][m][n] = (f32x4){0.f, 0.f, 0.f, 0.f};
        cur = nxt; cA = nA; cB = nB; ++ui;
        if constexpr (ALIGN_EPI) { if (wr == 1) PG8_BAR; }
    }
    PG8_WAIT_V(0);
    if constexpr (!ALIGN_EPI) { if (wr == 0) PG8_BAR; }
    PG8_BAR;
    if constexpr (Epi::AFTER_DRAIN) { E.fused(acc, cur, wr, wc, fr, fq, lds, wid, lane); S.done(cur); }
#undef PG8_SA
#undef PG8_SB
#undef PG8_STAGE
#undef PG8_LDA
#undef PG8_LDB
#undef PG8_MMA
#undef PG8_WAIT_V
#undef PG8_WAIT_L
#undef PG8_BAR
#undef PG8_SCHED
}
}

#include <hip/hip_cooperative_groups.h>
namespace cg = cooperative_groups;
#ifndef ONE_LAUNCH
#define ONE_LAUNCH 1
#endif
#define LAS __attribute__((address_space(3)))
typedef unsigned short bf16;
typedef unsigned u32x4 __attribute__((ext_vector_type(4)));
typedef unsigned u32x2 __attribute__((ext_vector_type(2)));
typedef float f32x4 __attribute__((ext_vector_type(4)));
typedef short bf16x8 __attribute__((ext_vector_type(8)));
constexpr int NWAVES = 8, NTHR = 512;
constexpr int MP = 16384, MS = 1024, M = MP + MS;
constexpr int D = 1024, FF = 2816, NPROJ = 8224, NPROJ_PAD = 8448;
constexpr float EPS = 1e-6f;
constexpr int N_PHASES = 11;
constexpr size_t O_Y = 0, O_PP = 17825792, O_CP = 17948672, O_SP = 18022400, O_PS = 20119552, O_CS = 22085632, O_SS = 23265280, O_END = 56819712;
constexpr size_t MiB = 1u << 20;
constexpr size_t WS_W1A = 0, WS_W1B = 11 * MiB, WS_WIN = WS_W1B + 5632 * 1024, WS_WPG = WS_WIN + (size_t)NPROJ_PAD * 1024 * 2, WS_WPO = WS_WPG + 512 * 1024, WS_WSO = WS_WPO + 2 * MiB,
                 WS_WO = WS_WSO + 4 * MiB, WS_W2A = WS_WO + 2 * MiB, WS_W2B = WS_W2A + 11 * MiB, WS_WEND = WS_W2B + 5632 * 1024;
constexpr size_t SZ1K = (size_t)M * 1024 * 2, SZ2K = 2 * SZ1K, SZ3K = 3 * SZ1K;
constexpr size_t WS_SMALL = 58 * MiB;
constexpr size_t WS_SSQ = WS_SMALL, WS_DT = WS_SSQ + (size_t)M * 16 * 4, WS_RSTD = WS_DT + (size_t)M * 32 * 4, WS_RAT = WS_RSTD + (size_t)M * 4, WS_SMALL_END = WS_RAT + (size_t)MP * 16;
constexpr size_t WS_XB = 62 * MiB;
constexpr size_t WS_RA = WS_XB + SZ1K;
constexpr size_t WS_RB = WS_RA + SZ3K;
constexpr size_t WS_RC = WS_RB + SZ3K;
constexpr size_t WS_RD = WS_RC + SZ1K;
constexpr size_t WS_RE = WS_RD + SZ2K;
constexpr size_t WS_RF = WS_RE + SZ2K;
constexpr size_t WS_CTL = WS_RF + SZ1K, CTL_BYTES = 16384;
constexpr size_t WS_WEFF = WS_CTL + CTL_BYTES;
constexpr size_t WS_END = WS_WEFF + 2 * MiB;
static_assert(WS_WEND <= WS_SMALL && WS_SMALL_END <= WS_XB && WS_END <= 512 * MiB, "d_ws map");
constexpr int LDS_BYTES = 145408;
constexpr int LDS_MISC_OFF = 144384;

__device__ __forceinline__ unsigned f2bf(float f) { unsigned u = __float_as_uint(f); return (u + 0x7fffu + ((u >> 16) & 1u)) >> 16; }
typedef float f32x2_t __attribute__((ext_vector_type(2))); typedef __bf16 bf16x2_t __attribute__((ext_vector_type(2)));
__device__ __forceinline__ unsigned pk2(float lo, float hi) { f32x2_t v = {lo, hi}; bf16x2_t b = __builtin_convertvector(v, bf16x2_t); return __builtin_bit_cast(unsigned, b); }
__device__ __forceinline__ float bflo(unsigned w) { return __uint_as_float(w << 16); }
__device__ __forceinline__ float bfhi(unsigned w) { return __uint_as_float(w & 0xffff0000u); }
__device__ __forceinline__ float bf2f(bf16 v) { return __uint_as_float((unsigned)v << 16); }
__device__ __forceinline__ float wave_sum(float v) {
#pragma unroll
    for (int o = 1; o < 64; o <<= 1) v += __shfl_xor(v, o);
    return v;
}
#define LDS_WAIT() asm volatile("s_waitcnt lgkmcnt(0)" ::: "memory")
#define LDS_BARRIER() do { asm volatile("s_waitcnt lgkmcnt(0)" ::: "memory"); __builtin_amdgcn_s_barrier(); asm volatile("" ::: "memory"); } while (0)
struct F8 { float v[8]; };
__device__ __forceinline__ F8 unpack8(u32x4 w) { F8 r; r.v[0] = bflo(w.x); r.v[1] = bfhi(w.x); r.v[2] = bflo(w.y); r.v[3] = bfhi(w.y); r.v[4] = bflo(w.z); r.v[5] = bfhi(w.z); r.v[6] = bflo(w.w); r.v[7] = bfhi(w.w); return r; }
__device__ __forceinline__ u32x4 pack8(const F8& a) { u32x4 w; w.x = pk2(a.v[0], a.v[1]); w.y = pk2(a.v[2], a.v[3]); w.z = pk2(a.v[4], a.v[5]); w.w = pk2(a.v[6], a.v[7]); return w; }
__device__ __forceinline__ F8 loadf8(const float* p) { const f32x4 a = *(const f32x4*)p, b = *(const f32x4*)(p + 4); F8 r; r.v[0] = a[0]; r.v[1] = a[1]; r.v[2] = a[2]; r.v[3] = a[3]; r.v[4] = b[0]; r.v[5] = b[1]; r.v[6] = b[2]; r.v[7] = b[3]; return r; }
__device__ __forceinline__ void storef8(float* p, const F8& a) { *(f32x4*)p = (f32x4){a.v[0], a.v[1], a.v[2], a.v[3]}; *(f32x4*)(p + 4) = (f32x4){a.v[4], a.v[5], a.v[6], a.v[7]}; }
__device__ __forceinline__ F8 zero8() { F8 r;
#pragma unroll
    for (int i = 0; i < 8; ++i) r.v[i] = 0.f;
    return r; }

struct Args { const float* in[25]; float* out; unsigned char* ws; int ph_lo, ph_hi; };
enum { I_XP = 0, I_XS, I_SPOOL, I_SCONV, I_SSSM, I_NF1, I_F1IN, I_F1OUT, I_NMIX, I_WIN, I_PWG, I_PSC, I_PWO, I_CW, I_CB, I_DTB, I_ALOG, I_DSKIP, I_SNORM, I_SWO, I_WO, I_NF2, I_F2IN, I_F2OUT, I_NFIN };

__device__ __forceinline__ void p0_item(const float* W, int K, int N, bf16* WT, int row_off, int mode, const float* gain, LAS float* scr, int item, int lane) {
    const int nblk = N / 32, kb = item / nblk, nb = item % nblk, k0 = 64 * kb, n0 = 32 * nb;
    const float gv = gain ? gain[k0 + lane] : 1.0f;
    float wv[32];
#pragma unroll
    for (int i = 0; i < 32; ++i) { const int kk = 2 * i + (lane >> 5); wv[i] = __builtin_nontemporal_load(W + (size_t)(k0 + kk) * N + n0 + (lane & 31)); }
#pragma unroll
    for (int i = 0; i < 32; ++i) { const int kk = 2 * i + (lane >> 5); scr[kk * 33 + (lane & 31)] = wv[i] * __shfl(gv, kk); }
    LDS_WAIT(); asm volatile("" ::: "memory");
    int dr = n0;
    if (mode == 1) { if (n0 < FF) dr = (n0 >> 7) * 256 + (n0 & 127); else { const int j = n0 - FF; dr = (j >> 7) * 256 + 128 + (j & 127); } }
    else if (mode == 2) { if (n0 >= 6176) dr = n0 - 32; else if (n0 >= 6144) dr = 8192 + (n0 - 6144); }
    const int c = lane & 7;
#pragma unroll
    for (int j = 0; j < 4; ++j) { const int n = (lane >> 3) + 8 * j; const LAS float* s = scr + (8 * c) * 33 + n;
        u32x4 o; o.x = pk2(s[0 * 33], s[1 * 33]); o.y = pk2(s[2 * 33], s[3 * 33]); o.z = pk2(s[4 * 33], s[5 * 33]); o.w = pk2(s[6 * 33], s[7 * 33]);
        *(u32x4*)(WT + (size_t)(row_off + dr + n) * K + k0 + 8 * c) = o; }
    LDS_WAIT(); asm volatile("" ::: "memory");
}
__device__ __forceinline__ void phase0(const Args& a, LAS unsigned char* lds, int G, int tid) {
    const int lane = tid & 63, wave = __builtin_amdgcn_readfirstlane(tid >> 6);
    LAS float* scr = (LAS float*)(lds + wave * 16384);
    const int gw = blockIdx.x * NWAVES + wave, NGW = G * NWAVES;
    unsigned char* ws = a.ws;
    constexpr int I1A = 16 * 176, I1B = 44 * 32, IIN = 16 * 257, IPG = 4 * 32, IPO = 16 * 32, ISO = 32 * 32, IWO = 16 * 32;
    constexpr int NITEMS = 2 * I1A + 2 * I1B + IIN + IPO + ISO + IWO; (void)IPG;
    for (int it = gw; it < NITEMS; it += NGW) {
        int r = it;
        if (r < I1A) { p0_item(a.in[I_F1IN], D, 2 * FF, (bf16*)(ws + WS_W1A), 0, 1, a.in[I_NF1], scr, r, lane); continue; } r -= I1A;
        if (r < I1A) { p0_item(a.in[I_F2IN], D, 2 * FF, (bf16*)(ws + WS_W2A), 0, 1, a.in[I_NF2], scr, r, lane); continue; } r -= I1A;
        if (r < IIN) { p0_item(a.in[I_WIN], D, NPROJ, (bf16*)(ws + WS_WIN), 0, 2, a.in[I_NMIX], scr, r, lane); continue; } r -= IIN;
        if (r < I1B) { p0_item(a.in[I_F1OUT], FF, D, (bf16*)(ws + WS_W1B), 0, 0, nullptr, scr, r, lane); continue; } r -= I1B;
        if (r < I1B) { p0_item(a.in[I_F2OUT], FF, D, (bf16*)(ws + WS_W2B), 0, 0, nullptr, scr, r, lane); continue; } r -= I1B;
        if (r < IPO) { p0_item(a.in[I_PWO], D, D, (bf16*)(ws + WS_WPO), 0, 0, a.in[I_PSC], scr, r, lane); continue; } r -= IPO;
        if (r < ISO) { p0_item(a.in[I_SWO], 2048, D, (bf16*)(ws + WS_WSO), 0, 0, a.in[I_SNORM], scr, r, lane); continue; } r -= ISO;
        p0_item(a.in[I_WO], D, D, (bf16*)(ws + WS_WO), 0, 0, nullptr, scr, r, lane);
    }
    { const float* wg = a.in[I_PWG]; u32x4* o = (u32x4*)(ws + WS_WPG);
      for (int i = blockIdx.x * NTHR + tid; i < 262144 / 8; i += G * NTHR) o[i] = pack8(loadf8(wg + (size_t)i * 8)); }
    { u32x4* z = (u32x4*)(ws + WS_WIN + (size_t)NPROJ * 1024 * 2); const int n16 = (NPROJ_PAD - NPROJ) * 1024 * 2 / 16;
      for (int i = blockIdx.x * NTHR + tid; i < n16; i += G * NTHR) z[i] = (u32x4){0u, 0u, 0u, 0u}; }
    bf16* XN = (bf16*)(ws + WS_XB);
    for (int m0 = gw * 2; m0 < M; m0 += NGW * 2) {
        const float* xrow = (m0 < MP) ? a.in[I_XP] + (size_t)m0 * D : a.in[I_XS] + (size_t)(m0 - MP) * D;
        const f32x4* xr = (const f32x4*)xrow + lane;
        f32x4 v[2][4]; float s[2] = {0.f, 0.f};
#pragma unroll
        for (int q = 0; q < 2; ++q)
#pragma unroll
            for (int j = 0; j < 4; ++j) v[q][j] = __builtin_nontemporal_load(xr + 256 * q + 64 * j);
#pragma unroll
        for (int q = 0; q < 2; ++q)
#pragma unroll
            for (int j = 0; j < 4; ++j) s[q] += (v[q][j][0] * v[q][j][0] + v[q][j][1] * v[q][j][1]) + (v[q][j][2] * v[q][j][2] + v[q][j][3] * v[q][j][3]);
#pragma unroll
        for (int q = 0; q < 2; ++q) { const float ms = wave_sum(s[q]) * (1.f / D) + EPS, rstd = __builtin_amdgcn_rsqf(ms);
            if (lane == 0) ((float*)(ws + WS_RSTD))[m0 + q] = ms * rstd;
            u32x2* o8 = (u32x2*)(XN + (size_t)(m0 + q) * D) + lane;
#pragma unroll
            for (int j = 0; j < 4; ++j) { u32x2 w; w.x = pk2(v[q][j][0] * rstd, v[q][j][1] * rstd); w.y = pk2(v[q][j][2] * rstd, v[q][j][3] * rstd); o8[64 * j] = w; } }
    }
}

__device__ __forceinline__ void phase4(const Args& a, int G, int tid) {
    unsigned char* ws = a.ws;
    const bf16* U = (const bf16*)(ws + WS_RC); const bf16* XBC = (const bf16*)(ws + WS_RA);
    bf16* Dp = (bf16*)(ws + WS_RF); bf16* XC = (bf16*)(ws + WS_RB);
    const float* spool = a.in[I_SPOOL]; const float* sconv = a.in[I_SCONV];
    const int gt = blockIdx.x * NTHR + tid, NT = G * NTHR;
    for (int u = gt; u < 65536 + 16384; u += NT) {
        const bool smp = u >= 65536; int b, t0, nrows, slab;
        if (!smp) { slab = u & 127; t0 = ((u >> 7) & 63) * 32; b = u >> 13; nrows = 32; }
        else { const int v = u - 65536; slab = v & 127; b = v >> 7; t0 = 0; nrows = 8; }
        const int c0 = slab * 8, w = 2 << (c0 >> 8);
        const size_t rowbase = smp ? (size_t)MP + b * 8 : (size_t)b * 2048;
        const bf16* Ub = U + rowbase * 1024 + c0; const float* hb = spool + ((size_t)b * 15 + 15) * 1024 + c0;
        F8 s = zero8();
        for (int j = 1; j < w; ++j) {
            const int i = t0 - j;
            if (i >= 0) { const F8 x = unpack8(*(const u32x4*)(Ub + (ptrdiff_t)i * 1024));
#pragma unroll
                for (int e = 0; e < 8; ++e) s.v[e] += x.v[e]; }
            else if (smp) { const F8 x = loadf8(hb + (ptrdiff_t)i * 1024);
#pragma unroll
                for (int e = 0; e < 8; ++e) s.v[e] += x.v[e]; }
        }
        for (int tb = t0; tb < t0 + nrows; tb += 8) {
            u32x4 curw[8]; F8 oldv[8];
#pragma unroll
            for (int k = 0; k < 8; ++k) curw[k] = *(const u32x4*)(Ub + (size_t)(tb + k) * 1024);
#pragma unroll
            for (int k = 0; k < 8; ++k) { const int i = tb + k - w + 1;
                if (i >= 0) oldv[k] = unpack8(*(const u32x4*)(Ub + (ptrdiff_t)i * 1024));
                else if (smp) oldv[k] = loadf8(hb + (ptrdiff_t)i * 1024);
                else oldv[k] = zero8(); }
#pragma unroll
            for (int k = 0; k < 8; ++k) {
                const int t = tb + k; const F8 cur = unpack8(curw[k]);
                const float icnt = 1.0f / (smp ? (float)w : (float)((t + 1 < w) ? t + 1 : w));
                F8 d;
#pragma unroll
                for (int e = 0; e < 8; ++e) { s.v[e] += cur.v[e]; d.v[e] = s.v[e] * icnt - cur.v[e]; s.v[e] -= oldv[k].v[e]; }
                *(u32x4*)(Dp + (rowbase + t) * 1024 + c0) = pack8(d);
            }
        }
    }
    const float* cw = a.in[I_CW]; const float* cb = a.in[I_CB];
    for (int u = gt; u < 196608 + 49152; u += NT) {
        const bool smp = u >= 196608; int b, t0, nrows, slab;
        if (!smp) { slab = u % 384; const int q = u / 384; t0 = (q & 63) * 32; b = q >> 6; nrows = 32; }
        else { const int v = u - 196608; slab = v % 384; b = v / 384; t0 = 0; nrows = 8; }
        const int c0 = slab * 8;
        const size_t rowbase = smp ? (size_t)MP + b * 8 : (size_t)b * 2048;
        const F8 w0 = loadf8(cw + c0), w1 = loadf8(cw + 3072 + c0), w2 = loadf8(cw + 6144 + c0), w3 = loadf8(cw + 9216 + c0), bi = loadf8(cb + c0);
        F8 xm3, xm2, xm1;
        if (smp) { xm3 = loadf8(sconv + ((size_t)b * 3 + 0) * 3072 + c0); xm2 = loadf8(sconv + ((size_t)b * 3 + 1) * 3072 + c0); xm1 = loadf8(sconv + ((size_t)b * 3 + 2) * 3072 + c0); }
        else if (t0 == 0) { xm3 = zero8(); xm2 = zero8(); xm1 = zero8(); }
        else { xm3 = unpack8(*(const u32x4*)(XBC + (rowbase + t0 - 3) * 3072 + c0)); xm2 = unpack8(*(const u32x4*)(XBC + (rowbase + t0 - 2) * 3072 + c0)); xm1 = unpack8(*(const u32x4*)(XBC + (rowbase + t0 - 1) * 3072 + c0)); }
        for (int tb = t0; tb < t0 + nrows; tb += 8) {
            u32x4 curw[8];
#pragma unroll
            for (int k = 0; k < 8; ++k) curw[k] = *(const u32x4*)(XBC + (rowbase + tb + k) * 3072 + c0);
#pragma unroll
            for (int k = 0; k < 8; ++k) {
                const F8 cur = unpack8(curw[k]);
                F8 y;
#pragma unroll
                for (int e = 0; e < 8; ++e) { const float v = bi.v[e] + xm3.v[e] * w0.v[e] + xm2.v[e] * w1.v[e] + xm1.v[e] * w2.v[e] + cur.v[e] * w3.v[e]; y.v[e] = v * __builtin_amdgcn_rcpf(1.0f + __expf(-v)); }
                *(u32x4*)(XC + (rowbase + tb + k) * 3072 + c0) = pack8(y);
                xm3 = xm2; xm2 = xm1; xm1 = cur;
            }
        }
    }
    for (int u = gt; u < (8 + 128) * 15 * 128; u += NT) {
        const int slab = u & 127, rj = u >> 7, c0 = slab * 8;
        if (rj < 120) { const int b = rj / 15, j = rj % 15;
            storef8(a.out + O_PP + ((size_t)b * 15 + j) * 1024 + c0, unpack8(*(const u32x4*)(U + ((size_t)b * 2048 + 2033 + j) * 1024 + c0))); }
        else { const int r2 = rj - 120, b = r2 / 15, j = r2 % 15;
            const F8 v = (j < 7) ? loadf8(spool + ((size_t)b * 15 + 8 + j) * 1024 + c0) : unpack8(*(const u32x4*)(U + ((size_t)MP + b * 8 + (j - 7)) * 1024 + c0));
            storef8(a.out + O_PS + ((size_t)b * 15 + j) * 1024 + c0, v); }
    }
    for (int u = gt; u < (8 + 128) * 3 * 384; u += NT) {
        const int slab = u % 384, rj = u / 384, c0 = slab * 8;
        if (rj < 24) { const int b = rj / 3, j = rj % 3;
            storef8(a.out + O_CP + ((size_t)b * 3 + j) * 3072 + c0, unpack8(*(const u32x4*)(XBC + ((size_t)b * 2048 + 2045 + j) * 3072 + c0))); }
        else { const int r2 = rj - 24, b = r2 / 3, j = r2 % 3;
            storef8(a.out + O_CS + ((size_t)b * 3 + j) * 3072 + c0, unpack8(*(const u32x4*)(XBC + ((size_t)MP + b * 8 + 5 + j) * 3072 + c0))); }
    }
}

#define MFMA16(p, q, c) __builtin_amdgcn_mfma_f32_16x16x32_bf16((p), (q), (c), 0, 0, 0)
constexpr int LDW = 136;
constexpr int LDX = 72;
typedef short v4i16_t __attribute__((ext_vector_type(4)));
__device__ __forceinline__ unsigned cvtpk(float lo, float hi) { f32x2_t v = {lo, hi}; bf16x2_t b = __builtin_convertvector(v, bf16x2_t); return __builtin_bit_cast(unsigned, b); }
__device__ __forceinline__ bf16x8 tr_frag(const LAS bf16* T, int pitch, int k0, int i0, int lane) {
    const int j = lane & 15, q = j >> 2, p = j & 3;
    const LAS bf16* ap = T + (k0 + q) * pitch + i0 + 4 * p;
    const v4i16_t lo = __builtin_amdgcn_ds_read_tr16_b64_v4i16((LAS v4i16_t*)ap), hi = __builtin_amdgcn_ds_read_tr16_b64_v4i16((LAS v4i16_t*)(ap + 4 * pitch));
    return (bf16x8){lo[0], lo[1], lo[2], lo[3], hi[0], hi[1], hi[2], hi[3]};
}
__device__ __forceinline__ void ssd_prompt_unit(LAS unsigned char* lds, int b, int h, const bf16* __restrict__ XC, const float* __restrict__ DT, const bf16* __restrict__ Z, bf16* __restrict__ YG, const float* a_log, const float* d_skip, float* __restrict__ out_ssm, float* __restrict__ SSQ2, int tid) {
    const int wave = __builtin_amdgcn_readfirstlane(tid >> 6), lane = tid & 63, l16 = lane & 15, quad = lane >> 4, g = h >> 3;
    LAS bf16* Cs = (LAS bf16*)lds;
    LAS bf16* Bs = Cs + 128 * LDW;
    LAS bf16* Xd = Bs + 128 * LDW;
    LAS bf16* Xw = Xd + 128 * LDX;
    LAS bf16* Hb = Xw + 128 * LDX;
    LAS float* acsb = (LAS float*)(Hb + 64 * LDW);
    LAS float* dtsb = acsb + 256;
    LAS bf16* HbB = (LAS bf16*)(dtsb + 256);
    const float A = -__expf(a_log[h]), Dh = d_skip[h];
    f32x4 hacc[4];
#pragma unroll
    for (int pt = 0; pt < 4; ++pt) hacc[pt] = (f32x4){0.f, 0.f, 0.f, 0.f};
    for (int i = tid; i < 64 * LDW / 2; i += NTHR) ((LAS unsigned*)Hb)[i] = 0u;
    const int lrow = 16 * wave + l16;
    u32x4 cgv[4], bgv[4], xgv[2]; float d0, d1;
    { const size_t row0 = (size_t)b * 2048;
#pragma unroll
      for (int i = 0; i < 4; ++i) { const int idx = tid + NTHR * i, l = idx >> 4, seg = idx & 15; const bf16* rp = XC + (row0 + l) * 3072 + g * 128 + seg * 8; cgv[i] = *(const u32x4*)(rp + 2560); bgv[i] = *(const u32x4*)(rp + 2048); }
#pragma unroll
      for (int i = 0; i < 2; ++i) { const int idx = tid + NTHR * i, l = idx >> 3, seg = idx & 7; xgv[i] = *(const u32x4*)(XC + (row0 + l) * 3072 + h * 64 + seg * 8); }
      d0 = DT[(row0 + lane) * 32 + h]; d1 = DT[(row0 + 64 + lane) * 32 + h]; }
#define WALK_SCAN(buf) do { if (wave == 0) { float a0_ = d0 * A, a1_ = d1 * A; \
        _Pragma("unroll") for (int o = 1; o < 64; o <<= 1) { const float t0_ = __shfl_up(a0_, o), t1_ = __shfl_up(a1_, o); if (lane >= o) { a0_ += t0_; a1_ += t1_; } } \
        a1_ += __shfl(a0_, 63); \
        acsb[(buf) * 128 + lane] = a0_; acsb[(buf) * 128 + 64 + lane] = a1_; dtsb[(buf) * 128 + lane] = d0; dtsb[(buf) * 128 + 64 + lane] = d1; } } while (0)
    WALK_SCAN(0);
    for (int c = 0; c < 16; ++c) {
        const size_t row0 = (size_t)b * 2048 + c * 128;
        LAS float* acs = acsb + (c & 1) * 128; LAS float* dts = dtsb + (c & 1) * 128;
        LDS_BARRIER();
        const float a_end = acs[127];
#pragma unroll
        for (int i = 0; i < 4; ++i) { const int idx = tid + NTHR * i, l = idx >> 4, seg = idx & 15;
            *(LAS u32x4*)(Cs + l * LDW + seg * 8) = cgv[i]; *(LAS u32x4*)(Bs + l * LDW + seg * 8) = bgv[i]; }
#pragma unroll
        for (int i = 0; i < 2; ++i) { const int idx = tid + NTHR * i, l = idx >> 3, seg = idx & 7;
            const float dtl = dts[l], wl = dtl * __expf(a_end - acs[l]); const F8 x = unpack8(xgv[i]);
            u32x4 wd, ww;
            wd.x = cvtpk(x.v[0] * dtl, x.v[1] * dtl); wd.y = cvtpk(x.v[2] * dtl, x.v[3] * dtl); wd.z = cvtpk(x.v[4] * dtl, x.v[5] * dtl); wd.w = cvtpk(x.v[6] * dtl, x.v[7] * dtl);
            ww.x = cvtpk(x.v[0] * wl, x.v[1] * wl); ww.y = cvtpk(x.v[2] * wl, x.v[3] * wl); ww.z = cvtpk(x.v[4] * wl, x.v[5] * wl); ww.w = cvtpk(x.v[6] * wl, x.v[7] * wl);
            *(LAS u32x4*)(Xd + l * LDX + seg * 8) = wd; *(LAS u32x4*)(Xw + l * LDX + seg * 8) = ww; }
        u32x2 xe[4], ze[4];
        { const size_t row = row0 + lrow;
#pragma unroll
          for (int pt = 0; pt < 4; ++pt) { const int p0 = 16 * pt + 4 * quad; xe[pt] = *(const u32x2*)(XC + row * 3072 + h * 64 + p0); ze[pt] = *(const u32x2*)(Z + row * 2048 + h * 64 + p0); } }
        if (c < 15) { const size_t rown = row0 + 128;
#pragma unroll
            for (int i = 0; i < 4; ++i) { const int idx = tid + NTHR * i, l = idx >> 4, seg = idx & 15; const bf16* rp = XC + (rown + l) * 3072 + g * 128 + seg * 8; cgv[i] = *(const u32x4*)(rp + 2560); bgv[i] = *(const u32x4*)(rp + 2048); }
#pragma unroll
            for (int i = 0; i < 2; ++i) { const int idx = tid + NTHR * i, l = idx >> 3, seg = idx & 7; xgv[i] = *(const u32x4*)(XC + (rown + l) * 3072 + h * 64 + seg * 8); }
            d0 = DT[(rown + lane) * 32 + h]; d1 = DT[(rown + 64 + lane) * 32 + h]; }
        LDS_BARRIER();
        bf16x8 cf[4];
#pragma unroll
        for (int kk = 0; kk < 4; ++kk) cf[kk] = *(const LAS bf16x8*)(Cs + lrow * LDW + kk * 32 + quad * 8);
        const float acs_l = acs[lrow];
        f32x4 yo[4];
#pragma unroll
        for (int pt = 0; pt < 4; ++pt) { f32x4 t = (f32x4){0.f, 0.f, 0.f, 0.f};
#pragma unroll
            for (int kk = 0; kk < 4; ++kk) t = MFMA16(*(const LAS bf16x8*)(((c & 1) ? HbB : Hb) + (16 * pt + l16) * LDW + kk * 32 + quad * 8), cf[kk], t);
            yo[pt] = t; }
        const int nct = (wave | 1) + 1;
        for (int ct = 0; ct < nct; ++ct) {
            f32x4 t = (f32x4){0.f, 0.f, 0.f, 0.f};
            if (ct <= wave) {
#pragma unroll
                for (int kk = 0; kk < 4; ++kk) t = MFMA16(*(const LAS bf16x8*)(Bs + (16 * ct + l16) * LDW + kk * 32 + quad * 8), cf[kk], t);
                const f32x4 as = *(const LAS f32x4*)(acs + 16 * ct + 4 * quad);
#pragma unroll
                for (int r = 0; r < 4; ++r) { const int sidx = 16 * ct + 4 * quad + r; t[r] = (sidx <= lrow) ? t[r] * __expf(acs_l - as[r]) : 0.f; }
            }
            u32x2 w; w.x = cvtpk(t[0], t[1]); w.y = cvtpk(t[2], t[3]);
            *(LAS u32x2*)(Cs + lrow * LDW + 16 * ct + 4 * quad) = w;
        }
        f32x4 yd[4];
#pragma unroll
        for (int pt = 0; pt < 4; ++pt) yd[pt] = (f32x4){0.f, 0.f, 0.f, 0.f};
        const int nks = (wave >> 1) + 1;
        for (int ks = 0; ks < nks; ++ks) { const bf16x8 gq = *(const LAS bf16x8*)(Cs + lrow * LDW + ks * 32 + quad * 8);
#pragma unroll
            for (int pt = 0; pt < 4; ++pt) yd[pt] = MFMA16(tr_frag(Xd, LDX, ks * 32 + 8 * quad, 16 * pt, lane), gq, yd[pt]); }
        { const float el = __expf(acs_l); const size_t row = row0 + lrow; float sq = 0.f;
#pragma unroll
          for (int pt = 0; pt < 4; ++pt) { const int p0 = 16 * pt + 4 * quad;
              const float xv[4] = {bflo(xe[pt].x), bfhi(xe[pt].x), bflo(xe[pt].y), bfhi(xe[pt].y)}, zv[4] = {bflo(ze[pt].x), bfhi(ze[pt].x), bflo(ze[pt].y), bfhi(ze[pt].y)};
              float o[4];
#pragma unroll
              for (int r = 0; r < 4; ++r) { const float y = yd[pt][r] + el * yo[pt][r] + Dh * xv[r]; o[r] = y * (zv[r] * __builtin_amdgcn_rcpf(1.0f + __expf(-zv[r]))); }
              sq += (o[0] * o[0] + o[1] * o[1]) + (o[2] * o[2] + o[3] * o[3]);
              u32x2 w; w.x = cvtpk(o[0], o[1]); w.y = cvtpk(o[2], o[3]);
              *(u32x2*)(YG + row * 2048 + h * 64 + p0) = w; }
          sq += __shfl_xor(sq, 16); sq += __shfl_xor(sq, 32);
          if (quad == 0) SSQ2[row * 32 + h] = sq; }
        { const float cd = __expf(a_end);
          bf16x8 bfr[4];
#pragma unroll
          for (int kk = 0; kk < 4; ++kk) bfr[kk] = tr_frag(Bs, LDW, kk * 32 + 8 * quad, 16 * wave, lane);
#pragma unroll
          for (int pt = 0; pt < 4; ++pt) { f32x4 t = hacc[pt] * cd;
#pragma unroll
              for (int kk = 0; kk < 4; ++kk) t = MFMA16(bfr[kk], tr_frag(Xw, LDX, kk * 32 + 8 * quad, 16 * pt, lane), t);
              hacc[pt] = t;
              u32x2 w; w.x = cvtpk(t[0], t[1]); w.y = cvtpk(t[2], t[3]);
              *(LAS u32x2*)(((c & 1) ? Hb : HbB) + (16 * pt + l16) * LDW + 16 * wave + 4 * quad) = w; } }
        if (c < 15) WALK_SCAN((c + 1) & 1);
    }
#undef WALK_SCAN
#pragma unroll
    for (int pt = 0; pt < 4; ++pt) *(f32x4*)(out_ssm + ((size_t)(b * 32 + h) * 64 + 16 * pt + l16) * 128 + 16 * wave + 4 * quad) = hacc[pt];
    __syncthreads();
}
constexpr int SST_BYTES = 8192;
__device__ __forceinline__ u32x4 ss_piece(int uu, int tid, const bf16* __restrict__ XC, const float* __restrict__ DT, const bf16* __restrict__ Z) {
    const int b = uu >> 5, h = uu & 31, g = h >> 3; const size_t rowb = (size_t)MP + b * 8; u32x4 pc = (u32x4){0u, 0u, 0u, 0u};
    if (tid < 256) { const int t = tid >> 5, ch = tid & 31; pc = *(const u32x4*)(XC + (rowb + t) * 3072 + 2048 + (ch >> 4) * 512 + g * 128 + (ch & 15) * 8); }
    else if (tid < 320) { const int q = tid - 256, t = q >> 3, ch = q & 7; pc = *(const u32x4*)(XC + (rowb + t) * 3072 + h * 64 + ch * 8); }
    else if (tid < 384) { const int q = tid - 320, t = q >> 3, ch = q & 7; pc = *(const u32x4*)(Z + (rowb + t) * 2048 + h * 64 + ch * 8); }
    else if (tid < 392) { pc.x = __float_as_uint(DT[(rowb + (tid - 384)) * 32 + h]); }
    return pc;
}
__device__ __forceinline__ void ss_stage(LAS unsigned char* st, int tid, u32x4 pc) {
    if (tid < 256) *(LAS u32x4*)(st + (tid >> 5) * 512 + (tid & 31) * 16) = pc;
    else if (tid < 320) *(LAS u32x4*)(st + 4096 + (tid - 256) * 16) = pc;
    else if (tid < 384) *(LAS u32x4*)(st + 5120 + (tid - 320) * 16) = pc;
    else if (tid < 392) *(LAS unsigned*)(st + 6144 + (tid - 384) * 4) = pc.x;
}
__device__ __forceinline__ void ss_state_load(int uu, int tid, const float* __restrict__ st_in, f32x4 (&hv)[4]) {
    const size_t so = ((size_t)uu * 64 + (tid >> 3)) * 128 + (tid & 7) * 16;
#pragma unroll
    for (int j = 0; j < 4; ++j) hv[j] = *(const f32x4*)(st_in + so + 4 * j);
}
__device__ __forceinline__ void ss_compute(const LAS unsigned char* st, int uu, int tid, f32x4 (&hv)[4], const float* a_log, const float* d_skip, bf16* __restrict__ YG, float* __restrict__ st_out) {
    const int p = tid >> 3, nq = tid & 7, b = uu >> 5, h = uu & 31; const size_t rowb = (size_t)MP + b * 8;
    const float A = -__expf(a_log[h]), Dh = d_skip[h];
    float yo = 0.f;
#pragma unroll 2
    for (int t = 0; t < 8; ++t) {
        const float dt = *(const LAS float*)(st + 6144 + t * 4), dA = __expf(dt * A);
        const float xv = bf2f(*(const LAS bf16*)(st + 4096 + t * 128 + p * 2)), z = bf2f(*(const LAS bf16*)(st + 5120 + t * 128 + p * 2));
        const LAS unsigned char* bc = st + t * 512 + nq * 32;
        const u32x4 Bw0 = *(const LAS u32x4*)bc, Bw1 = *(const LAS u32x4*)(bc + 16), Cw0 = *(const LAS u32x4*)(bc + 256), Cw1 = *(const LAS u32x4*)(bc + 272);
        const float coef = dt * xv; f32x2_t y2 = {0.f, 0.f}; const f32x2_t dA2 = {dA, dA}, cf2 = {coef, coef};
#define SS_PAIR(j, lohi, bw, cw) do { f32x2_t h2 = {hv[j][2 * (lohi)], hv[j][2 * (lohi) + 1]}; const f32x2_t b2 = {bflo(bw), bfhi(bw)}, c2 = {bflo(cw), bfhi(cw)}; \
            h2 = h2 * dA2 + cf2 * b2; y2 += h2 * c2; hv[j][2 * (lohi)] = h2.x; hv[j][2 * (lohi) + 1] = h2.y; } while (0)
        SS_PAIR(0, 0, Bw0.x, Cw0.x); SS_PAIR(0, 1, Bw0.y, Cw0.y); SS_PAIR(1, 0, Bw0.z, Cw0.z); SS_PAIR(1, 1, Bw0.w, Cw0.w);
        SS_PAIR(2, 0, Bw1.x, Cw1.x); SS_PAIR(2, 1, Bw1.y, Cw1.y); SS_PAIR(3, 0, Bw1.z, Cw1.z); SS_PAIR(3, 1, Bw1.w, Cw1.w);
#undef SS_PAIR
        float y = y2.x + y2.y;
        y += __shfl_xor(y, 1); y += __shfl_xor(y, 2); y += __shfl_xor(y, 4);
        y += Dh * xv;
        const float yg = y * (z * __builtin_amdgcn_rcpf(1.0f + __expf(-z)));
        yo = (nq == t) ? yg : yo;
    }
    YG[(rowb + nq) * 2048 + h * 64 + p] = (bf16)f2bf(yo);
    const size_t so = ((size_t)uu * 64 + p) * 128 + nq * 16;
#pragma unroll
    for (int j = 0; j < 4; ++j) __builtin_nontemporal_store(hv[j], (f32x4*)(st_out + so + 4 * j));
}
__device__ __forceinline__ void ssd_sample_units(LAS unsigned char* lds, int G, const bf16* __restrict__ XC, const float* __restrict__ DT, const bf16* __restrict__ Z, bf16* __restrict__ YG, const float* a_log, const float* d_skip, const float* __restrict__ st_in, float* __restrict__ st_out, int tid_in) {
    int tid = tid_in; asm volatile("" : "+v"(tid));
    int u = blockIdx.x; if (u >= 4096) return;
    f32x4 hna[4], hnb[4]; u32x4 pa = ss_piece(u, tid, XC, DT, Z), pb = (u32x4){0u, 0u, 0u, 0u};
    ss_state_load(u, tid, st_in, hna);
    if (u + G < 4096) { pb = ss_piece(u + G, tid, XC, DT, Z); ss_state_load(u + G, tid, st_in, hnb); }
    for (int it = 0; u < 4096; ++it) {
        LAS unsigned char* st0 = lds + (it & 1) * (2 * SST_BYTES); LAS unsigned char* st1 = st0 + SST_BYTES;
        const bool hasb = u + G < 4096;
        f32x4 ha[4], hb[4];
#pragma unroll
        for (int j = 0; j < 4; ++j) { ha[j] = hna[j]; hb[j] = hnb[j]; }
        ss_stage(st0, tid, pa); if (hasb) ss_stage(st1, tid, pb);
        const int un = u + 2 * G;
        if (un < 4096) { pa = ss_piece(un, tid, XC, DT, Z); ss_state_load(un, tid, st_in, hna); }
        if (un + G < 4096) { pb = ss_piece(un + G, tid, XC, DT, Z); ss_state_load(un + G, tid, st_in, hnb); }
        LDS_BARRIER();
        ss_compute(st0, u, tid, ha, a_log, d_skip, YG, st_out);
        if (hasb) ss_compute(st1, u + G, tid, hb, a_log, d_skip, YG, st_out);
        u = un;
    }
    __syncthreads();
}

__device__ __forceinline__ void ssd_sample_units_mfma(LAS unsigned char* lds, int G, const bf16* __restrict__ XC, const float* __restrict__ DT, const bf16* __restrict__ Z, bf16* __restrict__ YG, const float* a_log, const float* d_skip, const float* __restrict__ st_in, float* __restrict__ st_out, int tid_in) {
    int tid = tid_in; asm volatile("" : "+v"(tid));
    const int wave = __builtin_amdgcn_readfirstlane(tid >> 6), lane = tid & 63, l16 = lane & 15, quad = lane >> 4;
    LAS bf16* Cs = (LAS bf16*)lds;
    LAS bf16* Bs = (LAS bf16*)(lds + 4352);
    LAS bf16* Xd = (LAS bf16*)(lds + 13056);
    LAS bf16* Xw = (LAS bf16*)(lds + 17664);
    LAS bf16* Hb = (LAS bf16*)(lds + 22272);
    LAS bf16* Gs = (LAS bf16*)(lds + 39680) + wave * 640;
    LAS float* acs = (LAS float*)(lds + 44800);
    LAS float* dts = acs + 16;
    for (int i = tid; i < 44800 / 4; i += NTHR) ((LAS unsigned*)lds)[i] = 0u;
    int u = blockIdx.x; if (u >= 4096) { __syncthreads(); return; }
    f32x4 hst[4]; u32x4 pc = (u32x4){0u, 0u, 0u, 0u}; u32x2 xe = (u32x2){0u, 0u}, ze = (u32x2){0u, 0u}; float dtv = 0.f;
#define SM_LOAD(uu) do { const int b_ = (uu) >> 5, h_ = (uu) & 31, g_ = h_ >> 3; const size_t rowb_ = (size_t)MP + b_ * 8; \
        _Pragma("unroll") for (int pt = 0; pt < 4; ++pt) hst[pt] = *(const f32x4*)(st_in + ((size_t)(uu) * 64 + 16 * pt + l16) * 128 + 16 * wave + 4 * quad); \
        if (tid < 128) pc = *(const u32x4*)(XC + (rowb_ + (tid >> 4)) * 3072 + 2560 + g_ * 128 + (tid & 15) * 8); \
        else if (tid < 256) pc = *(const u32x4*)(XC + (rowb_ + ((tid - 128) >> 4)) * 3072 + 2048 + g_ * 128 + (tid & 15) * 8); \
        else if (tid < 320) pc = *(const u32x4*)(XC + (rowb_ + ((tid - 256) >> 3)) * 3072 + h_ * 64 + (tid & 7) * 8); \
        else if (tid < 328) dtv = DT[(rowb_ + (tid - 320)) * 32 + h_]; \
        if (wave < 4) { xe = *(const u32x2*)(XC + (rowb_ + (l16 & 7)) * 3072 + h_ * 64 + 16 * wave + 4 * quad); ze = *(const u32x2*)(Z + (rowb_ + (l16 & 7)) * 2048 + h_ * 64 + 16 * wave + 4 * quad); } } while (0)
    SM_LOAD(u);
    __syncthreads();
    while (u < 4096) {
        const int b = u >> 5, h = u & 31; const size_t rowb = (size_t)MP + b * 8;
        const float A = -__expf(a_log[h]), Dh = d_skip[h];
        f32x4 hacc[4]; const u32x4 pcc = pc; const u32x2 xec = xe, zec = ze;
#pragma unroll
        for (int pt = 0; pt < 4; ++pt) { hacc[pt] = hst[pt]; u32x2 w; w.x = cvtpk(hacc[pt][0], hacc[pt][1]); w.y = cvtpk(hacc[pt][2], hacc[pt][3]);
            *(LAS u32x2*)(Hb + (16 * pt + l16) * LDW + 16 * wave + 4 * quad) = w; }
        if (wave == 5) {
            float a0 = (lane < 8) ? dtv * A : 0.f;
#pragma unroll
            for (int o = 1; o < 8; o <<= 1) { const float t0 = __shfl_up(a0, o); if (lane >= o) a0 += t0; }
            const float aend = __shfl(a0, 7);
            if (lane < 16) { acs[lane] = (lane < 8) ? a0 : aend; dts[lane] = (lane < 8) ? dtv : 0.f; }
        }
        LDS_BARRIER();
        const float a_end = acs[7];
        if (tid < 128) *(LAS u32x4*)(Cs + (tid >> 4) * LDW + (tid & 15) * 8) = pcc;
        else if (tid < 256) *(LAS u32x4*)(Bs + ((tid - 128) >> 4) * LDW + (tid & 15) * 8) = pcc;
        else if (tid < 320) { const int t = (tid - 256) >> 3, seg = tid & 7; const float dtl = dts[t], wl = dtl * __expf(a_end - acs[t]); const F8 x = unpack8(pcc);
            u32x4 wd, ww;
            wd.x = cvtpk(x.v[0] * dtl, x.v[1] * dtl); wd.y = cvtpk(x.v[2] * dtl, x.v[3] * dtl); wd.z = cvtpk(x.v[4] * dtl, x.v[5] * dtl); wd.w = cvtpk(x.v[6] * dtl, x.v[7] * dtl);
            ww.x = cvtpk(x.v[0] * wl, x.v[1] * wl); ww.y = cvtpk(x.v[2] * wl, x.v[3] * wl); ww.z = cvtpk(x.v[4] * wl, x.v[5] * wl); ww.w = cvtpk(x.v[6] * wl, x.v[7] * wl);
            *(LAS u32x4*)(Xd + t * LDX + seg * 8) = wd; *(LAS u32x4*)(Xw + t * LDX + seg * 8) = ww; }
        const int un = u + G;
        if (un < 4096) SM_LOAD(un);
        LDS_BARRIER();
        if (wave < 4) {
            const int pt = wave;
            bf16x8 cf[4];
#pragma unroll
            for (int kk = 0; kk < 4; ++kk) cf[kk] = *(const LAS bf16x8*)(Cs + l16 * LDW + kk * 32 + quad * 8);
            const float acs_l = acs[l16];
            f32x4 yo = (f32x4){0.f, 0.f, 0.f, 0.f}, sc = (f32x4){0.f, 0.f, 0.f, 0.f};
#pragma unroll
            for (int kk = 0; kk < 4; ++kk) yo = MFMA16(*(const LAS bf16x8*)(Hb + (16 * pt + l16) * LDW + kk * 32 + quad * 8), cf[kk], yo);
#pragma unroll
            for (int kk = 0; kk < 4; ++kk) sc = MFMA16(*(const LAS bf16x8*)(Bs + l16 * LDW + kk * 32 + quad * 8), cf[kk], sc);
            { const f32x4 as = *(const LAS f32x4*)(acs + 4 * quad);
#pragma unroll
              for (int r = 0; r < 4; ++r) { const int sidx = 4 * quad + r; sc[r] = (sidx <= l16) ? sc[r] * __expf(acs_l - as[r]) : 0.f; }
              u32x2 w; w.x = cvtpk(sc[0], sc[1]); w.y = cvtpk(sc[2], sc[3]);
              *(LAS u32x2*)(Gs + l16 * 40 + 4 * quad) = w; }
            const bf16x8 gq = *(const LAS bf16x8*)(Gs + l16 * 40 + quad * 8);
            f32x4 yd = (f32x4){0.f, 0.f, 0.f, 0.f};
            yd = MFMA16(tr_frag(Xd, LDX, 8 * quad, 16 * pt, lane), gq, yd);
            const float el = __expf(acs_l);
            const float xv[4] = {bflo(xec.x), bfhi(xec.x), bflo(xec.y), bfhi(xec.y)}, zv[4] = {bflo(zec.x), bfhi(zec.x), bflo(zec.y), bfhi(zec.y)};
            float o[4];
#pragma unroll
            for (int r = 0; r < 4; ++r) { const float y = yd[r] + el * yo[r] + Dh * xv[r]; o[r] = y * (zv[r] * __builtin_amdgcn_rcpf(1.0f + __expf(-zv[r]))); }
            u32x2 w; w.x = cvtpk(o[0], o[1]); w.y = cvtpk(o[2], o[3]);
            if (l16 < 8) *(u32x2*)(YG + (rowb + l16) * 2048 + h * 64 + 16 * pt + 4 * quad) = w;
        }
        {
            const float cd = __expf(a_end);
            const bf16x8 bfr = tr_frag(Bs, LDW, 8 * quad, 16 * wave, lane);
#pragma unroll
            for (int pt = 0; pt < 4; ++pt) { f32x4 t = hacc[pt] * cd; t = MFMA16(bfr, tr_frag(Xw, LDX, 8 * quad, 16 * pt, lane), t);
                __builtin_nontemporal_store(t, (f32x4*)(st_out + ((size_t)u * 64 + 16 * pt + l16) * 128 + 16 * wave + 4 * quad)); }
        }
        LDS_BARRIER();
        u = un;
    }
#undef SM_LOAD
    __syncthreads();
}

#define XB_TMO      128
#define XB_XCNT(j)  (256  + 64 * (j))
#define XB_XSUB(j)  (1280 + 64 * (j))
#define XB_XGEN(j)  (2304 + 64 * (j))
#define XB_TOP      3328
#define XB_TOPGEN   3392
#define XCD_BAR_WORDS 3456
#define XB_SPIN_CAP (1u << 18)

__device__ __forceinline__ unsigned xb_ld(unsigned* p)              { return __hip_atomic_load(p, __ATOMIC_RELAXED, __HIP_MEMORY_SCOPE_AGENT); }
__device__ __forceinline__ unsigned xb_add(unsigned* p, unsigned v) { return __hip_atomic_fetch_add(p, v, __ATOMIC_RELAXED, __HIP_MEMORY_SCOPE_AGENT); }
__device__ __forceinline__ unsigned xb_xcc_id() { return (unsigned)__builtin_amdgcn_s_getreg((3 << 11) | 20) & 0xFu; }
#define XB_SPIN(cond, bar) do { unsigned _sp = 0; while (cond) { __builtin_amdgcn_s_sleep(1); \
    if ((++_sp & 255u) == 0u) { if (xb_ld(&(bar)[XB_TMO])) break; if (_sp > XB_SPIN_CAP) { atomicAdd(&(bar)[XB_TMO], 1u); break; } } } } while (0)

struct XcdBarrier {
    unsigned* bar; unsigned x;
    volatile LAS unsigned* st;
};

__device__ __forceinline__ XcdBarrier xcd_barrier_post(unsigned* bar, volatile LAS unsigned* st) {
    XcdBarrier b; b.bar = bar; b.x = xb_xcc_id(); b.st = st;
    if (threadIdx.x == 0) (void)xb_add(&bar[XB_XCNT(b.x)], 1u);
    return b;
}
__device__ __forceinline__ void xcd_barrier_complete(unsigned* bar, unsigned x, unsigned& nloc, unsigned& nx) {
    const unsigned G = gridDim.x * gridDim.y * gridDim.z;
    unsigned sum, cnt, mine, sp = 0u;
    for (;;) {
        sum = 0u; cnt = 0u; mine = 0u;
#pragma unroll
        for (unsigned j = 0; j < 16; ++j) { const unsigned c = xb_ld(&bar[XB_XCNT(j)]); sum += c; cnt += (c > 0u) ? 1u : 0u; mine = (j == x) ? c : mine; }
        if (sum == G) break;
        __builtin_amdgcn_s_sleep(1);
        if ((++sp & 255u) == 0u) { if (xb_ld(&bar[XB_TMO])) break; if (sp > XB_SPIN_CAP) { atomicAdd(&bar[XB_TMO], 1u); break; } }
    }
    nloc = mine > 0u ? mine : 1u; nx = cnt > 0u ? cnt : 1u;
}

__device__ __forceinline__ void xcd_barrier(const XcdBarrier& b) {
    asm volatile("s_waitcnt vmcnt(0)" ::: "memory");
    __syncthreads();
    if (threadIdx.x == 0) {
        unsigned* bar = b.bar;
        __builtin_amdgcn_s_waitcnt(0);
        unsigned nloc = b.st[0], nx = b.st[1];
        if (nloc == 0u) { xcd_barrier_complete(bar, b.x, nloc, nx); b.st[0] = nloc; b.st[1] = nx; }
        const unsigned old = xb_add(&bar[XB_XSUB(b.x)], 1u);
        const unsigned gen = old / nloc;
        if (old + 1u == (gen + 1u) * nloc) {
            __builtin_amdgcn_fence(__ATOMIC_RELEASE, "agent");
            asm volatile("s_waitcnt vmcnt(0)" ::: "memory");
            const unsigned og = xb_add(&bar[XB_TOP], 1u);
            const unsigned tg = og / nx;
            if (og + 1u == (tg + 1u) * nx) xb_add(&bar[XB_TOPGEN], 1u);
            else XB_SPIN(xb_ld(&bar[XB_TOPGEN]) == tg, bar);
            __builtin_amdgcn_fence(__ATOMIC_ACQUIRE, "agent");
            xb_add(&bar[XB_XGEN(b.x)], 1u);
            asm volatile("s_waitcnt vmcnt(0)" ::: "memory");
        } else {
            XB_SPIN(xb_ld(&bar[XB_XGEN(b.x)]) == gen, bar);
            __builtin_amdgcn_fence(__ATOMIC_ACQUIRE, "agent");
            asm volatile("s_waitcnt vmcnt(0)" ::: "memory");
        }
    }
    __syncthreads();
}

template <int S> __device__ __forceinline__ F8 part_sum(const float* __restrict__ Pf, int r, int col) {
    const bf16* P = (const bf16*)Pf; u32x4 w[S];
#pragma unroll
    for (int k = 0; k < S; ++k) w[k] = *(const u32x4*)(P + ((size_t)k * 1024 + r) * 1024 + col);
    F8 s = unpack8(w[0]);
#pragma unroll
    for (int k = 1; k < S; ++k) { const F8 v = unpack8(w[k]);
#pragma unroll
        for (int e = 0; e < 8; ++e) s.v[e] += v.v[e]; }
    return s;
}
template <int S, bool BASE_BF16, bool WRITE_X, bool WRITE_XB, bool SCALED = false> __device__ __forceinline__ void pass_resid(const float* P, const float* base, float* X, bf16* XB, float* RSTD, float scale, int G, int wave, int lane) {
    for (int r = blockIdx.x * NWAVES + wave; r < MS; r += G * NWAVES) {
        const size_t row = (size_t)MP + r; float ss = 0.f; const float rinv = SCALED ? RSTD[row] : 1.0f;
        F8 bb[2], aa[2];
#pragma unroll
        for (int hf = 0; hf < 2; ++hf) { const int col = hf * 512 + lane * 8;
            if constexpr (BASE_BF16) bb[hf] = unpack8(*(const u32x4*)(XB + row * 1024 + col)); else bb[hf] = loadf8(base + row * 1024 + col);
            aa[hf] = part_sum<S>(P, r, col); }
#pragma unroll
        for (int hf = 0; hf < 2; ++hf) { const int col = hf * 512 + lane * 8; F8 v;
#pragma unroll
            for (int e = 0; e < 8; ++e) { const float bv = SCALED ? bb[hf].v[e] * rinv : bb[hf].v[e]; v.v[e] = bv + scale * aa[hf].v[e]; ss += v.v[e] * v.v[e]; }
            if constexpr (WRITE_X) storef8(X + row * 1024 + col, v);
            if constexpr (WRITE_XB) *(u32x4*)(XB + row * 1024 + col) = pack8(v); }
        ss = wave_sum(ss);
        if (WRITE_XB && lane == 0) RSTD[row] = __builtin_amdgcn_rsqf(ss * (1.0f / 1024.0f) + EPS);
    }
}
template <int S> __device__ __forceinline__ void pass_final(const float* P, const bf16* XB, const float* gfin, float* Y, float scale, int G, int wave, int lane) {
    for (int r = blockIdx.x * NWAVES + wave; r < MS; r += G * NWAVES) {
        const size_t row = (size_t)MP + r; float ss = 0.f; F8 v[2];
#pragma unroll
        for (int hf = 0; hf < 2; ++hf) { const int col = hf * 512 + lane * 8;
            const F8 b = unpack8(*(const u32x4*)(XB + row * 1024 + col)), a = part_sum<S>(P, r, col);
#pragma unroll
            for (int e = 0; e < 8; ++e) { v[hf].v[e] = b.v[e] + scale * a.v[e]; ss += v[hf].v[e] * v[hf].v[e]; } }
        const float rstd = __builtin_amdgcn_rsqf(wave_sum(ss) * (1.0f / 1024.0f) + EPS);
#pragma unroll
        for (int hf = 0; hf < 2; ++hf) { const int col = hf * 512 + lane * 8; const F8 g = loadf8(gfin + col); F8 o;
#pragma unroll
            for (int e = 0; e < 8; ++e) o.v[e] = v[hf].v[e] * rstd * g.v[e];
            storef8(Y + row * 1024 + col, o); }
    }
}
__device__ __forceinline__ void pass_rstd_prompt(const float* SSQ, float* RSTD, int G, int tid) {
    for (int row = blockIdx.x * NTHR + tid; row < MP; row += G * NTHR) RSTD[row] = pg8::rstd16(SSQ, row);
}
template <int S> __device__ __forceinline__ void pass_merge(const float* P, const bf16* GL, const float* PP, bf16* O, int G, int wave, int lane) {
    for (int it = blockIdx.x * NWAVES + wave; it < 2 * MS; it += G * NWAVES) {
        const int r = it >> 1, hf = it & 1, col = hf * 512 + lane * 8; const size_t row = (size_t)MP + r;
        const F8 g0 = unpack8(*(const u32x4*)(GL + row * 2048 + col)), g1 = unpack8(*(const u32x4*)(GL + row * 2048 + 1024 + col)), bp = part_sum<4>(PP, r, col), a = part_sum<S>(P, r, col); F8 v;
#pragma unroll
        for (int e = 0; e < 8; ++e) v.v[e] = bp.v[e] * __builtin_amdgcn_rcpf(1.0f + __expf(-g0.v[e])) + a.v[e] * __builtin_amdgcn_rcpf(1.0f + __expf(-g1.v[e]));
        *(u32x4*)(O + row * 1024 + col) = pack8(v);
    }
}
template <int S> __device__ __forceinline__ void pass_plain(const float* P, bf16* O, int G, int wave, int lane) {
    for (int it = blockIdx.x * NWAVES + wave; it < 2 * MS; it += G * NWAVES) {
        const int r = it >> 1, hf = it & 1, col = hf * 512 + lane * 8; const size_t row = (size_t)MP + r;
        const F8 a = part_sum<S>(P, r, col); *(u32x4*)(O + row * 1024 + col) = pack8(a);
    }
}

__device__ unsigned g_bar[XCD_BAR_WORDS + 64];

__global__ void __launch_bounds__(NTHR, 2) fwd_kernel(Args a) {
    extern __shared__ __attribute__((aligned(16))) unsigned char lds_raw[];
    LAS unsigned char* lds = (LAS unsigned char*)lds_raw;
    const int tid = threadIdx.x, G = gridDim.x, lane = tid & 63, wave = __builtin_amdgcn_readfirstlane(tid >> 6);
    unsigned char* ws = a.ws;
    const int lo = a.ph_lo, hi = a.ph_hi;
    using namespace pg8;
    volatile LAS unsigned* MISC = (volatile LAS unsigned*)(lds + LDS_MISC_OFF);
    if (tid < 4) MISC[tid] = 0u;
    __syncthreads();
    const XcdBarrier bar = xcd_barrier_post((unsigned*)g_bar, MISC);
    bf16* XB = (bf16*)(ws + WS_XB); bf16* HID = (bf16*)(ws + WS_RA); float* SSQ = (float*)(ws + WS_SSQ); float* DT = (float*)(ws + WS_DT); float* RSTD = (float*)(ws + WS_RSTD);
    float* X = a.out + O_Y;
#ifndef PROBE_PHASE
#define PROBE_PHASE -1
#endif
#ifndef PROBE_AMP
#define PROBE_AMP 4
#endif
    unsigned long long tp0 = 0, tp1 = 0;
#define IN(k) ((((k) == PROBE_PHASE) ? (void)(tp0 = __builtin_amdgcn_s_memrealtime()) : (void)0), (lo <= (k) && (k) < hi))
#define SEAM(k) do { if ((k) + 1 < hi) { xcd_barrier(bar); } if ((k) == PROBE_PHASE) tp1 = __builtin_amdgcn_s_memrealtime(); } while (0)
    if (IN(0)) { phase0(a, lds, G, tid); SEAM(0); }
    if (IN(1)) {
        {
            Gemm gw{(const bf16_t*)(ws + WS_WPO), (const bf16_t*)(ws + WS_WPG), 1024, D, 256, D, 256, 256, nullptr}; StaticOrder Sw; Sw.init(1024, D, 256, 16, (int)blockIdx.x - (G - 16));
            if ((int)blockIdx.x >= G - 16) { EpiPlain Ew{(bf16*)(ws + WS_WEFF)}; gemm_phase<EpiPlain, StaticOrder, true, true>(lds, gw, Sw, Ew); }
        }
        Gemm g{XB, (const bf16_t*)(ws + WS_W1A), M, 2 * FF, D, D, D, 0, nullptr}; StaticOrder S; S.init(M, 2 * FF, D, G, (int)blockIdx.x);
        EpiSwiGLU E{HID, nullptr};
        gemm_phase<EpiSwiGLU, StaticOrder, true, true>(lds, g, S, E); SEAM(1);
    }
    if (IN(2)) {
        Gemm g{HID, (const bf16_t*)(ws + WS_W1B), M, D, FF, FF, FF, 0, (float*)(ws + WS_RD)}; SplitOrder S; S.init(FF, G, (int)blockIdx.x);
        typedef EpiResid<true, false, true, true> Epi2; Epi2 E{RSTD, RSTD, X, XB, SSQ, 0.5f};
        gemm_phase<Epi2, SplitOrder, true, true>(lds, g, S, E); xcd_barrier(bar);
        pass_resid<FF / 256, true, false, true, true>((const float*)(ws + WS_RD), nullptr, X, XB, RSTD, 0.5f, G, wave, lane); pass_rstd_prompt(SSQ, RSTD, G, tid); SEAM(2);
    }
    if (IN(3)) {
        Gemm g{XB, (const bf16_t*)(ws + WS_WIN), M, NPROJ_PAD, D, D, D, 0, nullptr}; StaticOrder S; S.init(M, NPROJ_PAD, D, G, (int)blockIdx.x);
        EpiInProj E{(bf16*)(ws + WS_RC), (bf16*)(ws + WS_RD), (bf16*)(ws + WS_RA), (bf16*)(ws + WS_RE), DT, a.in[I_DTB], RSTD};
        gemm_phase<EpiInProj, StaticOrder, true, true>(lds, g, S, E); SEAM(3);
    }
    if (IN(4)) { phase4(a, G, tid); SEAM(4); }
    if (IN(5)) {
        const bf16* XC = (const bf16*)(ws + WS_RB); const bf16* Z = (const bf16*)(ws + WS_RD); bf16* YG = (bf16*)(ws + WS_RA);
        if (PROBE_PHASE == 50) tp0 = __builtin_amdgcn_s_memrealtime();
        for (int u = blockIdx.x; u < 256; u += G) ssd_prompt_unit(lds, u >> 5, u & 31, XC, DT, Z, YG, a.in[I_ALOG], a.in[I_DSKIP], a.out + O_SP, (float*)(ws + WS_RC), tid);
        if (PROBE_PHASE == 50) tp1 = __builtin_amdgcn_s_memrealtime();
        if (PROBE_PHASE == 51) tp0 = __builtin_amdgcn_s_memrealtime();
        ssd_sample_units_mfma(lds, G, XC, DT, Z, YG, a.in[I_ALOG], a.in[I_DSKIP], a.in[I_SSSM], a.out + O_SS, tid);
        if (PROBE_PHASE == 51) tp1 = __builtin_amdgcn_s_memrealtime();
SEAM(5);
    }
    if (IN(6)) {
        Gemm g{(const bf16_t*)(ws + WS_RF), (const bf16_t*)(ws + WS_WEFF), M, D, D, D, D, 0, (float*)(ws + WS_RC + 4 * MiB)}; SplitOrder S; S.init(D, G, (int)blockIdx.x);
        EpiPlain E{(bf16*)(ws + WS_RB)};
        gemm_phase<EpiPlain, SplitOrder, true, true>(lds, g, S, E);
        bf16* YG = (bf16*)(ws + WS_RA);
        for (int u = MP * 4 + blockIdx.x * NWAVES + wave; u < M * 4; u += G * NWAVES) {
            u32x4* p = (u32x4*)(YG + (size_t)u * 512) + lane; F8 v = unpack8(*p); float sq = 0.f;
#pragma unroll
            for (int e = 0; e < 8; ++e) sq += v.v[e] * v.v[e];
            const float r = __builtin_amdgcn_rsqf(wave_sum(sq) * (1.0f / 512.0f) + EPS);
#pragma unroll
            for (int e = 0; e < 8; ++e) v.v[e] *= r;
            *p = pack8(v);
        }
        {
            const float* SSQ2 = (const float*)(ws + WS_RC); float* RAT = (float*)(ws + WS_RAT);
            for (int row = blockIdx.x * NTHR + tid; row < MP; row += G * NTHR) {
                const f32x4* q = (const f32x4*)(SSQ2 + (size_t)row * 32); float r[4];
#pragma unroll
                for (int g = 0; g < 4; ++g) { const f32x4 x0 = q[2 * g], x1 = q[2 * g + 1]; r[g] = __builtin_amdgcn_rsqf((((x0[0] + x0[1]) + (x0[2] + x0[3])) + ((x1[0] + x1[1]) + (x1[2] + x1[3]))) * (1.0f / 512.0f) + EPS); }
                *(f32x4*)(RAT + (size_t)row * 4) = (f32x4){r[0] / r[1], r[1] / r[2], r[2] / r[3], r[3]};
            }
        }
        SEAM(6);
    }
    if (IN(7)) {
        Gemm g{(const bf16_t*)(ws + WS_RA), (const bf16_t*)(ws + WS_WSO), M, D, 2048, 2048, 2048, 0, (float*)(ws + WS_RD)}; SplitOrder S; S.init(2048, G, (int)blockIdx.x);
        EpiMerge E{(const bf16_t*)(ws + WS_RE), (const bf16_t*)(ws + WS_RB), (bf16*)(ws + WS_RB + SZ1K), (const float*)(ws + WS_RAT)};
        gemm_phase<EpiMerge, SplitOrder, true, true>(lds, g, S, E); xcd_barrier(bar);
        pass_merge<8>((const float*)(ws + WS_RD), (const bf16*)(ws + WS_RE), (const float*)(ws + WS_RC + 4 * MiB), (bf16*)(ws + WS_RB + SZ1K), G, wave, lane); SEAM(7);
    }
    if (IN(8)) {
        Gemm g{(const bf16_t*)(ws + WS_RB + SZ1K), (const bf16_t*)(ws + WS_WO), M, D, D, D, D, 0, (float*)(ws + WS_RD)}; SplitOrder S; S.init(D, G, (int)blockIdx.x);
        typedef EpiResid<true, false, true> Epi8; Epi8 E{X, X, X, XB, SSQ, 1.0f};
        gemm_phase<Epi8, SplitOrder, true, true>(lds, g, S, E); xcd_barrier(bar);
        pass_resid<D / 256, true, false, true>((const float*)(ws + WS_RD), X, X, XB, RSTD, 1.0f, G, wave, lane); pass_rstd_prompt(SSQ, RSTD, G, tid); SEAM(8);
    }
    if (IN(9)) {
        Gemm g{XB, (const bf16_t*)(ws + WS_W2A), M, 2 * FF, D, D, D, 0, nullptr}; StaticOrder S; S.init(M, 2 * FF, D, G, (int)blockIdx.x);
        EpiSwiGLU E{HID, RSTD};
        gemm_phase<EpiSwiGLU, StaticOrder, true, true>(lds, g, S, E); SEAM(9);
    }
    if (IN(10)) {
        Gemm g{HID, (const bf16_t*)(ws + WS_W2B), M, D, FF, FF, FF, 0, (float*)(ws + WS_RD)}; SplitOrder S; S.init(FF, G, (int)blockIdx.x);
        typedef EpiResid<true, false, true> Epi10; Epi10 E{X, X, X, XB, SSQ, 0.5f};
        gemm_phase<Epi10, SplitOrder, true, true>(lds, g, S, E); xcd_barrier(bar);
        pass_final<FF / 256>((const float*)(ws + WS_RD), XB, a.in[I_NFIN], X, 0.5f, G, wave, lane);
        const float* gn = a.in[I_NFIN];
        for (int m0 = (blockIdx.x * NWAVES + wave) * 4; m0 < MP; m0 += G * NWAVES * 4) {
            const u32x4* xr = (const u32x4*)(XB + (size_t)m0 * D) + lane; u32x4 raw[4][2];
#pragma unroll
            for (int q = 0; q < 4; ++q) { raw[q][0] = xr[128 * q]; raw[q][1] = xr[128 * q + 64]; }
            const F8 g0 = loadf8(gn + lane * 8), g1 = loadf8(gn + 512 + lane * 8);
#pragma unroll
            for (int q = 0; q < 4; ++q) { const F8 a0 = unpack8(raw[q][0]), a1 = unpack8(raw[q][1]); float ss = 0.f;
#pragma unroll
                for (int e = 0; e < 8; ++e) ss += a0.v[e] * a0.v[e] + a1.v[e] * a1.v[e];
                const float rstd = __builtin_amdgcn_rsqf(wave_sum(ss) * (1.f / D) + EPS); F8 o0, o1;
#pragma unroll
                for (int e = 0; e < 8; ++e) { o0.v[e] = a0.v[e] * rstd * g0.v[e]; o1.v[e] = a1.v[e] * rstd * g1.v[e]; }
                storef8(X + (size_t)(m0 + q) * D + lane * 8, o0); storef8(X + (size_t)(m0 + q) * D + 512 + lane * 8, o1); }
        }
    }
    {
        __syncthreads();
        __shared__ unsigned s_last;
        if (tid == 0) s_last = (__hip_atomic_fetch_add(&g_bar[XCD_BAR_WORDS], 1u, __ATOMIC_RELAXED, __HIP_MEMORY_SCOPE_AGENT) == (unsigned)G - 1u) ? 1u : 0u;
        __syncthreads();
        if (s_last) { for (int i = tid; i < XCD_BAR_WORDS + 64; i += NTHR) __hip_atomic_store(&g_bar[i], 0u, __ATOMIC_RELAXED, __HIP_MEMORY_SCOPE_AGENT); }
    }
    if (hi > N_PHASES) cg::this_grid().sync();
    if (PROBE_PHASE == 99) { for (int i = 0; i < 16; ++i) xcd_barrier(bar); }
    if (PROBE_PHASE >= 0 && PROBE_PHASE != 99 && blockIdx.x == 0) { const unsigned long long t2 = __builtin_amdgcn_s_memrealtime(), want = (tp1 - tp0) * PROBE_AMP; while (__builtin_amdgcn_s_memrealtime() - t2 < want) __builtin_amdgcn_s_sleep(8); }
#undef IN
#undef SEAM
}

extern "C" void kernel_launch(void* const* d_in, const int* in_sizes, int n_in, void* d_out, int out_size, void* d_ws, size_t ws_size, hipStream_t stream) {
    static int grid = 0;
    if (grid == 0) {
        if (n_in != 25 || out_size != (int)O_END || ws_size < WS_END) { fprintf(stderr, "kernel_launch: unexpected sizes n_in %d out %d ws %zu (need %zu)\n", n_in, out_size, ws_size, (size_t)WS_END); grid = -1; return; }
        int dev = 0, cus = 0, per_cu = 0;
        hipGetDevice(&dev); hipDeviceGetAttribute(&cus, hipDeviceAttributeMultiprocessorCount, dev);
        if (hipFuncSetAttribute((const void*)fwd_kernel, hipFuncAttributeMaxDynamicSharedMemorySize, LDS_BYTES) != hipSuccess) { fprintf(stderr, "kernel_launch: hipFuncSetAttribute failed\n"); grid = -1; return; }
        hipOccupancyMaxActiveBlocksPerMultiprocessor(&per_cu, (const void*)fwd_kernel, NTHR, LDS_BYTES);
        (void)hipGetLastError();
        if (per_cu < 1) fprintf(stderr, "kernel_launch: occupancy query says %d blocks per CU\n", per_cu);
        grid = cus;
    }
    if (grid < 0) return;
    Args a{};
    for (int i = 0; i < 25; ++i) a.in[i] = (const float*)d_in[i];
    a.out = (float*)d_out; a.ws = (unsigned char*)d_ws;
    a.ph_lo = 0; a.ph_hi = N_PHASES;
    void* args[] = {&a};
    hipError_t e = hipLaunchCooperativeKernel((const void*)fwd_kernel, dim3(grid), dim3(NTHR), args, LDS_BYTES, stream);
    if (e != hipSuccess) fprintf(stderr, "cooperative launch failed: %s (grid %d)\n", hipGetErrorString(e), grid);

}
```
